# Optimizing an MI355X kernel written in HIP

```python
import math
import jax, jax.numpy as jnp
from jax import lax
import numpy as np

D_MODEL = 1024
BATCH = 2
SEQ = 8192
DEPTH = 1
DEC_BATCH = 4
DEC_SEQ = 8192
PAST_LEN = 128

PLE_DIM = 256
GRID_W = 64
Q_BLOCK = 128
EPS = 1e-6
A_HEADS = 8
A_HEAD_DIM = 64
A_ROT_DIM = A_HEAD_DIM // 4
A_ROPE_THETA = 500000.0
B_HEADS = 16
B_KV_HEADS = 4
B_HEAD_DIM = 64
B_AXIAL_THETA = 10000.0
D_FF = 2816
CONV_W = 3

A_Q = A_HEADS * 2 * A_HEAD_DIM
A_K = A_HEADS * 2 * A_HEAD_DIM
A_V = A_HEADS * 2 * A_HEAD_DIM
B_Q = B_HEADS * B_HEAD_DIM
B_KV = B_KV_HEADS * B_HEAD_DIM
A_WIDTH = A_V
B_WIDTH = B_Q
IN_COLS = A_Q + A_K + A_V + B_Q + 2 * B_KV + 2 * D_MODEL
IN_OFFSETS = (A_Q, A_Q + A_K, A_Q + A_K + A_V, A_Q + A_K + A_V + B_Q,
              A_Q + A_K + A_V + B_Q + B_KV, A_Q + A_K + A_V + B_Q + 2 * B_KV,
              A_Q + A_K + A_V + B_Q + 2 * B_KV + D_MODEL)

kernel_name = "hybrid_diffattn_axial_gqa_encoder"


def rms_norm(x, g):
    x32 = x.astype(jnp.float32)
    y = x32 * lax.rsqrt(jnp.mean(x32 * x32, axis=-1, keepdims=True) + EPS)
    return (y * g.astype(jnp.float32)).astype(x.dtype)


def rope_tables(pos, dim, theta):
    inv = theta ** (-jnp.arange(0, dim, 2, dtype=jnp.float32) / dim)
    ang = pos.astype(jnp.float32)[:, None] * inv[None, :]
    return jnp.cos(ang), jnp.sin(ang)


def rotate(x, cos, sin):
    half = x.shape[-1] // 2
    x1, x2 = x[..., :half], x[..., half:]
    c = cos[None, :, None, :].astype(x.dtype)
    s = sin[None, :, None, :].astype(x.dtype)
    return jnp.concatenate([x1 * c - x2 * s, x2 * c + x1 * s], axis=-1)


def partial_rope(x, cos, sin):
    rd = 2 * cos.shape[-1]
    return jnp.concatenate([rotate(x[..., :rd], cos, sin), x[..., rd:]], axis=-1)


def axial_rope(x, cos_r, sin_r, cos_c, sin_c):
    half = x.shape[-1] // 2
    return jnp.concatenate([rotate(x[..., :half], cos_r, sin_r),
                            rotate(x[..., half:], cos_c, sin_c)], axis=-1)


def to_blocks(x):
    b, s = x.shape[:2]
    return jnp.moveaxis(x.reshape((b, s // Q_BLOCK, Q_BLOCK) + x.shape[2:]), 1, 0)


def from_blocks(y):
    nb, b, qb = y.shape[:3]
    return jnp.moveaxis(y, 0, 1).reshape((b, nb * qb) + y.shape[3:])


def diff_attention(q1, q2, k1, k2, v, lam):
    scale = A_HEAD_DIM ** -0.5

    def block(qb):
        q1b, q2b = qb
        s1 = jnp.einsum('bqhd,bkhd->bhqk', q1b, k1).astype(jnp.float32) * scale
        s2 = jnp.einsum('bqhd,bkhd->bhqk', q2b, k2).astype(jnp.float32) * scale
        a = jax.nn.softmax(s1, axis=-1) - lam * jax.nn.softmax(s2, axis=-1)
        return jnp.einsum('bhqk,bkhe->bqhe', a.astype(v.dtype), v)

    return from_blocks(lax.map(block, (to_blocks(q1), to_blocks(q2))))


def gqa_attention(q, k, v):
    b, s = q.shape[:2]
    rep = B_HEADS // B_KV_HEADS
    scale = B_HEAD_DIM ** -0.5
    qg = q.reshape(b, s, B_KV_HEADS, rep, B_HEAD_DIM)

    def block(qb):
        sc = jnp.einsum('bqgrd,bkgd->bgrqk', qb, k).astype(jnp.float32) * scale
        pr = jax.nn.softmax(sc, axis=-1)
        return jnp.einsum('bgrqk,bkgd->bqgrd', pr.astype(v.dtype), v)

    out = from_blocks(lax.map(block, to_blocks(qg)))
    return out.reshape(b, s, B_WIDTH)


def depthwise_conv_centred(u, w, bias):
    s = u.shape[1]
    up = jnp.pad(u, ((0, 0), (1, 1), (0, 0)))
    return up[:, :s] * w[0] + up[:, 1:s + 1] * w[1] + up[:, 2:s + 2] * w[2] + bias


def encode(x, p, g_mix, w_in, lambda_q1, lambda_k1, lambda_q2, lambda_k2, g_diff, w_a,
           g_qn, g_kn, w_b, w_out, g_ffn, w_up, conv_w, conv_b, w_down,
           w_ple, g_ple, w_ple_gate, g_final):
    b, s, _ = x.shape
    rows = s // GRID_W
    pos = jnp.arange(s, dtype=jnp.int32)
    row_ids = jnp.repeat(jnp.arange(rows, dtype=jnp.int32), GRID_W)
    col_ids = jnp.tile(jnp.arange(GRID_W, dtype=jnp.int32), rows)
    cos_a, sin_a = rope_tables(pos, A_ROT_DIM, A_ROPE_THETA)
    cos_r, sin_r = rope_tables(row_ids, B_HEAD_DIM // 2, B_AXIAL_THETA)
    cos_c, sin_c = rope_tables(col_ids, B_HEAD_DIM // 2, B_AXIAL_THETA)

    h = x
    for i in range(DEPTH):
        lam_init = 0.8 - 0.6 * math.exp(-0.3 * i)
        n = rms_norm(h, g_mix[i])
        proj = n @ w_in[i]
        aq, ak, av, bq, bk, bv, ga, gb = jnp.split(proj, IN_OFFSETS, axis=-1)

        aq = aq.reshape(b, s, A_HEADS, 2, A_HEAD_DIM)
        ak = ak.reshape(b, s, A_HEADS, 2, A_HEAD_DIM)
        av = av.reshape(b, s, A_HEADS, 2 * A_HEAD_DIM)
        q1 = partial_rope(aq[..., 0, :], cos_a, sin_a)
        q2 = partial_rope(aq[..., 1, :], cos_a, sin_a)
        k1 = partial_rope(ak[..., 0, :], cos_a, sin_a)
        k2 = partial_rope(ak[..., 1, :], cos_a, sin_a)
        lam = (jnp.exp(jnp.sum(lambda_q1[i].astype(jnp.float32) * lambda_k1[i].astype(jnp.float32)))
               - jnp.exp(jnp.sum(lambda_q2[i].astype(jnp.float32) * lambda_k2[i].astype(jnp.float32)))
               + lam_init)
        oa = diff_attention(q1, q2, k1, k2, av, lam)
        oa = rms_norm(oa, g_diff[i]) * (1.0 - lam_init)
        ya = oa.reshape(b, s, A_WIDTH) @ w_a[i]

        bq = axial_rope(rms_norm(bq.reshape(b, s, B_HEADS, B_HEAD_DIM), g_qn[i]),
                        cos_r, sin_r, cos_c, sin_c)
        bk = axial_rope(rms_norm(bk.reshape(b, s, B_KV_HEADS, B_HEAD_DIM), g_kn[i]),
                        cos_r, sin_r, cos_c, sin_c)
        bv = bv.reshape(b, s, B_KV_HEADS, B_HEAD_DIM)
        yb = gqa_attention(bq, bk, bv) @ w_b[i]

        merged = jax.nn.sigmoid(ga) * ya + jax.nn.sigmoid(gb) * yb
        h = h + merged @ w_out[i]

        n2 = rms_norm(h, g_ffn[i])
        u = depthwise_conv_centred(n2 @ w_up[i], conv_w[i], conv_b[i])
        ug, uv = jnp.split(u, 2, axis=-1)
        h = h + (jax.nn.gelu(ug) * uv) @ w_down[i]

        gate = jax.nn.sigmoid(rms_norm(h, g_ple[i]) @ w_ple_gate[i])
        h = h + (p[i] @ w_ple[i]) * gate
    return rms_norm(h, g_final)


def setup_inputs(seed: int = 0) -> dict:
    key = jax.random.key(seed)
    ks = jax.random.split(key, 32)
    f32 = jnp.float32

    def dense(k, shape, fan_in):
        return jax.random.normal(k, shape, f32) * (fan_in ** -0.5)

    def gain(k, shape):
        return 1.0 + 0.01 * jax.random.normal(k, shape, f32)

    return {
        "x_prompt": jax.random.normal(ks[0], (BATCH, SEQ, D_MODEL), f32),
        "x_sample": jax.random.normal(ks[1], (DEC_BATCH, DEC_SEQ, D_MODEL), f32),
        "p_prompt": jax.random.normal(ks[2], (DEPTH, BATCH, SEQ, PLE_DIM), f32),
        "p_sample": jax.random.normal(ks[3], (DEPTH, DEC_BATCH, DEC_SEQ, PLE_DIM), f32),
        "g_mix": gain(ks[4], (DEPTH, D_MODEL)),
        "w_in": dense(ks[5], (DEPTH, D_MODEL, IN_COLS), D_MODEL),
        "lambda_q1": 0.1 * jax.random.normal(ks[6], (DEPTH, A_HEAD_DIM), f32),
        "lambda_k1": 0.1 * jax.random.normal(ks[7], (DEPTH, A_HEAD_DIM), f32),
        "lambda_q2": 0.1 * jax.random.normal(ks[8], (DEPTH, A_HEAD_DIM), f32),
        "lambda_k2": 0.1 * jax.random.normal(ks[9], (DEPTH, A_HEAD_DIM), f32),
        "g_diff": gain(ks[10], (DEPTH, 2 * A_HEAD_DIM)),
        "w_a": dense(ks[11], (DEPTH, A_WIDTH, D_MODEL), A_WIDTH),
        "g_qn": gain(ks[12], (DEPTH, B_HEAD_DIM)),
        "g_kn": gain(ks[13], (DEPTH, B_HEAD_DIM)),
        "w_b": dense(ks[14], (DEPTH, B_WIDTH, D_MODEL), B_WIDTH),
        "w_out": dense(ks[15], (DEPTH, D_MODEL, D_MODEL), D_MODEL),
        "g_ffn": gain(ks[16], (DEPTH, D_MODEL)),
        "w_up": dense(ks[17], (DEPTH, D_MODEL, 2 * D_FF), D_MODEL),
        "conv_w": dense(ks[18], (DEPTH, CONV_W, 2 * D_FF), CONV_W),
        "conv_b": 0.01 * jax.random.normal(ks[19], (DEPTH, 2 * D_FF), f32),
        "w_down": dense(ks[20], (DEPTH, D_FF, D_MODEL), D_FF),
        "w_ple": dense(ks[21], (DEPTH, PLE_DIM, D_MODEL), PLE_DIM),
        "g_ple": gain(ks[22], (DEPTH, D_MODEL)),
        "w_ple_gate": dense(ks[23], (DEPTH, D_MODEL, D_MODEL), D_MODEL),
        "g_final": gain(ks[24], (D_MODEL,)),
    }


def reference(x_prompt, x_sample, p_prompt, p_sample, g_mix, w_in, lambda_q1, lambda_k1,
              lambda_q2, lambda_k2, g_diff, w_a, g_qn, g_kn, w_b, w_out, g_ffn, w_up,
              conv_w, conv_b, w_down, w_ple, g_ple, w_ple_gate, g_final):
    y_prompt = encode(x_prompt, p_prompt, g_mix, w_in, lambda_q1, lambda_k1, lambda_q2, lambda_k2,
                      g_diff, w_a, g_qn, g_kn, w_b, w_out, g_ffn, w_up, conv_w, conv_b, w_down,
                      w_ple, g_ple, w_ple_gate, g_final)
    y_sample = encode(x_sample, p_sample, g_mix, w_in, lambda_q1, lambda_k1, lambda_q2, lambda_k2,
                      g_diff, w_a, g_qn, g_kn, w_b, w_out, g_ffn, w_up, conv_w, conv_b, w_down,
                      w_ple, g_ple, w_ple_gate, g_final)
    return (y_prompt, y_sample)
```

```cpp
#include <hip/hip_runtime.h>
#include <hip/hip_cooperative_groups.h>
#include <cstdio>
#include <cstdint>
__device__ __forceinline__ int lane_id_v() { int l; asm volatile("v_mbcnt_lo_u32_b32 %0, -1, 0\n\tv_mbcnt_hi_u32_b32 %0, -1, %0" : "=v"(l)); return l; }
__device__ __forceinline__ float shx(float v, int lane, int m) { return __int_as_float(__builtin_amdgcn_ds_bpermute((lane ^ m) << 2, __float_as_int(v))); }
namespace pg8 {
#define PG8_LAS __attribute__((address_space(3)))
typedef unsigned short bf16_t;
typedef short bf16x8 __attribute__((ext_vector_type(8)));
typedef float f32x4 __attribute__((ext_vector_type(4)));
typedef unsigned u32x4 __attribute__((ext_vector_type(4)));
constexpr int BM = 256, BK = 64, HALF = 128, HTB = HALF * BK * 2  , STAGE_BYTES = 8 * HTB, NXCD = 8, WGM = 8;

__host__ __device__ __forceinline__ int lds_byte(int r, int c) { const int st = (r >> 4) * 2 + (c >> 5), rr = r & 15, cc = c & 31, ob = rr * 64 + cc * 2; return st * 1024 + (ob ^ (((ob >> 9) & 1) << 5)); }
__host__ __device__ __forceinline__ void stage_rc(int b, int& R, int& C) { const int st = b / 1024, sb = b % 1024, swz = sb ^ (((sb >> 9) & 1) << 5); R = (st >> 1) * 16 + swz / 64; C = (st & 1) * 32 + (swz % 64) / 2; }
__host__ __device__ __forceinline__ int perm32(int rho) { const int n = rho >> 4, i = rho & 15; return 8 * (i >> 2) + 4 * n + (i & 3); }

struct Unit { int pm, pn; };
struct Gemm { const bf16_t* A; const bf16_t* Bt; int M, N, K; };

struct StaticOrder {
    int nM, nN, nwg, G, c;
    __host__ __device__ void init(int M, int N, int G_, int c_) { nM = M / BM; nN = N / BM; nwg = nM * nN; G = G_; c = c_; }
    __host__ __device__ bool next(int i, Unit& u) const {
        const long L = (long)i * G + c; if (L >= nwg) return false;
        int wgid = (int)L; { const int q = nwg / NXCD, r = nwg % NXCD, xcd = wgid % NXCD, off = wgid / NXCD; wgid = (xcd < r ? xcd * (q + 1) : r * (q + 1) + (xcd - r) * q) + off; }
        const int nig = WGM * nN, gid = wgid / nig, fm = gid * WGM, gsz = (nM - fm) < WGM ? (nM - fm) : WGM;
        u.pm = fm + ((wgid % nig) % gsz); u.pn = (wgid % nig) / gsz; return true;
    }
    __device__ __forceinline__ void a_ready(const Unit&) const {}
    __device__ __forceinline__ void done(const Unit&) const {}
};

__device__ __forceinline__ unsigned cvt_pk_bf16(float lo, float hi) { unsigned r; asm volatile("v_cvt_pk_bf16_f32 %0, %1, %2" : "=v"(r) : "v"(lo), "v"(hi)); return r; }
typedef float f32x2 __attribute__((ext_vector_type(2)));
__device__ __forceinline__ f32x2 gelu_pk(f32x2 v) {
    const f32x2 av = __builtin_elementwise_abs(v), d = av * 0.2316418882f + 1.0f;
    f32x2 t; t.x = __builtin_amdgcn_rcpf(d.x); t.y = __builtin_amdgcn_rcpf(d.y);
    f32x2 q = t * 0.5307027145f + (-0.7265760135f); q = q * t + 0.7107068705f; q = q * t + (-0.142248368f); q = q * t + 0.127414796f; q = q * t;
    const f32x2 s = (v * v) * (-0.72134752044f);
    f32x2 e; e.x = __builtin_amdgcn_exp2f(s.x); e.y = __builtin_amdgcn_exp2f(s.y);
    const f32x2 m = v * (q * e), r = v - m;
    f32x2 o; o.x = v.x < 0.f ? m.x : r.x; o.y = v.y < 0.f ? m.y : r.y; return o;
}

template <int ACT  > struct EpiBf16 {
    static constexpr bool PERM = true, AFTER_DRAIN = false; static_assert(ACT == 0 || ACT == 1, "EpiBf16: ACT is 0 (none) or 1 (gelu_pk)");
    bf16_t* O; int ldc; const float* bias; int split_cols; size_t split_stride; float scale0;
    __device__ __forceinline__ void operator()(const f32x4 (&acc)[2][2][4][2], const Unit& u, int wr, int wc, int fr, int fq) const {
        const int row0 = u.pm * BM + wr * 64 + fr; int colt = u.pn * BM; bf16_t* base = O;
        float sc = 1.f; if (split_cols) { const int t = colt / split_cols; base += (size_t)t * split_stride; colt -= t * split_cols; if (t == 0) sc = scale0; }
        const int col0 = colt + wc * 32 + 8 * fq, bcol0 = u.pn * BM + wc * 32 + 8 * fq;
        f32x4 bv[2][2];
#pragma unroll
        for (int bj = 0; bj < 2; ++bj)
#pragma unroll
            for (int n = 0; n < 2; ++n) bv[bj][n] = bias ? *(const f32x4*)(bias + bcol0 + bj * HALF + 4 * n) : (f32x4){0.f, 0.f, 0.f, 0.f};
#pragma unroll
        for (int ai = 0; ai < 2; ++ai)
#pragma unroll
            for (int m = 0; m < 4; ++m) { bf16_t* rowp = base + (size_t)(row0 + ai * HALF + m * 16) * ldc + col0;
#pragma unroll
                for (int bj = 0; bj < 2; ++bj) { f32x4 v0 = acc[ai][bj][m][0] + bv[bj][0], v1 = acc[ai][bj][m][1] + bv[bj][1];
                    if (ACT == 1) { f32x2 a = gelu_pk((f32x2){v0[0], v0[1]}), b = gelu_pk((f32x2){v0[2], v0[3]}), c = gelu_pk((f32x2){v1[0], v1[1]}), d = gelu_pk((f32x2){v1[2], v1[3]});
                        v0 = (f32x4){a.x, a.y, b.x, b.y}; v1 = (f32x4){c.x, c.y, d.x, d.y}; }
                    v0 = v0 * sc; v1 = v1 * sc; u32x4 w; w.x = cvt_pk_bf16(v0[0], v0[1]); w.y = cvt_pk_bf16(v0[2], v0[3]); w.z = cvt_pk_bf16(v1[0], v1[1]); w.w = cvt_pk_bf16(v1[2], v1[3]);
                    *(u32x4*)(rowp + bj * HALF) = w; } }
    }
};

__device__ __forceinline__ float sigm(float x) { return __builtin_amdgcn_rcpf(1.0f + __builtin_amdgcn_exp2f(-1.4426950408889634f * x)); }
__device__ __forceinline__ float bf_lo(unsigned w) { return __uint_as_float(w << 16); }
__device__ __forceinline__ float bf_hi(unsigned w) { return __uint_as_float(w & 0xffff0000u); }
__device__ __forceinline__ u32x4 pack8(const f32x4 v0, const f32x4 v1) { u32x4 w; w.x = cvt_pk_bf16(v0[0], v0[1]); w.y = cvt_pk_bf16(v0[2], v0[3]); w.z = cvt_pk_bf16(v1[0], v1[1]); w.w = cvt_pk_bf16(v1[2], v1[3]); return w; }
__device__ __forceinline__ void unpack8(const u32x4 g, f32x4& a, f32x4& b) { a = (f32x4){bf_lo(g.x), bf_hi(g.x), bf_lo(g.y), bf_hi(g.y)}; b = (f32x4){bf_lo(g.z), bf_hi(g.z), bf_lo(g.w), bf_hi(g.w)}; }

struct EpiProj {
    static constexpr bool PERM = true, AFTER_DRAIN = false;
    bf16_t* O; int ldc; int sig_pn;
    __device__ __forceinline__ void operator()(const f32x4 (&acc)[2][2][4][2], const Unit& u, int wr, int wc, int fr, int fq) const {
        const int row0 = u.pm * BM + wr * 64 + fr, col0 = u.pn * BM + wc * 32 + 8 * fq; const bool sg = u.pn >= sig_pn;
#pragma unroll
        for (int ai = 0; ai < 2; ++ai)
#pragma unroll
            for (int m = 0; m < 4; ++m) { bf16_t* rowp = O + (size_t)(row0 + ai * HALF + m * 16) * ldc + col0;
#pragma unroll
                for (int bj = 0; bj < 2; ++bj) { f32x4 v0 = acc[ai][bj][m][0], v1 = acc[ai][bj][m][1];
                    if (sg) {
#pragma unroll
                        for (int k = 0; k < 4; ++k) { v0[k] = sigm(v0[k]); v1[k] = sigm(v1[k]); } }
                    *(u32x4*)(rowp + bj * HALF) = pack8(v0, v1); } }
    }
};
struct EpiT1 {
    static constexpr bool PERM = true, AFTER_DRAIN = false;
    const bf16_t* G; int ldg; float* T; int ldt;
    __device__ __forceinline__ void operator()(const f32x4 (&acc)[2][2][4][2], const Unit& u, int wr, int wc, int fr, int fq) const {
        const int row0 = u.pm * BM + wr * 64 + fr, col0 = u.pn * BM + wc * 32 + 8 * fq;
#pragma unroll
        for (int ai = 0; ai < 2; ++ai)
#pragma unroll
            for (int m = 0; m < 4; ++m) { const size_t row = (size_t)(row0 + ai * HALF + m * 16);
#pragma unroll
                for (int bj = 0; bj < 2; ++bj) { const u32x4 g = *(const u32x4*)(G + row * ldg + col0 + bj * HALF); f32x4 g0, g1; unpack8(g, g0, g1);
                    float* tp = T + row * ldt + col0 + bj * HALF; *(f32x4*)tp = acc[ai][bj][m][0] * g0; *(f32x4*)(tp + 4) = acc[ai][bj][m][1] * g1; } }
    }
};
struct EpiMerge {
    static constexpr bool PERM = true, AFTER_DRAIN = false;
    const bf16_t* G; int ldg; const float* T; int ldt; bf16_t* O; int ldo;
    __device__ __forceinline__ void operator()(const f32x4 (&acc)[2][2][4][2], const Unit& u, int wr, int wc, int fr, int fq) const {
        const int row0 = u.pm * BM + wr * 64 + fr, col0 = u.pn * BM + wc * 32 + 8 * fq;
#pragma unroll
        for (int ai = 0; ai < 2; ++ai)
#pragma unroll
            for (int m = 0; m < 4; ++m) { const size_t row = (size_t)(row0 + ai * HALF + m * 16);
#pragma unroll
                for (int bj = 0; bj < 2; ++bj) { const u32x4 g = *(const u32x4*)(G + row * ldg + col0 + bj * HALF); f32x4 g0, g1; unpack8(g, g0, g1);
                    const float* tp = T + row * ldt + col0 + bj * HALF; const f32x4 t0 = *(const f32x4*)tp, t1 = *(const f32x4*)(tp + 4);
                    *(u32x4*)(O + row * ldo + col0 + bj * HALF) = pack8(t0 + acc[ai][bj][m][0] * g0, t1 + acc[ai][bj][m][1] * g1); } }
    }
};
template <bool MUL, bool XN> struct EpiResid {
    static constexpr bool PERM = true, AFTER_DRAIN = false;
    const float* base; float* out; const float* mul; bf16_t* xn; const float* gain; float* ss; int ld;
    __device__ __forceinline__ void operator()(const f32x4 (&acc)[2][2][4][2], const Unit& u, int wr, int wc, int fr, int fq) const {
        const int row0 = u.pm * BM + wr * 64 + fr, col0 = u.pn * BM + wc * 32 + 8 * fq;
        f32x4 gv[2][2];
#pragma unroll
        for (int bj = 0; bj < 2; ++bj) { if (XN) { gv[bj][0] = *(const f32x4*)(gain + col0 + bj * HALF); gv[bj][1] = *(const f32x4*)(gain + col0 + bj * HALF + 4); } else { gv[bj][0] = (f32x4){0.f, 0.f, 0.f, 0.f}; gv[bj][1] = gv[bj][0]; } }
#pragma unroll
        for (int ai = 0; ai < 2; ++ai)
#pragma unroll
            for (int m = 0; m < 4; ++m) { const size_t row = (size_t)(row0 + ai * HALF + m * 16); float s = 0.f;
#pragma unroll
                for (int bj = 0; bj < 2; ++bj) { const size_t p = row * ld + col0 + bj * HALF;
                    f32x4 v0 = acc[ai][bj][m][0], v1 = acc[ai][bj][m][1];
                    if (MUL) { v0 = v0 * *(const f32x4*)(mul + p); v1 = v1 * *(const f32x4*)(mul + p + 4); }
                    v0 = v0 + *(const f32x4*)(base + p); v1 = v1 + *(const f32x4*)(base + p + 4);
                    *(f32x4*)(out + p) = v0; *(f32x4*)(out + p + 4) = v1;
                    s += (v0[0] * v0[0] + v0[1] * v0[1]) + (v0[2] * v0[2] + v0[3] * v0[3]) + (v1[0] * v1[0] + v1[1] * v1[1]) + (v1[2] * v1[2] + v1[3] * v1[3]);
                    if (XN) *(u32x4*)(xn + p) = pack8(v0 * gv[bj][0], v1 * gv[bj][1]); }
                { const int ln = fr + 16 * fq; s += shx(s, ln, 16); s += shx(s, ln, 32); }
                if (fq == 0) __hip_atomic_fetch_add(ss + row, s, __ATOMIC_RELAXED, __HIP_MEMORY_SCOPE_AGENT);
                asm volatile("" ::: "memory"); }
    }
};
template <bool SIG> struct EpiScale {
    static constexpr bool PERM = true, AFTER_DRAIN = false;
    const float* ss; float inv_n, eps; bf16_t* O; float* F; int ldc;
    __device__ __forceinline__ void operator()(const f32x4 (&acc)[2][2][4][2], const Unit& u, int wr, int wc, int fr, int fq) const {
        const int row0 = u.pm * BM + wr * 64 + fr, col0 = u.pn * BM + wc * 32 + 8 * fq;
#pragma unroll
        for (int ai = 0; ai < 2; ++ai)
#pragma unroll
            for (int m = 0; m < 4; ++m) { const size_t row = (size_t)(row0 + ai * HALF + m * 16); const float r = __builtin_amdgcn_rsqf(ss[row] * inv_n + eps);
#pragma unroll
                for (int bj = 0; bj < 2; ++bj) { f32x4 v0 = acc[ai][bj][m][0] * r, v1 = acc[ai][bj][m][1] * r; const size_t p = row * ldc + col0 + bj * HALF;
                    if (SIG) {
#pragma unroll
                        for (int k = 0; k < 4; ++k) { v0[k] = sigm(v0[k]); v1[k] = sigm(v1[k]); }
                        *(f32x4*)(F + p) = v0; *(f32x4*)(F + p + 4) = v1;
                    } else *(u32x4*)(O + p) = pack8(v0, v1); } }
    }
};

template <class Epi, class Sched, bool ALIGN_EPI = false, bool SP2 = false>
__device__ __forceinline__ void gemm_phase(PG8_LAS unsigned char* lds, const Gemm g, const Sched& S, const Epi& E, int wave_s) {
    int tid_ = wave_s * 64 + lane_id_v(); asm volatile("" : "+v"(tid_));
    const int tid = tid_, wid = __builtin_amdgcn_readfirstlane(tid >> 6), lane = tid & 63, wr = wid >> 2, wc = wid & 3, fr = lane & 15, fq = lane >> 4;
    const int K = g.K, nt = K / BK;
    unsigned voffA[2], voffB[2];
#pragma unroll
    for (int i = 0; i < 2; ++i) { int R, C; stage_rc(tid * 16 + i * 8192, R, C); const int Rb = Epi::PERM ? ((R & ~31) + perm32(R & 31)) : R;
        voffA[i] = (unsigned)(R * K + C) * 2u; voffB[i] = (unsigned)(Rb * K + C) * 2u; }
    const size_t kstep = (size_t)(BK * 2);
    const size_t hstep = (size_t)HALF * K * 2;
    const size_t tstep = 2 * hstep;
    const unsigned ldsw = (unsigned)wid * 1024u;
    const int aoff = lds_byte(wr * 64 + fr, fq * 8), boff = lds_byte(wc * 32 + fr, fq * 8);
#define PG8_SA(b, h) (((b) * 2 + (h)) * HTB)
#define PG8_SB(b, h) ((4 + (b) * 2 + (h)) * HTB)
#define PG8_STAGE(bufoff, gbase, voff) do { _Pragma("unroll") for (int _i = 0; _i < 2; ++_i) \
        __builtin_amdgcn_global_load_lds((const unsigned*)((const char*)(gbase) + (voff)[_i]), (PG8_LAS unsigned*)(lds + (bufoff) + ldsw + _i * 8192), 16, 0, 0); } while (0)
#define PG8_LDA(dst, b, h) do { _Pragma("unroll") for (int m = 0; m < 4; ++m) _Pragma("unroll") for (int k = 0; k < 2; ++k) dst[m][k] = *(const PG8_LAS bf16x8*)(lds + PG8_SA(b, h) + aoff + m * 2048 + k * 1024); } while (0)
#define PG8_LDB(dst, b, h) do { _Pragma("unroll") for (int n = 0; n < 2; ++n) _Pragma("unroll") for (int k = 0; k < 2; ++k) dst[n][k] = *(const PG8_LAS bf16x8*)(lds + PG8_SB(b, h) + boff + n * 2048 + k * 1024); } while (0)
#define PG8_MMA(ai, bj, At, Bt) do { __builtin_amdgcn_s_setprio(1); _Pragma("unroll") for (int m = 0; m < 4; ++m) _Pragma("unroll") for (int n = 0; n < 2; ++n) _Pragma("unroll") for (int k = 0; k < 2; ++k) \
        acc[ai][bj][m][n] = __builtin_amdgcn_mfma_f32_16x16x32_bf16(Bt[n][k], At[m][k], acc[ai][bj][m][n], 0, 0, 0); __builtin_amdgcn_s_setprio(0); } while (0)
#define PG8_WAIT_V(n) asm volatile("s_waitcnt vmcnt(" #n ")" ::: "memory")
#define PG8_WAIT_L(n) asm volatile("s_waitcnt lgkmcnt(" #n ")" ::: "memory")
#define PG8_BAR __builtin_amdgcn_s_barrier()
#define PG8_SCHED __builtin_amdgcn_sched_barrier(0)
    Unit cur, nxt; int ui = 0;
    if (!S.next(0, cur)) return;
    f32x4 acc[2][2][4][2];
#pragma unroll
    for (int a = 0; a < 2; ++a)
#pragma unroll
        for (int b = 0; b < 2; ++b)
#pragma unroll
            for (int m = 0; m < 4; ++m)
#pragma unroll
                for (int n = 0; n < 2; ++n) acc[a][b][m][n] = (f32x4){0.f, 0.f, 0.f, 0.f};
    bf16x8 At[4][2], B0[2][2], B1[2][2];
    const char* cA = (const char*)g.A + (size_t)cur.pm * tstep; const char* cB = (const char*)g.Bt + (size_t)cur.pn * tstep;
    S.a_ready(cur);
    if constexpr (SP2) {
        PG8_STAGE(PG8_SB(0, 0), cB, voffB); PG8_STAGE(PG8_SB(0, 1), cB + hstep, voffB); PG8_STAGE(PG8_SA(0, 0), cA, voffA); PG8_STAGE(PG8_SA(0, 1), cA + hstep, voffA);
        if (wr == 1) PG8_BAR;
        PG8_WAIT_V(2); PG8_BAR;
        PG8_STAGE(PG8_SB(1, 0), cB + kstep, voffB); PG8_STAGE(PG8_SA(1, 0), cA + kstep, voffA); PG8_STAGE(PG8_SB(1, 1), cB + hstep + kstep, voffB);
        PG8_WAIT_V(6); PG8_BAR;
    } else {
        PG8_STAGE(PG8_SB(0, 0), cB, voffB); PG8_STAGE(PG8_SA(0, 0), cA, voffA); PG8_STAGE(PG8_SB(0, 1), cB + hstep, voffB); PG8_STAGE(PG8_SA(0, 1), cA + hstep, voffA);
        if (wr == 1) PG8_BAR;
        PG8_WAIT_V(4); PG8_BAR;
        PG8_STAGE(PG8_SB(1, 0), cB + kstep, voffB); PG8_STAGE(PG8_SA(1, 0), cA + kstep, voffA); PG8_STAGE(PG8_SB(1, 1), cB + hstep + kstep, voffB);
        PG8_WAIT_V(6); PG8_BAR;
    }
    for (;;) {
        const bool has_next = S.next(ui + 1, nxt);
        const char* nA = has_next ? (const char*)g.A + (size_t)nxt.pm * tstep : cA; const char* nB = has_next ? (const char*)g.Bt + (size_t)nxt.pn * tstep : cB;
        for (int t = 0; t < nt; t += 2) {
            const bool last = (t == nt - 2);
            const char* a1 = cA + (size_t)(t + 1) * kstep;
            const char* a2 = last ? nA : cA + (size_t)(t + 2) * kstep; const char* b2 = last ? nB : cB + (size_t)(t + 2) * kstep;
            const char* a3 = a2 + kstep; const char* b3 = b2 + kstep;
            if (last && has_next) S.a_ready(nxt);
            if constexpr (SP2) {
            PG8_LDB(B0, 0, 0); PG8_LDB(B1, 0, 1); PG8_SCHED; PG8_LDA(At, 0, 0); PG8_STAGE(PG8_SA(1, 1), a1 + hstep, voffA);
            PG8_WAIT_V(8); PG8_WAIT_L(0); PG8_BAR; PG8_MMA(0, 0, At, B0); PG8_MMA(0, 1, At, B1); PG8_BAR; PG8_SCHED;
            PG8_LDA(At, 0, 1); PG8_STAGE(PG8_SB(0, 0), b2, voffB); PG8_STAGE(PG8_SB(0, 1), b2 + hstep, voffB); PG8_STAGE(PG8_SA(0, 0), a2, voffA);
            PG8_WAIT_V(8); PG8_WAIT_L(0); PG8_BAR; PG8_MMA(1, 0, At, B0); PG8_MMA(1, 1, At, B1); PG8_BAR; PG8_SCHED;
            PG8_LDB(B0, 1, 0); PG8_LDB(B1, 1, 1); PG8_SCHED; PG8_LDA(At, 1, 0); PG8_STAGE(PG8_SA(0, 1), a2 + hstep, voffA);
            PG8_WAIT_V(8); PG8_WAIT_L(0); PG8_BAR; PG8_MMA(0, 0, At, B0); PG8_MMA(0, 1, At, B1); PG8_BAR; PG8_SCHED;
            PG8_LDA(At, 1, 1); PG8_STAGE(PG8_SB(1, 0), b3, voffB); PG8_STAGE(PG8_SB(1, 1), b3 + hstep, voffB); PG8_STAGE(PG8_SA(1, 0), a3, voffA);
            PG8_WAIT_V(8); PG8_WAIT_L(0); PG8_BAR; PG8_MMA(1, 0, At, B0); PG8_MMA(1, 1, At, B1); PG8_BAR; PG8_SCHED;
            } else {
            PG8_LDB(B0, 0, 0); PG8_SCHED; PG8_LDA(At, 0, 0); PG8_STAGE(PG8_SA(1, 1), a1 + hstep, voffA);
            PG8_WAIT_L(8); PG8_BAR; PG8_WAIT_L(0); PG8_MMA(0, 0, At, B0); PG8_BAR; PG8_SCHED;
            PG8_LDB(B1, 0, 1); PG8_STAGE(PG8_SB(0, 0), b2, voffB);
            PG8_BAR; PG8_WAIT_L(0); PG8_MMA(0, 1, At, B1); PG8_BAR;
            PG8_LDA(At, 0, 1); PG8_STAGE(PG8_SA(0, 0), a2, voffA);
            PG8_BAR; PG8_WAIT_L(0); PG8_MMA(1, 0, At, B0); PG8_BAR; PG8_SCHED;
            PG8_STAGE(PG8_SB(0, 1), b2 + hstep, voffB);
            PG8_WAIT_V(6); PG8_BAR; PG8_MMA(1, 1, At, B1); PG8_BAR;
            PG8_LDB(B0, 1, 0); PG8_SCHED; PG8_LDA(At, 1, 0); PG8_STAGE(PG8_SA(0, 1), a2 + hstep, voffA);
            PG8_WAIT_L(8); PG8_BAR; PG8_WAIT_L(0); PG8_MMA(0, 0, At, B0); PG8_BAR; PG8_SCHED;
            PG8_LDB(B1, 1, 1); PG8_STAGE(PG8_SB(1, 0), b3, voffB);
            PG8_BAR; PG8_WAIT_L(0); PG8_MMA(0, 1, At, B1); PG8_BAR;
            PG8_LDA(At, 1, 1); PG8_STAGE(PG8_SA(1, 0), a3, voffA);
            PG8_BAR; PG8_WAIT_L(0); PG8_MMA(1, 0, At, B0); PG8_BAR; PG8_SCHED;
            PG8_STAGE(PG8_SB(1, 1), b3 + hstep, voffB);
            PG8_WAIT_V(6); PG8_BAR; PG8_MMA(1, 1, At, B1); PG8_BAR;
            }
        }
        if constexpr (ALIGN_EPI) { if (wr == 0) PG8_BAR; }
        if constexpr (!Epi::AFTER_DRAIN) { E(acc, cur, wr, wc, fr, fq); S.done(cur); }
        if (!has_next) break;
#pragma unroll
        for (int a = 0; a < 2; ++a)
#pragma unroll
            for (int b = 0; b < 2; ++b)
#pragma unroll
                for (int m = 0; m < 4; ++m)
#pragma unroll
                    for (int n = 0; n < 2; ++n) acc[a][b][m][n] = (f32x4){0.f, 0.f, 0.f, 0.f};
        cur = nxt; cA = nA; cB = nB; ++ui;
        if constexpr (ALIGN_EPI) { if (wr == 1) PG8_BAR; }
    }
    PG8_WAIT_V(0);
    if constexpr (!ALIGN_EPI) { if (wr == 0) PG8_BAR; }
    PG8_BAR;
    if constexpr (Epi::AFTER_DRAIN) { E.fused(acc, cur, wr, wc, fr, fq, lds, wid, lane); S.done(cur); }
#undef PG8_SA
#undef PG8_SB
#undef PG8_STAGE
#undef PG8_LDA
#undef PG8_LDB
#undef PG8_MMA
#undef PG8_WAIT_V
#undef PG8_WAIT_L
#undef PG8_BAR
#undef PG8_SCHED
}
}

#ifndef PG8_SP2
#define PG8_SP2 true
#endif
#ifndef PG8_ALIGN
#define PG8_ALIGN true
#endif
#include <hip/hip_bf16.h>
#include <cmath>
#include <hip/hip_bf16.h>
#include <cmath>
namespace attn_body {
using bf16=__hip_bfloat16;
using bf16x8=__attribute__((ext_vector_type(8)))short;
using s16x4=__attribute__((ext_vector_type(4)))short;
using f32x16=__attribute__((ext_vector_type(16)))float;
using u32x4=__attribute__((ext_vector_type(4)))unsigned;
constexpr int BATCH=2,NHEAD=16,SEQ=8192,D=64,DM=NHEAD*D;
constexpr int NW=8,QBLK=32,QB=QBLK*NW,KVBLK=64,NQB=SEQ/QB;
constexpr int ATTN_PITCH=DM, ATTN_UNIT_ROWS=QB;
__device__ __forceinline__ int crow(int r,int hi){return (r&3)+8*(r>>2)+4*hi;}
#define SBAR() __builtin_amdgcn_sched_barrier(0)
__device__ __forceinline__ void cmask(f32x16&p0,f32x16&p1,int jb,int qrel,int hi){
  const float NEG=-INFINITY; int kb=64*jb+4*hi;
  #pragma unroll
  for(int r=0;r<16;++r){int kv=kb+(r&3)+8*(r>>2); if(kv>qrel)p0[r]=NEG; if(kv+32>qrel)p1[r]=NEG;}
}

constexpr int NSLOT=3, SLOTB=8192;
constexpr int LDS_K=0, LDS_V=NSLOT*SLOTB, LDS_WS=2*NSLOT*SLOTB, LDS_OST=LDS_WS+NW*64*4, LDS_BYTES=LDS_OST+NW*4096;
constexpr float C2=0.125f*1.4426950408889634f;
__device__ __forceinline__ void glds16(const void*gsrc,unsigned lds_dst){unsigned keep;
  asm volatile("s_mov_b32 %0, m0\n\ts_mov_b32 m0, %2\n\ts_nop 0\n\tglobal_load_lds_dwordx4 %1, off\n\ts_mov_b32 m0, %0":"=&s"(keep):"v"(gsrc),"s"(lds_dst):"memory");}
__device__ __forceinline__ float max3f(float a,float b,float c){float r;asm("v_max3_f32 %0, %1, %2, %3":"=v"(r):"v"(a),"v"(b),"v"(c));return r;}
__device__ __forceinline__ float max2f(float a,float b){float r;asm("v_max_f32_e32 %0, %1, %2":"=v"(r):"v"(a),"v"(b));return r;}
__device__ __forceinline__ float fadd_s(float a,float b){float r;asm("v_add_f32_e32 %0, %1, %2":"=v"(r):"v"(a),"v"(b));return r;}
__device__ __forceinline__ float fsub_s(float a,float b){float r;asm("v_sub_f32_e32 %0, %1, %2":"=v"(r):"v"(a),"v"(b));return r;}
typedef float f32x2_t __attribute__((ext_vector_type(2))); typedef __bf16 bf16x2_t __attribute__((ext_vector_type(2)));
__device__ __forceinline__ unsigned cvtpk_s(float lo,float hi){f32x2_t v={lo,hi};bf16x2_t b=__builtin_convertvector(v,bf16x2_t);return __builtin_bit_cast(unsigned,b);}
#define WAIT_BAR(N) asm volatile("s_waitcnt vmcnt(" #N ") lgkmcnt(0)\n\ts_barrier":::"memory")

__device__ __forceinline__ void qkt(f32x16&p0,f32x16&p1,const char*Kslot,const bf16x8*qr,const f32x16&negm,int r32,int hi){
  const char*kb=Kslot+hi*1024+r32*16;
  #pragma unroll
  for(int d0=0;d0<4;++d0){
    const bf16x8 b0=*reinterpret_cast<const bf16x8*>(kb+d0*2048);
    const bf16x8 b1=*reinterpret_cast<const bf16x8*>(kb+d0*2048+512);
    if(d0==0){p0=__builtin_amdgcn_mfma_f32_32x32x16_bf16(b0,qr[0],negm,0,0,0);p1=__builtin_amdgcn_mfma_f32_32x32x16_bf16(b1,qr[0],negm,0,0,0);}
    else{p0=__builtin_amdgcn_mfma_f32_32x32x16_bf16(b0,qr[d0],p0,0,0,0);p1=__builtin_amdgcn_mfma_f32_32x32x16_bf16(b1,qr[d0],p1,0,0,0);}}
}
typedef __attribute__((address_space(3))) const char* lds_cptr;
typedef short v4i16_t __attribute__((ext_vector_type(4)));
__device__ __forceinline__ void kload8(bf16x8*kf,lds_cptr kp){
  kf[0]=*(const __attribute__((address_space(3))) bf16x8*)(kp);      kf[1]=*(const __attribute__((address_space(3))) bf16x8*)(kp+512);
  kf[2]=*(const __attribute__((address_space(3))) bf16x8*)(kp+2048); kf[3]=*(const __attribute__((address_space(3))) bf16x8*)(kp+2560);
  kf[4]=*(const __attribute__((address_space(3))) bf16x8*)(kp+4096); kf[5]=*(const __attribute__((address_space(3))) bf16x8*)(kp+4608);
  kf[6]=*(const __attribute__((address_space(3))) bf16x8*)(kp+6144); kf[7]=*(const __attribute__((address_space(3))) bf16x8*)(kp+6656);
}
__device__ __forceinline__ void kload2(bf16x8*kf,lds_cptr kp,int j){ kf[2*j]=*(const __attribute__((address_space(3))) bf16x8*)(kp+j*2048); kf[2*j+1]=*(const __attribute__((address_space(3))) bf16x8*)(kp+j*2048+512); }
__device__ __forceinline__ s16x4 vtr(lds_cptr p){ return __builtin_bit_cast(s16x4,__builtin_amdgcn_ds_read_tr16_b64_v4i16((__attribute__((address_space(3))) v4i16_t*)p)); }
__device__ __forceinline__ float rowmax(const f32x16&p0,const f32x16&p1){
  float a=max3f(p0[0],p0[1],p1[0]),b=max3f(p0[2],p0[3],p1[1]);a=max3f(a,p1[2],p1[3]);
  #pragma unroll
  for(int r=4;r<16;r+=4){a=max3f(a,p0[r],p0[r+1]);b=max3f(b,p0[r+2],p0[r+3]);a=max3f(a,p1[r],p1[r+1]);b=max3f(b,p1[r+2],p1[r+3]);}
  const float m=max2f(a,b);
  auto rr=__builtin_amdgcn_permlane32_swap(__float_as_uint(m),__float_as_uint(m),false,false);
  return max2f(__uint_as_float(rr[0]),__uint_as_float(rr[1]));
}
__device__ __forceinline__ void pv(f32x16*o,int vb,bf16x8 pa0,bf16x8 pa1,bf16x8 pa2,bf16x8 pa3){
  #pragma unroll
  for(int d0=0;d0<2;++d0){s16x4 lo[4],hi[4];
    #pragma unroll
    for(int ks=0;ks<4;++ks){
      asm volatile("ds_read_b64_tr_b16 %0,%1 offset:%c2":"=&v"(lo[ks]):"v"(vb),"i"(d0*4096+ks*1024):"memory");
      asm volatile("ds_read_b64_tr_b16 %0,%1 offset:%c2":"=&v"(hi[ks]):"v"(vb),"i"(d0*4096+ks*1024+512):"memory");}
    asm volatile("s_waitcnt lgkmcnt(0)":::"memory");SBAR();
    #define PK(k) (bf16x8){lo[k][0],lo[k][1],lo[k][2],lo[k][3],hi[k][0],hi[k][1],hi[k][2],hi[k][3]}
    o[d0]=__builtin_amdgcn_mfma_f32_32x32x16_bf16(pa0,PK(0),o[d0],0,0,0);
    o[d0]=__builtin_amdgcn_mfma_f32_32x32x16_bf16(pa1,PK(1),o[d0],0,0,0);
    o[d0]=__builtin_amdgcn_mfma_f32_32x32x16_bf16(pa2,PK(2),o[d0],0,0,0);
    o[d0]=__builtin_amdgcn_mfma_f32_32x32x16_bf16(pa3,PK(3),o[d0],0,0,0);
    #undef PK
  }
}

#ifndef ATTN_STORE16
#define ATTN_STORE16(p,v) (*(u32x4*)(p)=(v))
#endif
template<int THRL> __device__ __forceinline__ void attn_unit(int qb,const bf16*Qh,const bf16*Kh,const bf16*Vh,bf16*Oh,int pq,int pk,int pv_,int po,char*shm,int wave_s){
  int tid_=wave_s*64+lane_id_v(); asm volatile("":"+v"(tid_)); const int tid=tid_,lane=tid&63,r32=lane&31,hi=lane>>5; const int wid=__builtin_amdgcn_readfirstlane(tid>>6);
  const int q0=qb*QB;
  const bf16*Qw=Qh+(long)(q0+wid*QBLK)*pq;
  const unsigned lds0=(unsigned)(uintptr_t)shm;
  float*wsf=(float*)(shm+LDS_WS)+wid*64;
  const bf16*ksrc=Kh+(long)lane*pk+wid*8;
  const bf16*vsrc=Vh+(long)(16*(wid&3)+(lane>>2))*pv_+(wid>>2)*32+(lane&3)*8;
  const unsigned kdst=lds0+LDS_K+wid*1024, vdst=lds0+LDS_V+wid*1024;
  #define DMA_K(t,slot) glds16(ksrc+(long)(t)*KVBLK*pk,(unsigned)__builtin_amdgcn_readfirstlane(kdst+(slot)))
  #define DMA_V(t,slot) glds16(vsrc+(long)(t)*KVBLK*pv_,(unsigned)__builtin_amdgcn_readfirstlane(vdst+(slot)))
  const int vb0=(int)(lds0+LDS_V)+((lane>>4)&1)*32+(lane&3)*8+(4*hi+((lane&15)>>2))*64;
  const char*Kbase=shm+LDS_K; bf16x8 kf[8];
  const lds_cptr shm3=(lds_cptr)shm; const lds_cptr kp0=shm3+LDS_K+hi*1024+r32*16; const lds_cptr vp0=shm3+LDS_V+((lane>>4)&1)*32+(lane&3)*8+(4*hi+((lane&15)>>2))*64;
  constexpr int NT=SEQ/KVBLK;
  DMA_K(0,0);DMA_V(0,0);DMA_K(1,SLOTB);
  bf16x8 qr[4];
  #pragma unroll
  for(int d0=0;d0<4;++d0)qr[d0]=*reinterpret_cast<const bf16x8*>(&Qw[(long)r32*pq+d0*16+hi*8]);
  float mhat=0.f,l_reg=0.f;f32x16 o[2];o[0]=f32x16{};o[1]=f32x16{};f32x16 negm=f32x16{};asm volatile("":"+v"(negm));

  #define CMASK(P0,P1,t) do{}while(0)
  bool resc=false;
  #define START(P0,P1) do{ const float rm=rowmax(P0,P1); resc=false; \
    { const float dl=rm; mhat=fadd_s(mhat,dl); \
      _Pragma("unroll") for(int r=0;r<16;++r){P0[r]=fsub_s(P0[r],dl);P1[r]=fsub_s(P1[r],dl);} \
      _Pragma("unroll") for(int r=0;r<16;++r)negm[r]=-mhat; asm volatile("":"+v"(negm)); } \
    _Pragma("unroll") for(int r=0;r<16;++r)P0[r]=__builtin_amdgcn_exp2f(P0[r]); }while(0)
  #define RESC() do{ if(resc){ asm volatile("s_waitcnt lgkmcnt(0)":::"memory"); \
      _Pragma("unroll") for(int d_=0;d_<2;++d_) _Pragma("unroll") for(int r=0;r<16;++r)o[d_][r]*=wsf[crow(r,hi)]; } }while(0)
  f32x16 pA0,pA1,pB0,pB1;
  int sl_prev=0,sl_cur=0,sl_next=SLOTB;
  #define ROT() do{sl_prev=sl_cur;sl_cur=sl_next;sl_next=(sl_next==(NSLOT-1)*SLOTB)?0:sl_next+SLOTB;}while(0)
  DMA_K(2,2*SLOTB);
  WAIT_BAR(3);
  qkt(pA0,pA1,Kbase,qr,negm,r32,hi);asm volatile("s_nop 15\n\ts_nop 7":"+v"(pA0),"+v"(pA1));CMASK(pA0,pA1,0);
  START(pA0,pA1);
  _Pragma("unroll") for(int r=0;r<16;++r)pA1[r]=__builtin_amdgcn_exp2f(pA1[r]);
  WAIT_BAR(0);
  DMA_K(3,0);DMA_V(1,SLOTB);
  ROT();
  kload8(kf,kp0+sl_cur);
  WAIT_BAR(2);
  s16x4 vlo[8],vhi[8]; u32x4 pw0,pw1,pw2,pw3;
  #define PKW(P,B) cvtpk_s(P[B],P[B+1])
  #define PAF(k) __builtin_bit_cast(bf16x8,pw##k)
  #define VFR(i) (bf16x8){vlo[i][0],vlo[i][1],vlo[i][2],vlo[i][3],vhi[i][0],vhi[i][1],vhi[i][2],vhi[i][3]}
  #define PIN(x) asm volatile("":"+v"(x))
  #define MX3(a,b,c) __builtin_fmaxf(__builtin_fmaxf((a),(b)),(c))
  #define GAPA(MF,A0,A1,A2,A3,W0,W1,PW) do{ MF; sacc+=A0; sacc+=A1; sacc+=A2; sacc+=A3; PIN(sacc); W0; W1; PIN(PW); SBAR(); }while(0)
  #define EX(v) __builtin_amdgcn_exp2f(v)
  #define GAPB(MF,X,B) do{ MF; X[B]=EX(X[B]); X[B+1]=EX(X[B+1]); X[B+2]=EX(X[B+2]); X[B+3]=EX(X[B+3]); PIN(X); SBAR(); }while(0)
  #define VRD(i) do{ vlo[i]=vtr(vp_+(((i)>>2)*4096+((i)&3)*1024)); vhi[i]=vtr(vp_+(((i)>>2)*4096+((i)&3)*1024+512)); }while(0)
  #define KRD(G,j) do{ if(G){ kload2(kf,kp0+sl_next,j); SBAR(); } }while(0)
  #define STEP(C0,C1,P0,P1,t,GK,GV,GL) do{ SBAR(); \
    const lds_cptr vp_=vp0+sl_prev; \
    VRD(0); SBAR(); float sacc=(P0[0]+P0[1]); \
    GAPA(C0=__builtin_amdgcn_mfma_f32_32x32x16_bf16(kf[0],qr[0],negm,0,0,0), P0[2],P0[3],P0[4],P0[5],     pw0[0]=PKW(P0,0), pw0[1]=PKW(P0,2), pw0); \
    VRD(4); SBAR(); GAPA(C1=__builtin_amdgcn_mfma_f32_32x32x16_bf16(kf[1],qr[0],negm,0,0,0), P0[6],P0[7],P0[8],P0[9],     pw0[2]=PKW(P0,4), pw0[3]=PKW(P0,6), pw0); \
    VRD(1); SBAR(); GAPA(C0=__builtin_amdgcn_mfma_f32_32x32x16_bf16(kf[2],qr[1],C0,0,0,0),   P0[10],P0[11],P0[12],P0[13], pw1[0]=PKW(P0,8), pw1[1]=PKW(P0,10), pw1); \
    VRD(5); SBAR(); GAPA(C1=__builtin_amdgcn_mfma_f32_32x32x16_bf16(kf[3],qr[1],C1,0,0,0),   P0[14],P0[15],P1[0],P1[1],   pw1[2]=PKW(P0,12),pw1[3]=PKW(P0,14), pw1); \
    VRD(2); SBAR(); GAPA(C0=__builtin_amdgcn_mfma_f32_32x32x16_bf16(kf[4],qr[2],C0,0,0,0),   P1[2],P1[3],P1[4],P1[5],     pw2[0]=PKW(P1,0), pw2[1]=PKW(P1,2), pw2); \
    VRD(6); SBAR(); GAPA(C1=__builtin_amdgcn_mfma_f32_32x32x16_bf16(kf[5],qr[2],C1,0,0,0),   P1[6],P1[7],P1[8],P1[9],     pw2[2]=PKW(P1,4), pw2[3]=PKW(P1,6), pw2); \
    VRD(3); SBAR(); GAPA(C0=__builtin_amdgcn_mfma_f32_32x32x16_bf16(kf[6],qr[3],C0,0,0,0),   P1[10],P1[11],P1[12],P1[13], pw3[0]=PKW(P1,8), pw3[1]=PKW(P1,10), pw3); \
    VRD(7); SBAR(); GAPA(C1=__builtin_amdgcn_mfma_f32_32x32x16_bf16(kf[7],qr[3],C1,0,0,0),   P1[14],P1[15],0.f,0.f,       pw3[2]=PKW(P1,12),pw3[3]=PKW(P1,14), pw3); \
    l_reg+=sacc; \
    if(GK){DMA_K((t)+3,sl_cur);} if(GV){DMA_V((t)+1,sl_next);} \
    CMASK(C0,C1,t); \
    { float a=MX3(C0[0],C0[1],C1[0]),b=MX3(C0[2],C0[3],C1[1]); a=MX3(a,C1[2],C1[3]); \
      _Pragma("unroll") for(int r=4;r<16;r+=4){a=MX3(a,C0[r],C0[r+1]);b=MX3(b,C0[r+2],C0[r+3]);a=MX3(a,C1[r],C1[r+1]);b=MX3(b,C1[r+2],C1[r+3]);} \
      float rm=__builtin_fmaxf(a,b); { auto rr=__builtin_amdgcn_permlane32_swap(__float_as_uint(rm),__float_as_uint(rm),false,false); rm=__builtin_fmaxf(__uint_as_float(rr[0]),__uint_as_float(rr[1])); } \
      resc=false; \
      if(__builtin_expect(__any(rm>(float)THRL),0)){ const float dl=__builtin_fmaxf(rm,0.f); mhat+=dl; \
        _Pragma("unroll") for(int r=0;r<16;++r){C0[r]-=dl;C1[r]-=dl;} \
        _Pragma("unroll") for(int r=0;r<16;++r)negm[r]=-mhat; asm volatile("":"+v"(negm)); \
        const float f=__builtin_amdgcn_exp2f(-dl); l_reg*=f; if(hi==0)wsf[r32]=f; resc=true; } } \
    SBAR(); \
    GAPB(o[0]=__builtin_amdgcn_mfma_f32_32x32x16_bf16(PAF(0),VFR(0),o[0],0,0,0), C0,0); \
    GAPB(o[1]=__builtin_amdgcn_mfma_f32_32x32x16_bf16(PAF(0),VFR(4),o[1],0,0,0), C0,4); \
    KRD(GL,0); GAPB(o[0]=__builtin_amdgcn_mfma_f32_32x32x16_bf16(PAF(1),VFR(1),o[0],0,0,0), C0,8); \
    KRD(GL,1); GAPB(o[1]=__builtin_amdgcn_mfma_f32_32x32x16_bf16(PAF(1),VFR(5),o[1],0,0,0), C0,12); \
    KRD(GL,2); GAPB(o[0]=__builtin_amdgcn_mfma_f32_32x32x16_bf16(PAF(2),VFR(2),o[0],0,0,0), C1,0); \
    KRD(GL,3); GAPB(o[1]=__builtin_amdgcn_mfma_f32_32x32x16_bf16(PAF(2),VFR(6),o[1],0,0,0), C1,4); \
    GAPB(o[0]=__builtin_amdgcn_mfma_f32_32x32x16_bf16(PAF(3),VFR(3),o[0],0,0,0), C1,8); \
    GAPB(o[1]=__builtin_amdgcn_mfma_f32_32x32x16_bf16(PAF(3),VFR(7),o[1],0,0,0), C1,12); \
    }while(0)
  int t=1;
  #undef CMASK
  #define CMASK(P0,P1,t) do{}while(0)
  for(;t+5<NT;t+=2){
    STEP(pB0,pB1,pA0,pA1,t,true,true,true);     WAIT_BAR(2); RESC(); ROT();
    STEP(pA0,pA1,pB0,pB1,t+1,true,true,true);   WAIT_BAR(2); RESC(); ROT();
  }
  #undef CMASK
  #define CMASK(P0,P1,t) do{}while(0)
  #define ENDW(tt) do{ if((tt)+3<NT){WAIT_BAR(2);} else if((tt)+2<NT){WAIT_BAR(1);} else {WAIT_BAR(0);} }while(0)
  for(;t+1<NT;t+=2){
    STEP(pB0,pB1,pA0,pA1,t,(t+3<NT),(t+1<NT),(t+1<NT));       ENDW(t);   RESC(); ROT();
    STEP(pA0,pA1,pB0,pB1,t+1,(t+4<NT),(t+2<NT),(t+2<NT));     ENDW(t+1); RESC(); ROT();
  }
  STEP(pB0,pB1,pA0,pA1,NT-1,false,false,false); RESC();
  { float sacc=pB0[0]+pB0[1]; _Pragma("unroll") for(int r=2;r<16;++r)sacc+=pB0[r]; _Pragma("unroll") for(int r=0;r<16;++r)sacc+=pB1[r]; l_reg+=sacc;
    pw0=(u32x4){PKW(pB0,0),PKW(pB0,2),PKW(pB0,4),PKW(pB0,6)};pw1=(u32x4){PKW(pB0,8),PKW(pB0,10),PKW(pB0,12),PKW(pB0,14)};pw2=(u32x4){PKW(pB1,0),PKW(pB1,2),PKW(pB1,4),PKW(pB1,6)};pw3=(u32x4){PKW(pB1,8),PKW(pB1,10),PKW(pB1,12),PKW(pB1,14)};
    SBAR(); pv(o,vb0+sl_cur,PAF(0),PAF(1),PAF(2),PAF(3)); }
  #undef PKW
  #undef PAF
  #undef VFR
  #undef PIN
  #undef MX3
  #undef GAPA
  #undef GAPB
  #undef EX
  #undef VRD
  #undef KRD
  #undef STEP
  #undef ENDW
  {auto rr=__builtin_amdgcn_permlane32_swap(__float_as_uint(l_reg),__float_as_uint(l_reg),false,false);l_reg=__uint_as_float(rr[0])+__uint_as_float(rr[1]);}
  if(hi==0)wsf[32+r32]=l_reg;asm volatile("s_waitcnt lgkmcnt(0)":::"memory");
  float rli[16];
  #pragma unroll
  for(int r=0;r<16;++r)rli[r]=__builtin_amdgcn_rcpf(wsf[32+crow(r,hi)]);
  bf16*Ow=Oh+(long)(q0+wid*QBLK)*po;
  { bf16*stg=(bf16*)(shm+LDS_OST)+wid*2048;
    #pragma unroll
    for(int r=0;r<16;++r){const int orow=crow(r,hi);
      #pragma unroll
      for(int d0=0;d0<2;++d0)stg[orow*64+d0*32+r32]=__float2bfloat16(o[d0][r]*rli[r]);}
    asm volatile("s_waitcnt lgkmcnt(0)":::"memory");
    #pragma unroll
    for(int i=0;i<4;++i){const int row=i*8+(lane>>3),ch=lane&7; const u32x4 v=*(const u32x4*)(stg+row*64+ch*8); ATTN_STORE16(Ow+(long)row*po+ch*8,v);} }
  asm volatile("s_waitcnt lgkmcnt(0)\n\ts_barrier":::"memory");
  #undef DMA_K
  #undef DMA_V
  #undef CMASK
  #undef START
  #undef RESC
  #undef ROT
}
#undef SBAR
#undef WAIT_BAR
}
#define LAS __attribute__((address_space(3)))
#define XB_TMO      128
#define XB_XCNT(j)  (256  + 64 * (j))
#define XB_XSUB(j)  (1280 + 64 * (j))
#define XB_XGEN(j)  (2304 + 64 * (j))
#define XB_TOP      3328
#define XB_TOPGEN   3392
#define XCD_BAR_WORDS 3456
#define XB_SPIN_CAP (1u << 18)

__device__ __forceinline__ unsigned xb_ld(unsigned* p)              { return __hip_atomic_load(p, __ATOMIC_RELAXED, __HIP_MEMORY_SCOPE_AGENT); }
__device__ __forceinline__ unsigned xb_add(unsigned* p, unsigned v) { return __hip_atomic_fetch_add(p, v, __ATOMIC_RELAXED, __HIP_MEMORY_SCOPE_AGENT); }
__device__ __forceinline__ unsigned xb_xcc_id() { return (unsigned)__builtin_amdgcn_s_getreg((3 << 11) | 20) & 0xFu; }
#define XB_SPIN(cond, bar) do { unsigned _sp = 0; while (cond) { __builtin_amdgcn_s_sleep(1); \
    if ((++_sp & 255u) == 0u) { if (xb_ld(&(bar)[XB_TMO])) break; if (_sp > XB_SPIN_CAP) { atomicAdd(&(bar)[XB_TMO], 1u); break; } } } } while (0)

struct XcdBarrier {
    unsigned* bar; unsigned x;
    volatile LAS unsigned* st; bool leader;
};

__device__ __forceinline__ XcdBarrier xcd_barrier_post(unsigned* bar, volatile LAS unsigned* st, bool leader) {
    XcdBarrier b; b.bar = bar; b.x = xb_xcc_id(); b.st = st; b.leader = leader;
    if (leader) (void)xb_add(&bar[XB_XCNT(b.x)], 1u);
    return b;
}
__device__ __forceinline__ void xcd_barrier_complete(unsigned* bar, unsigned x, unsigned& nloc, unsigned& nx) {
    const unsigned G = gridDim.x * gridDim.y * gridDim.z;
    unsigned sum, cnt, mine, sp = 0u;
    for (;;) {
        sum = 0u; cnt = 0u; mine = 0u;
#pragma unroll
        for (unsigned j = 0; j < 16; ++j) { const unsigned c = xb_ld(&bar[XB_XCNT(j)]); sum += c; cnt += (c > 0u) ? 1u : 0u; mine = (j == x) ? c : mine; }
        if (sum == G) break;
        __builtin_amdgcn_s_sleep(1);
        if ((++sp & 255u) == 0u) { if (xb_ld(&bar[XB_TMO])) break; if (sp > XB_SPIN_CAP) { atomicAdd(&bar[XB_TMO], 1u); break; } }
    }
    nloc = mine > 0u ? mine : 1u; nx = cnt > 0u ? cnt : 1u;
}

__device__ __forceinline__ void xcd_barrier(const XcdBarrier& b) {
    asm volatile("s_waitcnt vmcnt(0)" ::: "memory");
    __syncthreads();
    if (b.leader) {
        unsigned* bar = b.bar;
        __builtin_amdgcn_s_waitcnt(0);
        unsigned nloc = b.st[0], nx = b.st[1];
        if (nloc == 0u) { xcd_barrier_complete(bar, b.x, nloc, nx); b.st[0] = nloc; b.st[1] = nx; }
        const unsigned old = xb_add(&bar[XB_XSUB(b.x)], 1u);
        const unsigned gen = old / nloc;
        if (old + 1u == (gen + 1u) * nloc) {
            __builtin_amdgcn_fence(__ATOMIC_RELEASE, "agent");
            asm volatile("s_waitcnt vmcnt(0)" ::: "memory");
            const unsigned og = xb_add(&bar[XB_TOP], 1u);
            const unsigned tg = og / nx;
            if (og + 1u == (tg + 1u) * nx) xb_add(&bar[XB_TOPGEN], 1u);
            else XB_SPIN(xb_ld(&bar[XB_TOPGEN]) == tg, bar);
            __builtin_amdgcn_fence(__ATOMIC_ACQUIRE, "agent");
            xb_add(&bar[XB_XGEN(b.x)], 1u);
            asm volatile("s_waitcnt vmcnt(0)" ::: "memory");
        } else {
            XB_SPIN(xb_ld(&bar[XB_XGEN(b.x)]) == gen, bar);
            __builtin_amdgcn_fence(__ATOMIC_ACQUIRE, "agent");
            asm volatile("s_waitcnt vmcnt(0)" ::: "memory");
        }
    }
    __syncthreads();
}
#undef LAS
namespace cg = cooperative_groups;
#ifndef NCHUNK_DEF
#define NCHUNK_DEF 3
#endif
constexpr int NWAVES = 8;
constexpr int SEQ = 8192, DM = 1024, MC = 16384  , NCHUNK = NCHUNK_DEF, NPROJ = 6656, DFF = 2816, NUP = 2 * DFF, PLE = 256;
constexpr int C_AQ = 0, C_AK = 1024, C_AV = 2048, C_BQ = 3072, C_BK = 4096, C_BV = 4352, C_GA = 4608, C_GB = 5632;
constexpr float EPS = 1e-6f;
constexpr float QSCALE = 0.125f * 1.4426950408889634f;
constexpr size_t MiB = 1u << 20;
constexpr size_t WS_SS = 0;
constexpr size_t WS_TABA = 1 * MiB;
constexpr size_t WS_TABX = 1 * MiB + 512 * 1024;
constexpr size_t WS_WIN = 2 * MiB, WS_WA = 15 * MiB, WS_WB = 17 * MiB, WS_WOUT = 19 * MiB, WS_WUP = 21 * MiB, WS_WDN = 32 * MiB, WS_WPLE = 38 * MiB, WS_WPG = 39 * MiB;
constexpr size_t WS_XN = 42 * MiB;
constexpr size_t WS_PB = 74 * MiB;
constexpr size_t WS_PROJ = 82 * MiB;
constexpr size_t WS_U = WS_PROJ;
constexpr size_t WS_SG = WS_PROJ;
constexpr size_t WS_OA1 = 290 * MiB, WS_OA2 = 322 * MiB, WS_OB = 354 * MiB, WS_MG = 386 * MiB;
constexpr size_t WS_ACT = WS_OA1;
constexpr size_t WS_END = 418 * MiB;
constexpr int LDS_BYTES = 147456, MISC_OFF = 131072 + 320;
constexpr size_t WS_BAR = 1 * MiB + 768 * 1024;

#define GAS __attribute__((address_space(1)))
#define LAS __attribute__((address_space(3)))
typedef unsigned short bf16_t;
typedef unsigned v4u __attribute__((ext_vector_type(4)));
typedef unsigned v2u __attribute__((ext_vector_type(2)));
typedef float f32x4 __attribute__((ext_vector_type(4)));
#define LDS_WAIT() asm volatile("s_waitcnt lgkmcnt(0)" ::: "memory")
__device__ __forceinline__ unsigned f2bf(float f) { unsigned u = __builtin_bit_cast(unsigned, f); return (u + 0x7fffu + ((u >> 16) & 1u)) >> 16; }
__device__ __forceinline__ unsigned pk2(float lo, float hi) { return f2bf(lo) | (f2bf(hi) << 16); }
__device__ __forceinline__ float wave_sum(float v, int lane) {
#pragma unroll
    for (int o = 1; o < 64; o <<= 1) v += shx(v, lane, o);
    return v;
}
__device__ __forceinline__ void unpack16(const v4u a, const v4u b, float (&x)[16]) {
    x[0] = pg8::bf_lo(a.x); x[1] = pg8::bf_hi(a.x); x[2] = pg8::bf_lo(a.y); x[3] = pg8::bf_hi(a.y); x[4] = pg8::bf_lo(a.z); x[5] = pg8::bf_hi(a.z); x[6] = pg8::bf_lo(a.w); x[7] = pg8::bf_hi(a.w);
    x[8] = pg8::bf_lo(b.x); x[9] = pg8::bf_hi(b.x); x[10] = pg8::bf_lo(b.y); x[11] = pg8::bf_hi(b.y); x[12] = pg8::bf_lo(b.z); x[13] = pg8::bf_hi(b.z); x[14] = pg8::bf_lo(b.w); x[15] = pg8::bf_hi(b.w);
}
__device__ __forceinline__ void pack16(const float (&x)[16], v4u& a, v4u& b) {
    a.x = pk2(x[0], x[1]); a.y = pk2(x[2], x[3]); a.z = pk2(x[4], x[5]); a.w = pk2(x[6], x[7]);
    b.x = pk2(x[8], x[9]); b.y = pk2(x[10], x[11]); b.z = pk2(x[12], x[13]); b.w = pk2(x[14], x[15]);
}

__device__ __forceinline__ void p0_transpose_item(const float* W, int K, int N, bf16_t* WT, LAS float* scr, int item, int lane) {
    const int nblk = N / 32, kb = item / nblk, nb = item % nblk, k0 = 64 * kb, n0 = 32 * nb;
#pragma unroll 8
    for (int i = 0; i < 32; ++i) { const int kk = 2 * i + (lane >> 5); scr[kk * 33 + (lane & 31)] = W[(size_t)(k0 + kk) * N + n0 + (lane & 31)]; }
    LDS_WAIT(); asm volatile("" ::: "memory");
    const int c = lane & 7;
#pragma unroll
    for (int j = 0; j < 4; ++j) { const int n = (lane >> 3) + 8 * j; const LAS float* s = scr + (8 * c) * 33 + n;
        v4u o; o.x = pk2(s[0 * 33], s[1 * 33]); o.y = pk2(s[2 * 33], s[3 * 33]); o.z = pk2(s[4 * 33], s[5 * 33]); o.w = pk2(s[6 * 33], s[7 * 33]);
        *(GAS v4u*)(WT + (size_t)(n0 + n) * K + k0 + 8 * c) = o; }
    LDS_WAIT(); asm volatile("" ::: "memory");
}

struct Ctx {
    int vcu, G, wave_s;
};
__device__ __forceinline__ unsigned long long karg(int i) { const __attribute__((address_space(4))) unsigned long long* ka = (const __attribute__((address_space(4))) unsigned long long*)__builtin_amdgcn_kernarg_segment_ptr(); asm volatile("" : "+s"(ka)); return ka[i]; }
#define KIN(i) ((const float*)karg(i))
#define KOUT() ((float*)karg(25))
#define KWS() ((unsigned char*)karg(26))

__device__ __forceinline__ void phase_prologue(const Ctx& F, LAS unsigned char* lds) {
    int tid_ = F.wave_s * 64 + lane_id_v(); asm volatile("" : "+v"(tid_)); const int tid = tid_, lane = tid & 63, wave = F.wave_s, gw = F.vcu * NWAVES + wave, NGW = F.G * NWAVES; (void)lane; (void)gw; (void)NGW;
    unsigned char* const ws = KWS(); (void)ws;
    const int gt = F.vcu * (NWAVES * 64) + tid, NGT = F.G * NWAVES * 64;
    float* ss = (float*)(ws + WS_SS);
    for (int i = gt; i < 9 * MC; i += NGT) ss[i] = 0.f;
    {
        float* tab = (float*)(ws + WS_TABA);
        for (int i = gt; i < SEQ * 8; i += NGT) { const int pos = i >> 3, k = i & 7;
            const float inv = k == 0 ? 1.0f : k == 1 ? 0.19392274474868576f : k == 2 ? 0.03760603093086393f : k == 3 ? 0.007292664737217109f : k == 4 ? 0.001414213562373095f : k == 5 ? 0.0002742481756762073f : k == 6 ? 5.318295896944988e-05f : 1.031338537721246e-05f;
            const float ang = (float)pos * inv; double rev = (double)ang * 0.15915494309189535; rev -= __builtin_floor(rev); const float r = (float)rev;
            tab[pos * 16 + k] = __builtin_amdgcn_cosf(r); tab[pos * 16 + 8 + k] = __builtin_amdgcn_sinf(r); }
    }
    {
        float* tab = (float*)(ws + WS_TABX);
        for (int i = gt; i < 128 * 16; i += NGT) { const int pos = i >> 4, k = i & 15;
            const float inv = __builtin_amdgcn_exp2f(-(float)k * (13.287712379549449f / 16.0f));
            const float ang = (float)pos * inv; double rev = (double)ang * 0.15915494309189535; rev -= __builtin_floor(rev); const float r = (float)rev;
            tab[pos * 32 + k] = __builtin_amdgcn_cosf(r); tab[pos * 32 + 16 + k] = __builtin_amdgcn_sinf(r); }
    }
    LAS float* scr = (LAS float*)(lds + wave * 16384);
    constexpr int I_IN = (DM / 64) * (NPROJ / 32), I_SQ = (DM / 64) * (DM / 32), I_UP = (DM / 64) * (NUP / 32), I_DN = (DFF / 64) * (DM / 32), I_PLE = (PLE / 64) * (DM / 32);
    constexpr int NITEMS = I_IN + 4 * I_SQ + I_UP + I_DN + I_PLE;
    for (int it = gw; it < NITEMS; it += NGW) {
        int r = it;
        if (r < I_IN) { p0_transpose_item(KIN(5), DM, NPROJ, (bf16_t*)(ws + WS_WIN), scr, r, lane); continue; } r -= I_IN;
        if (r < I_SQ) { p0_transpose_item(KIN(11), DM, DM, (bf16_t*)(ws + WS_WA), scr, r, lane); continue; } r -= I_SQ;
        if (r < I_SQ) { p0_transpose_item(KIN(14), DM, DM, (bf16_t*)(ws + WS_WB), scr, r, lane); continue; } r -= I_SQ;
        if (r < I_SQ) { p0_transpose_item(KIN(15), DM, DM, (bf16_t*)(ws + WS_WOUT), scr, r, lane); continue; } r -= I_SQ;
        if (r < I_SQ) { p0_transpose_item(KIN(23), DM, DM, (bf16_t*)(ws + WS_WPG), scr, r, lane); continue; } r -= I_SQ;
        if (r < I_UP) { p0_transpose_item(KIN(17), DM, NUP, (bf16_t*)(ws + WS_WUP), scr, r, lane); continue; } r -= I_UP;
        if (r < I_DN) { p0_transpose_item(KIN(20), DFF, DM, (bf16_t*)(ws + WS_WDN), scr, r, lane); continue; } r -= I_DN;
        p0_transpose_item(KIN(21), PLE, DM, (bf16_t*)(ws + WS_WPLE), scr, r, lane);
    }
}

__device__ __forceinline__ void phase_prep(const Ctx& F, const float* x, const float* p) {
    int tid_ = F.wave_s * 64 + lane_id_v(); asm volatile("" : "+v"(tid_)); const int tid = tid_, lane = tid & 63, wave = F.wave_s, gw = F.vcu * NWAVES + wave, NGW = F.G * NWAVES; (void)lane; (void)gw; (void)NGW;
    unsigned char* const ws = KWS(); (void)ws;
    const float* g = KIN(4);
    bf16_t* XN = (bf16_t*)(ws + WS_XN); bf16_t* PB = (bf16_t*)(ws + WS_PB);
    f32x4 gv[4];
#pragma unroll
    for (int j = 0; j < 4; ++j) gv[j] = ((const f32x4*)g)[lane + 64 * j];
    for (int m = gw; m < MC; m += NGW) {
        const f32x4* xr = (const f32x4*)(x + (size_t)m * DM) + lane;
        f32x4 v[4]; float s = 0.f;
#pragma unroll
        for (int j = 0; j < 4; ++j) { v[j] = xr[64 * j]; s += (v[j].x * v[j].x + v[j].y * v[j].y) + (v[j].z * v[j].z + v[j].w * v[j].w); }
        const f32x4 pv = ((const f32x4*)(p + (size_t)m * PLE))[lane];
        const float rstd = __builtin_amdgcn_rsqf(wave_sum(s, lane) * (1.f / DM) + EPS);
        v2u* o8 = (v2u*)(XN + (size_t)m * DM) + lane;
#pragma unroll
        for (int j = 0; j < 4; ++j) { const f32x4 y = v[j] * rstd * gv[j]; v2u w; w.x = pk2(y.x, y.y); w.y = pk2(y.z, y.w); o8[64 * j] = w; }
        { v2u w; w.x = pk2(pv.x, pv.y); w.y = pk2(pv.z, pv.w); ((v2u*)(PB + (size_t)m * PLE))[lane] = w; }
    }
}

__device__ __forceinline__ void phase_rope(const Ctx& F) {
    int tid_ = F.wave_s * 64 + lane_id_v(); asm volatile("" : "+v"(tid_)); const int tid = tid_, lane = tid & 63, wave = F.wave_s, gw = F.vcu * NWAVES + wave, NGW = F.G * NWAVES; (void)lane; (void)gw; (void)NGW;
    unsigned char* const ws = KWS(); (void)ws;
    bf16_t* PROJ = (bf16_t*)(ws + WS_PROJ);
    const float* tabA = (const float*)(ws + WS_TABA); const float* tabX = (const float*)(ws + WS_TABX);
    const int q4 = lane & 3;
    float gq[16], gk[16];
#pragma unroll
    for (int k = 0; k < 16; ++k) { gq[k] = KIN(12)[q4 * 16 + k]; gk[k] = KIN(13)[q4 * 16 + k]; }
    for (int m = gw; m < MC; m += NGW) {
        const int t = m & (SEQ - 1);
        bf16_t* row = PROJ + (size_t)m * NPROJ;
        float c8[8], s8[8];
        { const f32x4* tp = (const f32x4*)(tabA + t * 16); const f32x4 a = tp[0], b = tp[1], c = tp[2], d = tp[3];
          c8[0] = a.x; c8[1] = a.y; c8[2] = a.z; c8[3] = a.w; c8[4] = b.x; c8[5] = b.y; c8[6] = b.z; c8[7] = b.w;
          s8[0] = c.x; s8[1] = c.y; s8[2] = c.z; s8[3] = c.w; s8[4] = d.x; s8[5] = d.y; s8[6] = d.z; s8[7] = d.w; }
        {
            v4u* pp = (v4u*)(row + C_AQ + lane * 16); v4u a = pp[0], b = pp[1]; float x[16]; unpack16(a, b, x);
            if (q4 == 0) {
#pragma unroll
                for (int i = 0; i < 8; ++i) { const float x1 = x[i], x2 = x[8 + i]; x[i] = x1 * c8[i] - x2 * s8[i]; x[8 + i] = x2 * c8[i] + x1 * s8[i]; } }
#pragma unroll
            for (int i = 0; i < 16; ++i) x[i] *= QSCALE;
            pack16(x, a, b); pp[0] = a; pp[1] = b;
        }
        if (q4 == 0) {
            v4u* pp = (v4u*)(row + C_AK + lane * 16); v4u a = pp[0], b = pp[1]; float x[16]; unpack16(a, b, x);
#pragma unroll
            for (int i = 0; i < 8; ++i) { const float x1 = x[i], x2 = x[8 + i]; x[i] = x1 * c8[i] - x2 * s8[i]; x[8 + i] = x2 * c8[i] + x1 * s8[i]; }
            pack16(x, a, b); pp[0] = a; pp[1] = b;
        }
        float cx[16], sx[16];
        { const int pos = (q4 < 2) ? (t >> 6) : (t & 63); const f32x4* tp = (const f32x4*)(tabX + pos * 32);
#pragma unroll
          for (int j = 0; j < 4; ++j) { const f32x4 a = tp[j], b = tp[4 + j]; cx[4 * j] = a.x; cx[4 * j + 1] = a.y; cx[4 * j + 2] = a.z; cx[4 * j + 3] = a.w; sx[4 * j] = b.x; sx[4 * j + 1] = b.y; sx[4 * j + 2] = b.z; sx[4 * j + 3] = b.w; } }
        const float sgn = (q4 & 1) ? 1.f : -1.f;
        {
            v4u* pp = (v4u*)(row + C_BQ + lane * 16); v4u a = pp[0], b = pp[1]; float x[16]; unpack16(a, b, x);
            float s = 0.f;
#pragma unroll
            for (int i = 0; i < 16; ++i) s += x[i] * x[i];
            s += shx(s, lane, 1); s += shx(s, lane, 2);
            const float r = __builtin_amdgcn_rsqf(s * (1.f / 64.f) + EPS);
#pragma unroll
            for (int i = 0; i < 16; ++i) x[i] = x[i] * r * gq[i];
#pragma unroll
            for (int i = 0; i < 16; ++i) { const float o = shx(x[i], lane, 1); x[i] = (x[i] * cx[i] + sgn * o * sx[i]) * QSCALE; }
            pack16(x, a, b); pp[0] = a; pp[1] = b;
        }
        {
            v4u* pp = (v4u*)(row + C_BK + (lane & 15) * 16); v4u a = pp[0], b = pp[1]; float x[16]; unpack16(a, b, x);
            float s = 0.f;
#pragma unroll
            for (int i = 0; i < 16; ++i) s += x[i] * x[i];
            s += shx(s, lane, 1); s += shx(s, lane, 2);
            const float r = __builtin_amdgcn_rsqf(s * (1.f / 64.f) + EPS);
#pragma unroll
            for (int i = 0; i < 16; ++i) x[i] = x[i] * r * gk[i];
#pragma unroll
            for (int i = 0; i < 16; ++i) { const float o = shx(x[i], lane, 1); x[i] = x[i] * cx[i] + sgn * o * sx[i]; }
            asm volatile("" ::: "memory");
            if (lane < 16) { pack16(x, a, b); pp[0] = a; pp[1] = b; }
        }
    }
}

__device__ __forceinline__ void phase_attn(const Ctx& F, char* lds) {
    int tid_ = F.wave_s * 64 + lane_id_v(); asm volatile("" : "+v"(tid_)); const int tid = tid_, lane = tid & 63, wave = F.wave_s, gw = F.vcu * NWAVES + wave, NGW = F.G * NWAVES; (void)lane; (void)gw; (void)NGW;
    unsigned char* const ws = KWS(); (void)ws;
    using abf = attn_body::bf16;
    abf* PROJ = (abf*)(ws + WS_PROJ); abf* OA1 = (abf*)(ws + WS_OA1); abf* OA2 = (abf*)(ws + WS_OA2); abf* OB = (abf*)(ws + WS_OB);
    for (int i = 0;; ++i) {
        const int L = i * F.G + F.vcu; if (L >= 3072) break;
        const int sr = L >> 10, i4 = (L >> 8) & 3, v = L & 255, g = v >> 3, s = v & 7;
        const int qd = sr * 8 + (g >> 2), mem = g & 3, qb = i4 * 8 + s;
        const abf *Qh, *Kh, *Vh; abf* Oh; int po;
        if (qd < 8) { const int b = qd >> 2, kvh = qd & 3, qh = kvh * 4 + mem; const size_t r0 = (size_t)b * SEQ;
            Qh = PROJ + r0 * NPROJ + C_BQ + qh * 64; Kh = PROJ + r0 * NPROJ + C_BK + kvh * 64; Vh = PROJ + r0 * NPROJ + C_BV + kvh * 64; Oh = OB + r0 * DM + qh * 64; po = DM;
        } else { const int d = qd - 8, b = d >> 3, h = d & 7, j = mem >> 1, e = mem & 1; const size_t r0 = (size_t)b * SEQ;
            Qh = PROJ + r0 * NPROJ + C_AQ + h * 128 + j * 64; Kh = PROJ + r0 * NPROJ + C_AK + h * 128 + j * 64; Vh = PROJ + r0 * NPROJ + C_AV + h * 128 + e * 64;
            Oh = (j ? OA2 : OA1) + r0 * DM + h * 128 + e * 64; po = DM; }
        attn_body::attn_unit<8>(qb, Qh, Kh, Vh, Oh, NPROJ, NPROJ, NPROJ, po, lds, F.wave_s);
    }
}

__device__ __forceinline__ void phase_diffnorm(const Ctx& F) {
    int tid_ = F.wave_s * 64 + lane_id_v(); asm volatile("" : "+v"(tid_)); const int tid = tid_, lane = tid & 63, wave = F.wave_s, gw = F.vcu * NWAVES + wave, NGW = F.G * NWAVES; (void)lane; (void)gw; (void)NGW;
    unsigned char* const ws = KWS(); (void)ws;
    bf16_t* OA1 = (bf16_t*)(ws + WS_OA1); const bf16_t* OA2 = (const bf16_t*)(ws + WS_OA2);
    const float s1 = wave_sum(KIN(6)[lane] * KIN(7)[lane], lane), s2 = wave_sum(KIN(8)[lane] * KIN(9)[lane], lane);
    const float lam = __expf(s1) - __expf(s2) + 0.2f;
    float gd[16];
#pragma unroll
    for (int k = 0; k < 16; ++k) gd[k] = KIN(10)[(lane & 7) * 16 + k] * 0.8f;
    for (int m = gw; m < MC; m += NGW) {
        v4u* pp = (v4u*)(OA1 + (size_t)m * DM + lane * 16); const v4u* p2 = (const v4u*)(OA2 + (size_t)m * DM + lane * 16);
        v4u a = pp[0], b = pp[1]; const v4u c = p2[0], d = p2[1]; float x[16], y[16]; unpack16(a, b, x); unpack16(c, d, y);
        float s = 0.f;
#pragma unroll
        for (int i = 0; i < 16; ++i) { x[i] = x[i] - lam * y[i]; s += x[i] * x[i]; }
        s += shx(s, lane, 1); s += shx(s, lane, 2); s += shx(s, lane, 4);
        const float r = __builtin_amdgcn_rsqf(s * (1.f / 128.f) + EPS);
#pragma unroll
        for (int i = 0; i < 16; ++i) x[i] = x[i] * r * gd[i];
        pack16(x, a, b); pp[0] = a; pp[1] = b;
    }
}

__device__ __forceinline__ float gelu_tanh(float x) { const float u = x + 0.044715f * x * x * x; return x * __builtin_amdgcn_rcpf(1.0f + __builtin_amdgcn_exp2f(-2.302208198f * u)); }
__device__ __forceinline__ void ld8(const bf16_t* p, float (&x)[8]) { const v4u a = *(const v4u*)p; x[0] = pg8::bf_lo(a.x); x[1] = pg8::bf_hi(a.x); x[2] = pg8::bf_lo(a.y); x[3] = pg8::bf_hi(a.y); x[4] = pg8::bf_lo(a.z); x[5] = pg8::bf_hi(a.z); x[6] = pg8::bf_lo(a.w); x[7] = pg8::bf_hi(a.w); }
__device__ __forceinline__ void phase_conv(const Ctx& F) {
    int tid_ = F.wave_s * 64 + lane_id_v(); asm volatile("" : "+v"(tid_)); const int tid = tid_, lane = tid & 63, wave = F.wave_s, gw = F.vcu * NWAVES + wave, NGW = F.G * NWAVES; (void)lane; (void)gw; (void)NGW;
    unsigned char* const ws = KWS(); (void)ws;
    const bf16_t* U = (const bf16_t*)(ws + WS_U); bf16_t* ACT = (bf16_t*)(ws + WS_ACT);
    const float* cw = KIN(18); const float* cb = KIN(19);
    const int gt = F.vcu * (NWAVES * 64) + tid, NGT = F.G * NWAVES * 64;
    constexpr int NCG = DFF / 8, RUN = 16, NITEM = (MC / RUN) * NCG;
    for (int it = gt; it < NITEM; it += NGT) {
        const int cgi = it % NCG, run = it / NCG, ch0 = cgi * 8, t0 = run * RUN;
        float wg[3][8], wv[3][8], bg[8], bv[8];
#pragma unroll
        for (int k = 0; k < 3; ++k) { const f32x4 a = *(const f32x4*)(cw + k * NUP + ch0), b = *(const f32x4*)(cw + k * NUP + ch0 + 4), c = *(const f32x4*)(cw + k * NUP + DFF + ch0), d = *(const f32x4*)(cw + k * NUP + DFF + ch0 + 4);
            wg[k][0] = a.x; wg[k][1] = a.y; wg[k][2] = a.z; wg[k][3] = a.w; wg[k][4] = b.x; wg[k][5] = b.y; wg[k][6] = b.z; wg[k][7] = b.w;
            wv[k][0] = c.x; wv[k][1] = c.y; wv[k][2] = c.z; wv[k][3] = c.w; wv[k][4] = d.x; wv[k][5] = d.y; wv[k][6] = d.z; wv[k][7] = d.w; }
        { const f32x4 a = *(const f32x4*)(cb + ch0), b = *(const f32x4*)(cb + ch0 + 4), c = *(const f32x4*)(cb + DFF + ch0), d = *(const f32x4*)(cb + DFF + ch0 + 4);
          bg[0] = a.x; bg[1] = a.y; bg[2] = a.z; bg[3] = a.w; bg[4] = b.x; bg[5] = b.y; bg[6] = b.z; bg[7] = b.w; bv[0] = c.x; bv[1] = c.y; bv[2] = c.z; bv[3] = c.w; bv[4] = d.x; bv[5] = d.y; bv[6] = d.z; bv[7] = d.w; }
        float pg_[8], pv_[8], cg_[8], cv_[8], ng_[8], nv_[8];
        const bf16_t* up = U + (size_t)t0 * NUP + ch0;
        if ((t0 & (SEQ - 1)) == 0) {
#pragma unroll
            for (int k = 0; k < 8; ++k) { pg_[k] = 0.f; pv_[k] = 0.f; }
        } else { ld8(up - NUP, pg_); ld8(up - NUP + DFF, pv_); }
        ld8(up, cg_); ld8(up + DFF, cv_);
#pragma unroll 4
        for (int i = 0; i < RUN; ++i) {
            const int t = t0 + i;
            if ((t & (SEQ - 1)) == SEQ - 1) {
#pragma unroll
                for (int k = 0; k < 8; ++k) { ng_[k] = 0.f; nv_[k] = 0.f; }
            } else { ld8(up + (size_t)(i + 1) * NUP, ng_); ld8(up + (size_t)(i + 1) * NUP + DFF, nv_); }
            float o[8];
#pragma unroll
            for (int k = 0; k < 8; ++k) { const float ug = pg_[k] * wg[0][k] + cg_[k] * wg[1][k] + ng_[k] * wg[2][k] + bg[k]; const float uv = pv_[k] * wv[0][k] + cv_[k] * wv[1][k] + nv_[k] * wv[2][k] + bv[k]; o[k] = gelu_tanh(ug) * uv; }
            v4u w; w.x = pk2(o[0], o[1]); w.y = pk2(o[2], o[3]); w.z = pk2(o[4], o[5]); w.w = pk2(o[6], o[7]);
            *(v4u*)(ACT + (size_t)t * DFF + ch0) = w;
#pragma unroll
            for (int k = 0; k < 8; ++k) { pg_[k] = cg_[k]; pv_[k] = cv_[k]; cg_[k] = ng_[k]; cv_[k] = nv_[k]; }
        }
    }
}

__device__ __forceinline__ void phase_final(const Ctx& F, float* out, const float* ss3) {
    int tid_ = F.wave_s * 64 + lane_id_v(); asm volatile("" : "+v"(tid_)); const int tid = tid_, lane = tid & 63, wave = F.wave_s, gw = F.vcu * NWAVES + wave, NGW = F.G * NWAVES; (void)lane; (void)gw; (void)NGW;
    unsigned char* const ws = KWS(); (void)ws;
    const float* g = KIN(24);
    f32x4 gv[4];
#pragma unroll
    for (int j = 0; j < 4; ++j) gv[j] = ((const f32x4*)g)[lane + 64 * j];
    for (int m = gw; m < MC; m += NGW) {
        f32x4* xr = (f32x4*)(out + (size_t)m * DM) + lane;
        const float r = __builtin_amdgcn_rsqf(ss3[m] * (1.f / DM) + EPS);
#pragma unroll
        for (int j = 0; j < 4; ++j) xr[64 * j] = xr[64 * j] * r * gv[j];
    }
}

struct Args { const float* in[25]; float* out; unsigned char* ws; };

template <int c> __device__ __forceinline__ void run_chunk(const Ctx& F, unsigned char* lds, const XcdBarrier& gbar) {
    LAS unsigned char* L = (LAS unsigned char*)lds;
    const int bid = (int)blockIdx.x;
#define WSP(T, off) ((T*)(ws + (off)))
#define XC() ((c == 0) ? KIN(0) : KIN(1) + (size_t)(c - 1) * MC * DM)
#define OUTC() (KOUT() + (size_t)c * MC * DM)
#define SSP(k) ((float*)(ws + WS_SS) + (size_t)(c * 3 + (k)) * MC)
#ifndef SKIP_GB
        {
            unsigned char* const ws = KWS(); pg8::Gemm g{WSP(bf16_t, WS_XN), (const bf16_t*)(ws + WS_WIN), MC, NPROJ, DM}; pg8::StaticOrder S; S.init(MC, NPROJ, F.G, bid);
            pg8::EpiProj E{WSP(bf16_t, WS_PROJ), NPROJ, C_GA / 256};
            pg8::gemm_phase<pg8::EpiProj, pg8::StaticOrder, PG8_ALIGN, PG8_SP2>(L, g, S, E, F.wave_s);
        }
#endif
        xcd_barrier(gbar);
#ifndef SKIP_EW
        phase_rope(F);
#endif
        xcd_barrier(gbar);
#ifndef SKIP_ATTN
        phase_attn(F, (char*)lds);
#endif
        xcd_barrier(gbar);
#ifndef SKIP_EW
        phase_diffnorm(F);
#endif
        xcd_barrier(gbar);
#ifndef SKIP_GF
        {
            unsigned char* const ws = KWS(); pg8::Gemm g{WSP(bf16_t, WS_OA1), (const bf16_t*)(ws + WS_WA), MC, DM, DM}; pg8::StaticOrder S; S.init(MC, DM, F.G, bid);
            pg8::EpiT1 E{WSP(bf16_t, WS_PROJ) + C_GA, NPROJ, OUTC(), DM};
            pg8::gemm_phase<pg8::EpiT1, pg8::StaticOrder, PG8_ALIGN, PG8_SP2>(L, g, S, E, F.wave_s);
        }
#endif
        xcd_barrier(gbar);
#ifndef SKIP_GG
        {
            unsigned char* const ws = KWS(); pg8::Gemm g{WSP(bf16_t, WS_OB), (const bf16_t*)(ws + WS_WB), MC, DM, DM}; pg8::StaticOrder S; S.init(MC, DM, F.G, bid);
            pg8::EpiMerge E{WSP(bf16_t, WS_PROJ) + C_GB, NPROJ, OUTC(), DM, WSP(bf16_t, WS_MG), DM};
            pg8::gemm_phase<pg8::EpiMerge, pg8::StaticOrder, PG8_ALIGN, PG8_SP2>(L, g, S, E, F.wave_s);
        }
#endif
        xcd_barrier(gbar);
#ifndef SKIP_GH
        {
            unsigned char* const ws = KWS(); pg8::Gemm g{WSP(bf16_t, WS_MG), (const bf16_t*)(ws + WS_WOUT), MC, DM, DM}; pg8::StaticOrder S; S.init(MC, DM, F.G, bid);
            pg8::EpiResid<false, true> E{XC(), OUTC(), nullptr, WSP(bf16_t, WS_XN), KIN(16), SSP(0), DM};
            pg8::gemm_phase<pg8::EpiResid<false, true>, pg8::StaticOrder, PG8_ALIGN, PG8_SP2>(L, g, S, E, F.wave_s);
        }
#endif
        xcd_barrier(gbar);
#ifndef SKIP_GI
        {
            unsigned char* const ws = KWS(); pg8::Gemm g{WSP(bf16_t, WS_XN), (const bf16_t*)(ws + WS_WUP), MC, NUP, DM}; pg8::StaticOrder S; S.init(MC, NUP, F.G, bid);
            pg8::EpiScale<false> E{SSP(0), 1.f / DM, EPS, WSP(bf16_t, WS_U), nullptr, NUP};
            pg8::gemm_phase<pg8::EpiScale<false>, pg8::StaticOrder, PG8_ALIGN, PG8_SP2>(L, g, S, E, F.wave_s);
        }
#endif
        xcd_barrier(gbar);
#ifndef SKIP_CONV
        phase_conv(F);
#endif
        xcd_barrier(gbar);
#ifndef SKIP_GK
        {
            unsigned char* const ws = KWS(); pg8::Gemm g{WSP(bf16_t, WS_ACT), (const bf16_t*)(ws + WS_WDN), MC, DM, DFF}; pg8::StaticOrder S; S.init(MC, DM, F.G, bid);
            float* const oc = OUTC(); pg8::EpiResid<false, true> E{oc, oc, nullptr, WSP(bf16_t, WS_XN), KIN(22), SSP(1), DM};
            pg8::gemm_phase<pg8::EpiResid<false, true>, pg8::StaticOrder, PG8_ALIGN, PG8_SP2>(L, g, S, E, F.wave_s);
        }
#endif
        xcd_barrier(gbar);
#ifndef SKIP_GL
        {
            unsigned char* const ws = KWS(); pg8::Gemm g{WSP(bf16_t, WS_XN), (const bf16_t*)(ws + WS_WPG), MC, DM, DM}; pg8::StaticOrder S; S.init(MC, DM, F.G, bid);
            pg8::EpiScale<true> E{SSP(1), 1.f / DM, EPS, nullptr, WSP(float, WS_SG), DM};
            pg8::gemm_phase<pg8::EpiScale<true>, pg8::StaticOrder, PG8_ALIGN, PG8_SP2>(L, g, S, E, F.wave_s);
        }
#endif
        xcd_barrier(gbar);
#ifndef SKIP_GM
        {
            unsigned char* const ws = KWS(); pg8::Gemm g{WSP(bf16_t, WS_PB), (const bf16_t*)(ws + WS_WPLE), MC, DM, PLE}; pg8::StaticOrder S; S.init(MC, DM, F.G, bid);
            float* const oc = OUTC(); pg8::EpiResid<true, false> E{oc, oc, WSP(float, WS_SG), nullptr, nullptr, SSP(2), DM};
            pg8::gemm_phase<pg8::EpiResid<true, false>, pg8::StaticOrder, PG8_ALIGN, PG8_SP2>(L, g, S, E, F.wave_s);
        }
#endif
        xcd_barrier(gbar);
#ifndef SKIP_EW
        { unsigned char* const ws = KWS(); phase_final(F, OUTC(), SSP(2)); }
#endif
        if (c + 1 < NCHUNK) { phase_prep(F, KIN(1) + (size_t)c * MC * DM, KIN(3) + (size_t)c * MC * PLE); xcd_barrier(gbar); }
}

__global__ void __launch_bounds__(NWAVES * 64, 2) mk_fwd(Args args) {
    extern __shared__ __attribute__((aligned(16))) unsigned char lds[];
    cg::grid_group grid = cg::this_grid();
    Ctx F;
    F.wave_s = __builtin_amdgcn_readfirstlane((int)threadIdx.x >> 6);
    if (threadIdx.x < 32) ((volatile LAS unsigned*)((LAS unsigned char*)lds + MISC_OFF))[threadIdx.x] = 0u;
    __syncthreads();
    const XcdBarrier gbar = xcd_barrier_post((unsigned*)(KWS() + WS_BAR), (volatile LAS unsigned*)((LAS unsigned char*)lds + MISC_OFF) + 8, threadIdx.x == 0);
    F.G = gridDim.x; { const int bx = blockIdx.x; F.vcu = (F.G % 8 == 0) ? (bx % 8) * (F.G / 8) + bx / 8 : bx; }
    (void)args;
    LAS unsigned char* L = (LAS unsigned char*)lds;
#ifndef SKIP_EW
    phase_prologue(F, L);
    phase_prep(F, KIN(0), KIN(2));
#endif
    grid.sync();
    run_chunk<0>(F, lds, gbar);
#ifndef ONE_CHUNK
    run_chunk<1>(F, lds, gbar);
    run_chunk<2>(F, lds, gbar);
#endif
}

extern "C" void kernel_launch(void* const* d_in, const int* in_sizes, int n_in, void* d_out, int out_size, void* d_ws, size_t ws_size, hipStream_t stream) {
    static int grid = 0;
    if (grid == 0) {
        if (n_in != 25 || ws_size < WS_END) { fprintf(stderr, "kernel_launch: unexpected inputs (n_in %d, ws %zu)\n", n_in, ws_size); grid = -1; return; }
        int dev = 0, cus = 0, per_cu = 0;
        hipGetDevice(&dev); hipDeviceGetAttribute(&cus, hipDeviceAttributeMultiprocessorCount, dev);
        hipFuncSetAttribute((const void*)mk_fwd, hipFuncAttributeMaxDynamicSharedMemorySize, LDS_BYTES);
        hipOccupancyMaxActiveBlocksPerMultiprocessor(&per_cu, (const void*)mk_fwd, NWAVES * 64, LDS_BYTES);
        (void)hipGetLastError();
        if (per_cu < 1) per_cu = 1;
        grid = cus;
    }
    if (grid < 0) return;
    if (hipMemsetAsync((char*)d_ws + WS_BAR, 0, 16384, stream) != hipSuccess) { fprintf(stderr, "kernel_launch: memset failed\n"); return; }
    Args a{};
    for (int i = 0; i < 25; ++i) a.in[i] = (const float*)d_in[i];
    a.out = (float*)d_out; a.ws = (unsigned char*)d_ws;
    void* kargs[] = {&a};
    hipError_t e = hipLaunchCooperativeKernel((const void*)mk_fwd, dim3(grid), dim3(NWAVES * 64), kargs, LDS_BYTES, stream);
    if (e != hipSuccess) fprintf(stderr, "cooperative launch failed: %s (grid %d)\n", hipGetErrorString(e), grid);
}
```

```cpp
#include <hip/hip_runtime.h>
#include <hip/hip_cooperative_groups.h>
#include <cstdio>
#include <cstdint>
__device__ __forceinline__ int lane_id_v() { int l; asm volatile("v_mbcnt_lo_u32_b32 %0, -1, 0\n\tv_mbcnt_hi_u32_b32 %0, -1, %0" : "=v"(l)); return l; }
__device__ __forceinline__ float shx(float v, int lane, int m) { return __int_as_float(__builtin_amdgcn_ds_bpermute((lane ^ m) << 2, __float_as_int(v))); }
namespace pg8 {
#define PG8_LAS __attribute__((address_space(3)))
typedef unsigned short bf16_t;
typedef short bf16x8 __attribute__((ext_vector_type(8)));
typedef float f32x4 __attribute__((ext_vector_type(4)));
typedef unsigned u32x4 __attribute__((ext_vector_type(4)));
constexpr int BM = 256, BK = 64, HALF = 128, HTB = HALF * BK * 2  , STAGE_BYTES = 8 * HTB, NXCD = 8, WGM = 8;

__host__ __device__ __forceinline__ int lds_byte(int r, int c) { const int st = (r >> 4) * 2 + (c >> 5), rr = r & 15, cc = c & 31, ob = rr * 64 + cc * 2; return st * 1024 + (ob ^ (((ob >> 9) & 1) << 5)); }
__host__ __device__ __forceinline__ void stage_rc(int b, int& R, int& C) { const int st = b / 1024, sb = b % 1024, swz = sb ^ (((sb >> 9) & 1) << 5); R = (st >> 1) * 16 + swz / 64; C = (st & 1) * 32 + (swz % 64) / 2; }
__host__ __device__ __forceinline__ int perm32(int rho) { const int n = rho >> 4, i = rho & 15; return 8 * (i >> 2) + 4 * n + (i & 3); }

struct Unit { int pm, pn; };
struct Gemm { const bf16_t* A; const bf16_t* Bt; int M, N, K; };

struct StaticOrder {
    int nM, nN, nwg, G, c;
    __host__ __device__ void init(int M, int N, int G_, int c_) { nM = M / BM; nN = N / BM; nwg = nM * nN; G = G_; c = c_; }
    __host__ __device__ bool next(int i, Unit& u) const {
        const long L = (long)i * G + c; if (L >= nwg) return false;
        int wgid = (int)L; { const int q = nwg / NXCD, r = nwg % NXCD, xcd = wgid % NXCD, off = wgid / NXCD; wgid = (xcd < r ? xcd * (q + 1) : r * (q + 1) + (xcd - r) * q) + off; }
        const int nig = WGM * nN, gid = wgid / nig, fm = gid * WGM, gsz = (nM - fm) < WGM ? (nM - fm) : WGM;
        u.pm = fm + ((wgid % nig) % gsz); u.pn = (wgid % nig) / gsz; return true;
    }
    __device__ __forceinline__ void a_ready(const Unit&) const {}
    __device__ __forceinline__ void done(const Unit&) const {}
};

__device__ __forceinline__ unsigned cvt_pk_bf16(float lo, float hi) { unsigned r; asm volatile("v_cvt_pk_bf16_f32 %0, %1, %2" : "=v"(r) : "v"(lo), "v"(hi)); return r; }
typedef float f32x2 __attribute__((ext_vector_type(2)));
__device__ __forceinline__ f32x2 gelu_pk(f32x2 v) {
    const f32x2 av = __builtin_elementwise_abs(v), d = av * 0.2316418882f + 1.0f;
    f32x2 t; t.x = __builtin_amdgcn_rcpf(d.x); t.y = __builtin_amdgcn_rcpf(d.y);
    f32x2 q = t * 0.5307027145f + (-0.7265760135f); q = q * t + 0.7107068705f; q = q * t + (-0.142248368f); q = q * t + 0.127414796f; q = q * t;
    const f32x2 s = (v * v) * (-0.72134752044f);
    f32x2 e; e.x = __builtin_amdgcn_exp2f(s.x); e.y = __builtin_amdgcn_exp2f(s.y);
    const f32x2 m = v * (q * e), r = v - m;
    f32x2 o; o.x = v.x < 0.f ? m.x : r.x; o.y = v.y < 0.f ? m.y : r.y; return o;
}

template <int ACT  > struct EpiBf16 {
    static constexpr bool PERM = true, AFTER_DRAIN = false; static_assert(ACT == 0 || ACT == 1, "EpiBf16: ACT is 0 (none) or 1 (gelu_pk)");
    bf16_t* O; int ldc; const float* bias; int split_cols; size_t split_stride; float scale0;
    __device__ __forceinline__ void operator()(const f32x4 (&acc)[2][2][4][2], const Unit& u, int wr, int wc, int fr, int fq) const {
        const int row0 = u.pm * BM + wr * 64 + fr; int colt = u.pn * BM; bf16_t* base = O;
        float sc = 1.f; if (split_cols) { const int t = colt / split_cols; base += (size_t)t * split_stride; colt -= t * split_cols; if (t == 0) sc = scale0; }
        const int col0 = colt + wc * 32 + 8 * fq, bcol0 = u.pn * BM + wc * 32 + 8 * fq;
        f32x4 bv[2][2];
#pragma unroll
        for (int bj = 0; bj < 2; ++bj)
#pragma unroll
            for (int n = 0; n < 2; ++n) bv[bj][n] = bias ? *(const f32x4*)(bias + bcol0 + bj * HALF + 4 * n) : (f32x4){0.f, 0.f, 0.f, 0.f};
#pragma unroll
        for (int ai = 0; ai < 2; ++ai)
#pragma unroll
            for (int m = 0; m < 4; ++m) { bf16_t* rowp = base + (size_t)(row0 + ai * HALF + m * 16) * ldc + col0;
#pragma unroll
                for (int bj = 0; bj < 2; ++bj) { f32x4 v0 = acc[ai][bj][m][0] + bv[bj][0], v1 = acc[ai][bj][m][1] + bv[bj][1];
                    if (ACT == 1) { f32x2 a = gelu_pk((f32x2){v0[0], v0[1]}), b = gelu_pk((f32x2){v0[2], v0[3]}), c = gelu_pk((f32x2){v1[0], v1[1]}), d = gelu_pk((f32x2){v1[2], v1[3]});
                        v0 = (f32x4){a.x, a.y, b.x, b.y}; v1 = (f32x4){c.x, c.y, d.x, d.y}; }
                    v0 = v0 * sc; v1 = v1 * sc; u32x4 w; w.x = cvt_pk_bf16(v0[0], v0[1]); w.y = cvt_pk_bf16(v0[2], v0[3]); w.z = cvt_pk_bf16(v1[0], v1[1]); w.w = cvt_pk_bf16(v1[2], v1[3]);
                    *(u32x4*)(rowp + bj * HALF) = w; } }
    }
};

__device__ __forceinline__ float sigm(float x) { return __builtin_amdgcn_rcpf(1.0f + __builtin_amdgcn_exp2f(-1.4426950408889634f * x)); }
__device__ __forceinline__ float bf_lo(unsigned w) { return __uint_as_float(w << 16); }
__device__ __forceinline__ float bf_hi(unsigned w) { return __uint_as_float(w & 0xffff0000u); }
__device__ __forceinline__ u32x4 pack8(const f32x4 v0, const f32x4 v1) { u32x4 w; w.x = cvt_pk_bf16(v0[0], v0[1]); w.y = cvt_pk_bf16(v0[2], v0[3]); w.z = cvt_pk_bf16(v1[0], v1[1]); w.w = cvt_pk_bf16(v1[2], v1[3]); return w; }
__device__ __forceinline__ void unpack8(const u32x4 g, f32x4& a, f32x4& b) { a = (f32x4){bf_lo(g.x), bf_hi(g.x), bf_lo(g.y), bf_hi(g.y)}; b = (f32x4){bf_lo(g.z), bf_hi(g.z), bf_lo(g.w), bf_hi(g.w)}; }

struct EpiProj {
    static constexpr bool PERM = true, AFTER_DRAIN = false;
    bf16_t* O; int ldc; int sig_pn;
    __device__ __forceinline__ void operator()(const f32x4 (&acc)[2][2][4][2], const Unit& u, int wr, int wc, int fr, int fq) const {
        const int row0 = u.pm * BM + wr * 64 + fr, col0 = u.pn * BM + wc * 32 + 8 * fq; const bool sg = u.pn >= sig_pn;
#pragma unroll
        for (int ai = 0; ai < 2; ++ai)
#pragma unroll
            for (int m = 0; m < 4; ++m) { bf16_t* rowp = O + (size_t)(row0 + ai * HALF + m * 16) * ldc + col0;
#pragma unroll
                for (int bj = 0; bj < 2; ++bj) { f32x4 v0 = acc[ai][bj][m][0], v1 = acc[ai][bj][m][1];
                    if (sg) {
#pragma unroll
                        for (int k = 0; k < 4; ++k) { v0[k] = sigm(v0[k]); v1[k] = sigm(v1[k]); } }
                    *(u32x4*)(rowp + bj * HALF) = pack8(v0, v1); } }
    }
};
struct EpiT1 {
    static constexpr bool PERM = true, AFTER_DRAIN = false;
    const bf16_t* G; int ldg; float* T; int ldt;
    __device__ __forceinline__ void operator()(const f32x4 (&acc)[2][2][4][2], const Unit& u, int wr, int wc, int fr, int fq) const {
        const int row0 = u.pm * BM + wr * 64 + fr, col0 = u.pn * BM + wc * 32 + 8 * fq;
#pragma unroll
        for (int ai = 0; ai < 2; ++ai)
#pragma unroll
            for (int m = 0; m < 4; ++m) { const size_t row = (size_t)(row0 + ai * HALF + m * 16);
#pragma unroll
                for (int bj = 0; bj < 2; ++bj) { const u32x4 g = *(const u32x4*)(G + row * ldg + col0 + bj * HALF); f32x4 g0, g1; unpack8(g, g0, g1);
                    float* tp = T + row * ldt + col0 + bj * HALF; *(f32x4*)tp = acc[ai][bj][m][0] * g0; *(f32x4*)(tp + 4) = acc[ai][bj][m][1] * g1; } }
    }
};
struct EpiMerge {
    static constexpr bool PERM = true, AFTER_DRAIN = false;
    const bf16_t* G; int ldg; const float* T; int ldt; bf16_t* O; int ldo;
    __device__ __forceinline__ void operator()(const f32x4 (&acc)[2][2][4][2], const Unit& u, int wr, int wc, int fr, int fq) const {
        const int row0 = u.pm * BM + wr * 64 + fr, col0 = u.pn * BM + wc * 32 + 8 * fq;
#pragma unroll
        for (int ai = 0; ai < 2; ++ai)
#pragma unroll
            for (int m = 0; m < 4; ++m) { const size_t row = (size_t)(row0 + ai * HALF + m * 16);
#pragma unroll
                for (int bj = 0; bj < 2; ++bj) { const u32x4 g = *(const u32x4*)(G + row * ldg + col0 + bj * HALF); f32x4 g0, g1; unpack8(g, g0, g1);
                    const float* tp = T + row * ldt + col0 + bj * HALF; const f32x4 t0 = *(const f32x4*)tp, t1 = *(const f32x4*)(tp + 4);
                    *(u32x4*)(O + row * ldo + col0 + bj * HALF) = pack8(t0 + acc[ai][bj][m][0] * g0, t1 + acc[ai][bj][m][1] * g1); } }
    }
};
template <bool MUL, bool XN> struct EpiResid {
    static constexpr bool PERM = true, AFTER_DRAIN = false;
    const float* base; float* out; const float* mul; bf16_t* xn; const float* gain; float* ss; int ld;
    __device__ __forceinline__ void operator()(const f32x4 (&acc)[2][2][4][2], const Unit& u, int wr, int wc, int fr, int fq) const {
        const int row0 = u.pm * BM + wr * 64 + fr, col0 = u.pn * BM + wc * 32 + 8 * fq;
        f32x4 gv[2][2];
#pragma unroll
        for (int bj = 0; bj < 2; ++bj) { if (XN) { gv[bj][0] = *(const f32x4*)(gain + col0 + bj * HALF); gv[bj][1] = *(const f32x4*)(gain + col0 + bj * HALF + 4); } else { gv[bj][0] = (f32x4){0.f, 0.f, 0.f, 0.f}; gv[bj][1] = gv[bj][0]; } }
#pragma unroll
        for (int ai = 0; ai < 2; ++ai)
#pragma unroll
            for (int m = 0; m < 4; ++m) { const size_t row = (size_t)(row0 + ai * HALF + m * 16); float s = 0.f;
#pragma unroll
                for (int bj = 0; bj < 2; ++bj) { const size_t p = row * ld + col0 + bj * HALF;
                    f32x4 v0 = acc[ai][bj][m][0], v1 = acc[ai][bj][m][1];
                    if (MUL) { v0 = v0 * *(const f32x4*)(mul + p); v1 = v1 * *(const f32x4*)(mul + p + 4); }
                    v0 = v0 + *(const f32x4*)(base + p); v1 = v1 + *(const f32x4*)(base + p + 4);
                    *(f32x4*)(out + p) = v0; *(f32x4*)(out + p + 4) = v1;
                    s += (v0[0] * v0[0] + v0[1] * v0[1]) + (v0[2] * v0[2] + v0[3] * v0[3]) + (v1[0] * v1[0] + v1[1] * v1[1]) + (v1[2] * v1[2] + v1[3] * v1[3]);
                    if (XN) *(u32x4*)(xn + p) = pack8(v0 * gv[bj][0], v1 * gv[bj][1]); }
                { const int ln = fr + 16 * fq; s += shx(s, ln, 16); s += shx(s, ln, 32); }
                if (fq == 0) __hip_atomic_fetch_add(ss + row, s, __ATOMIC_RELAXED, __HIP_MEMORY_SCOPE_AGENT);
                asm volatile("" ::: "memory"); }
    }
};
template <bool SIG> struct EpiScale {
    static constexpr bool PERM = true, AFTER_DRAIN = false;
    const float* ss; float inv_n, eps; bf16_t* O; float* F; int ldc;
    __device__ __forceinline__ void operator()(const f32x4 (&acc)[2][2][4][2], const Unit& u, int wr, int wc, int fr, int fq) const {
        const int row0 = u.pm * BM + wr * 64 + fr, col0 = u.pn * BM + wc * 32 + 8 * fq;
#pragma unroll
        for (int ai = 0; ai < 2; ++ai)
#pragma unroll
            for (int m = 0; m < 4; ++m) { const size_t row = (size_t)(row0 + ai * HALF + m * 16); const float r = __builtin_amdgcn_rsqf(ss[row] * inv_n + eps);
#pragma unroll
                for (int bj = 0; bj < 2; ++bj) { f32x4 v0 = acc[ai][bj][m][0] * r, v1 = acc[ai][bj][m][1] * r; const size_t p = row * ldc + col0 + bj * HALF;
                    if (SIG) {
#pragma unroll
                        for (int k = 0; k < 4; ++k) { v0[k] = sigm(v0[k]); v1[k] = sigm(v1[k]); }
                        *(f32x4*)(F + p) = v0; *(f32x4*)(F + p + 4) = v1;
                    } else *(u32x4*)(O + p) = pack8(v0, v1); } }
    }
};

template <class Epi, class Sched, bool ALIGN_EPI = false, bool SP2 = false>
__device__ __forceinline__ void gemm_phase(PG8_LAS unsigned char* lds, const Gemm g, const Sched& S, const Epi& E, int wave_s) {
    int tid_ = wave_s * 64 + lane_id_v(); asm volatile("" : "+v"(tid_));
    const int tid = tid_, wid = __builtin_amdgcn_readfirstlane(tid >> 6), lane = tid & 63, wr = wid >> 2, wc = wid & 3, fr = lane & 15, fq = lane >> 4;
    const int K = g.K, nt = K / BK;
    unsigned voffA[2], voffB[2];
#pragma unroll
    for (int i = 0; i < 2; ++i) { int R, C; stage_rc(tid * 16 + i * 8192, R, C); const int Rb = Epi::PERM ? ((R & ~31) + perm32(R & 31)) : R;
        voffA[i] = (unsigned)(R * K + C) * 2u; voffB[i] = (unsigned)(Rb * K + C) * 2u; }
    const size_t kstep = (size_t)(BK * 2);
    const size_t hstep = (size_t)HALF * K * 2;
    const size_t tstep = 2 * hstep;
    const unsigned ldsw = (unsigned)wid * 1024u;
    const int aoff = lds_byte(wr * 64 + fr, fq * 8), boff = lds_byte(wc * 32 + fr, fq * 8);
#define PG8_SA(b, h) (((b) * 2 + (h)) * HTB)
#define PG8_SB(b, h) ((4 + (b) * 2 + (h)) * HTB)
#define PG8_STAGE(bufoff, gbase, voff) do { _Pragma("unroll") for (int _i = 0; _i < 2; ++_i) \
        __builtin_amdgcn_global_load_lds((const unsigned*)((const char*)(gbase) + (voff)[_i]), (PG8_LAS unsigned*)(lds + (bufoff) + ldsw + _i * 8192), 16, 0, 0); } while (0)
#define PG8_LDA(dst, b, h) do { _Pragma("unroll") for (int m = 0; m < 4; ++m) _Pragma("unroll") for (int k = 0; k < 2; ++k) dst[m][k] = *(const PG8_LAS bf16x8*)(lds + PG8_SA(b, h) + aoff + m * 2048 + k * 1024); } while (0)
#define PG8_LDB(dst, b, h) do { _Pragma("unroll") for (int n = 0; n < 2; ++n) _Pragma("unroll") for (int k = 0; k < 2; ++k) dst[n][k] = *(const PG8_LAS bf16x8*)(lds + PG8_SB(b, h) + boff + n * 2048 + k * 1024); } while (0)
#define PG8_MMA(ai, bj, At, Bt) do { __builtin_amdgcn_s_setprio(1); _Pragma("unroll") for (int m = 0; m < 4; ++m) _Pragma("unroll") for (int n = 0; n < 2; ++n) _Pragma("unroll") for (int k = 0; k < 2; ++k) \
        acc[ai][bj][m][n] = __builtin_amdgcn_mfma_f32_16x16x32_bf16(Bt[n][k], At[m][k], acc[ai][bj][m][n], 0, 0, 0); __builtin_amdgcn_s_setprio(0); } while (0)
#define PG8_WAIT_V(n) asm volatile("s_waitcnt vmcnt(" #n ")" ::: "memory")
#define PG8_WAIT_L(n) asm volatile("s_waitcnt lgkmcnt(" #n ")" ::: "memory")
#define PG8_BAR __builtin_amdgcn_s_barrier()
#define PG8_SCHED __builtin_amdgcn_sched_barrier(0)
    Unit cur, nxt; int ui = 0;
    if (!S.next(0, cur)) return;
    f32x4 acc[2][2][4][2];
#pragma unroll
    for (int a = 0; a < 2; ++a)
#pragma unroll
        for (int b = 0; b < 2; ++b)
#pragma unroll
            for (int m = 0; m < 4; ++m)
#pragma unroll
                for (int n = 0; n < 2; ++n) acc[a][b][m][n] = (f32x4){0.f, 0.f, 0.f, 0.f};
    bf16x8 At[4][2], B0[2][2], B1[2][2];
    const char* cA = (const char*)g.A + (size_t)cur.pm * tstep; const char* cB = (const char*)g.Bt + (size_t)cur.pn * tstep;
    S.a_ready(cur);
    if constexpr (SP2) {
        PG8_STAGE(PG8_SB(0, 0), cB, voffB); PG8_STAGE(PG8_SB(0, 1), cB + hstep, voffB); PG8_STAGE(PG8_SA(0, 0), cA, voffA); PG8_STAGE(PG8_SA(0, 1), cA + hstep, voffA);
        if (wr == 1) PG8_BAR;
        PG8_WAIT_V(2); PG8_BAR;
        PG8_STAGE(PG8_SB(1, 0), cB + kstep, voffB); PG8_STAGE(PG8_SA(1, 0), cA + kstep, voffA); PG8_STAGE(PG8_SB(1, 1), cB + hstep + kstep, voffB);
        PG8_WAIT_V(6); PG8_BAR;
    } else {
        PG8_STAGE(PG8_SB(0, 0), cB, voffB); PG8_STAGE(PG8_SA(0, 0), cA, voffA); PG8_STAGE(PG8_SB(0, 1), cB + hstep, voffB); PG8_STAGE(PG8_SA(0, 1), cA + hstep, voffA);
        if (wr == 1) PG8_BAR;
        PG8_WAIT_V(4); PG8_BAR;
        PG8_STAGE(PG8_SB(1, 0), cB + kstep, voffB); PG8_STAGE(PG8_SA(1, 0), cA + kstep, voffA); PG8_STAGE(PG8_SB(1, 1), cB + hstep + kstep, voffB);
        PG8_WAIT_V(6); PG8_BAR;
    }
    for (;;) {
        const bool has_next = S.next(ui + 1, nxt);
        const char* nA = has_next ? (const char*)g.A + (size_t)nxt.pm * tstep : cA; const char* nB = has_next ? (const char*)g.Bt + (size_t)nxt.pn * tstep : cB;
        for (int t = 0; t < nt; t += 2) {
            const bool last = (t == nt - 2);
            const char* a1 = cA + (size_t)(t + 1) * kstep;
            const char* a2 = last ? nA : cA + (size_t)(t + 2) * kstep; const char* b2 = last ? nB : cB + (size_t)(t + 2) * kstep;
            const char* a3 = a2 + kstep; const char* b3 = b2 + kstep;
            if (last && has_next) S.a_ready(nxt);
            if constexpr (SP2) {
            PG8_LDB(B0, 0, 0); PG8_LDB(B1, 0, 1); PG8_SCHED; PG8_LDA(At, 0, 0); PG8_STAGE(PG8_SA(1, 1), a1 + hstep, voffA);
            PG8_WAIT_V(8); PG8_WAIT_L(0); PG8_BAR; PG8_MMA(0, 0, At, B0); PG8_MMA(0, 1, At, B1); PG8_BAR; PG8_SCHED;
            PG8_LDA(At, 0, 1); PG8_STAGE(PG8_SB(0, 0), b2, voffB); PG8_STAGE(PG8_SB(0, 1), b2 + hstep, voffB); PG8_STAGE(PG8_SA(0, 0), a2, voffA);
            PG8_WAIT_V(8); PG8_WAIT_L(0); PG8_BAR; PG8_MMA(1, 0, At, B0); PG8_MMA(1, 1, At, B1); PG8_BAR; PG8_SCHED;
            PG8_LDB(B0, 1, 0); PG8_LDB(B1, 1, 1); PG8_SCHED; PG8_LDA(At, 1, 0); PG8_STAGE(PG8_SA(0, 1), a2 + hstep, voffA);
            PG8_WAIT_V(8); PG8_WAIT_L(0); PG8_BAR; PG8_MMA(0, 0, At, B0); PG8_MMA(0, 1, At, B1); PG8_BAR; PG8_SCHED;
            PG8_LDA(At, 1, 1); PG8_STAGE(PG8_SB(1, 0), b3, voffB); PG8_STAGE(PG8_SB(1, 1), b3 + hstep, voffB); PG8_STAGE(PG8_SA(1, 0), a3, voffA);
            PG8_WAIT_V(8); PG8_WAIT_L(0); PG8_BAR; PG8_MMA(1, 0, At, B0); PG8_MMA(1, 1, At, B1); PG8_BAR; PG8_SCHED;
            } else {
            PG8_LDB(B0, 0, 0); PG8_SCHED; PG8_LDA(At, 0, 0); PG8_STAGE(PG8_SA(1, 1), a1 + hstep, voffA);
            PG8_WAIT_L(8); PG8_BAR; PG8_WAIT_L(0); PG8_MMA(0, 0, At, B0); PG8_BAR; PG8_SCHED;
            PG8_LDB(B1, 0, 1); PG8_STAGE(PG8_SB(0, 0), b2, voffB);
            PG8_BAR; PG8_WAIT_L(0); PG8_MMA(0, 1, At, B1); PG8_BAR;
            PG8_LDA(At, 0, 1); PG8_STAGE(PG8_SA(0, 0), a2, voffA);
            PG8_BAR; PG8_WAIT_L(0); PG8_MMA(1, 0, At, B0); PG8_BAR; PG8_SCHED;
            PG8_STAGE(PG8_SB(0, 1), b2 + hstep, voffB);
            PG8_WAIT_V(6); PG8_BAR; PG8_MMA(1, 1, At, B1); PG8_BAR;
            PG8_LDB(B0, 1, 0); PG8_SCHED; PG8_LDA(At, 1, 0); PG8_STAGE(PG8_SA(0, 1), a2 + hstep, voffA);
            PG8_WAIT_L(8); PG8_BAR; PG8_WAIT_L(0); PG8_MMA(0, 0, At, B0); PG8_BAR; PG8_SCHED;
            PG8_LDB(B1, 1, 1); PG8_STAGE(PG8_SB(1, 0), b3, voffB);
            PG8_BAR; PG8_WAIT_L(0); PG8_MMA(0, 1, At, B1); PG8_BAR;
            PG8_LDA(At, 1, 1); PG8_STAGE(PG8_SA(1, 0), a3, voffA);
            PG8_BAR; PG8_WAIT_L(0); PG8_MMA(1, 0, At, B0); PG8_BAR; PG8_SCHED;
            PG8_STAGE(PG8_SB(1, 1), b3 + hstep, voffB);
            PG8_WAIT_V(6); PG8_BAR; PG8_MMA(1, 1, At, B1); PG8_BAR;
            }
        }
        if constexpr (ALIGN_EPI) { if (wr == 0) PG8_BAR; }
        if constexpr (!Epi::AFTER_DRAIN) { E(acc, cur, wr, wc, fr, fq); S.done(cur); }
        if (!has_next) break;
#pragma unroll
        for (int a = 0; a < 2; ++a)
#pragma unroll
            for (int b = 0; b < 2; ++b)
#pragma unroll
                for (int m = 0; m < 4; ++m)
#pragma unroll
                    for (int n = 0; n < 2; ++n) acc[a][b][m][n] = (f32x4){0.f, 0.f, 0.f, 0.f};
        cur = nxt; cA = nA; cB = nB; ++ui;
        if constexpr (ALIGN_EPI) { if (wr == 1) PG8_BAR; }
    }
    PG8_WAIT_V(0);
    if constexpr (!ALIGN_EPI) { if (wr == 0) PG8_BAR; }
    PG8_BAR;
    if constexpr (Epi::AFTER_DRAIN) { E.fused(acc, cur, wr, wc, fr, fq, lds, wid, lane); S.done(cur); }
#undef PG8_SA
#undef PG8_SB
#undef PG8_STAGE
#undef PG8_LDA
#undef PG8_LDB
#undef PG8_MMA
#undef PG8_WAIT_V
#undef PG8_WAIT_L
#undef PG8_BAR
#undef PG8_SCHED
}
}

#ifndef PG8_SP2
#define PG8_SP2 true
#endif
#ifndef PG8_ALIGN
#define PG8_ALIGN true
#endif
#include <hip/hip_bf16.h>
#include <cmath>
#include <hip/hip_bf16.h>
#include <cmath>
namespace attn_body {
using bf16=__hip_bfloat16;
using bf16x8=__attribute__((ext_vector_type(8)))short;
using s16x4=__attribute__((ext_vector_type(4)))short;
using f32x16=__attribute__((ext_vector_type(16)))float;
using u32x4=__attribute__((ext_vector_type(4)))unsigned;
constexpr int BATCH=2,NHEAD=16,SEQ=8192,D=64,DM=NHEAD*D;
constexpr int NW=8,QBLK=32,QB=QBLK*NW,KVBLK=64,NQB=SEQ/QB;
constexpr int ATTN_PITCH=DM, ATTN_UNIT_ROWS=QB;
__device__ __forceinline__ int crow(int r,int hi){return (r&3)+8*(r>>2)+4*hi;}
#define SBAR() __builtin_amdgcn_sched_barrier(0)
__device__ __forceinline__ void cmask(f32x16&p0,f32x16&p1,int jb,int qrel,int hi){
  const float NEG=-INFINITY; int kb=64*jb+4*hi;
  #pragma unroll
  for(int r=0;r<16;++r){int kv=kb+(r&3)+8*(r>>2); if(kv>qrel)p0[r]=NEG; if(kv+32>qrel)p1[r]=NEG;}
}

constexpr int NSLOT=3, SLOTB=8192;
constexpr int LDS_K=0, LDS_V=NSLOT*SLOTB, LDS_WS=2*NSLOT*SLOTB, LDS_OST=LDS_WS+NW*64*4, LDS_BYTES=LDS_OST+NW*4096;
constexpr float C2=0.125f*1.4426950408889634f;
__device__ __forceinline__ void glds16(const void*gsrc,unsigned lds_dst){unsigned keep;
  asm volatile("s_mov_b32 %0, m0\n\ts_mov_b32 m0, %2\n\ts_nop 0\n\tglobal_load_lds_dwordx4 %1, off\n\ts_mov_b32 m0, %0":"=&s"(keep):"v"(gsrc),"s"(lds_dst):"memory");}
__device__ __forceinline__ float max3f(float a,float b,float c){float r;asm("v_max3_f32 %0, %1, %2, %3":"=v"(r):"v"(a),"v"(b),"v"(c));return r;}
__device__ __forceinline__ float max2f(float a,float b){float r;asm("v_max_f32_e32 %0, %1, %2":"=v"(r):"v"(a),"v"(b));return r;}
__device__ __forceinline__ float fadd_s(float a,float b){float r;asm("v_add_f32_e32 %0, %1, %2":"=v"(r):"v"(a),"v"(b));return r;}
__device__ __forceinline__ float fsub_s(float a,float b){float r;asm("v_sub_f32_e32 %0, %1, %2":"=v"(r):"v"(a),"v"(b));return r;}
typedef float f32x2_t __attribute__((ext_vector_type(2))); typedef __bf16 bf16x2_t __attribute__((ext_vector_type(2)));
__device__ __forceinline__ unsigned cvtpk_s(float lo,float hi){f32x2_t v={lo,hi};bf16x2_t b=__builtin_convertvector(v,bf16x2_t);return __builtin_bit_cast(unsigned,b);}
#define WAIT_BAR(N) asm volatile("s_waitcnt vmcnt(" #N ") lgkmcnt(0)\n\ts_barrier":::"memory")

__device__ __forceinline__ void qkt(f32x16&p0,f32x16&p1,const char*Kslot,const bf16x8*qr,const f32x16&negm,int r32,int hi){
  const char*kb=Kslot+hi*1024+r32*16;
  #pragma unroll
  for(int d0=0;d0<4;++d0){
    const bf16x8 b0=*reinterpret_cast<const bf16x8*>(kb+d0*2048);
    const bf16x8 b1=*reinterpret_cast<const bf16x8*>(kb+d0*2048+512);
    if(d0==0){p0=__builtin_amdgcn_mfma_f32_32x32x16_bf16(b0,qr[0],negm,0,0,0);p1=__builtin_amdgcn_mfma_f32_32x32x16_bf16(b1,qr[0],negm,0,0,0);}
    else{p0=__builtin_amdgcn_mfma_f32_32x32x16_bf16(b0,qr[d0],p0,0,0,0);p1=__builtin_amdgcn_mfma_f32_32x32x16_bf16(b1,qr[d0],p1,0,0,0);}}
}
typedef __attribute__((address_space(3))) const char* lds_cptr;
typedef short v4i16_t __attribute__((ext_vector_type(4)));
__device__ __forceinline__ void kload8(bf16x8*kf,lds_cptr kp){
  kf[0]=*(const __attribute__((address_space(3))) bf16x8*)(kp);      kf[1]=*(const __attribute__((address_space(3))) bf16x8*)(kp+512);
  kf[2]=*(const __attribute__((address_space(3))) bf16x8*)(kp+2048); kf[3]=*(const __attribute__((address_space(3))) bf16x8*)(kp+2560);
  kf[4]=*(const __attribute__((address_space(3))) bf16x8*)(kp+4096); kf[5]=*(const __attribute__((address_space(3))) bf16x8*)(kp+4608);
  kf[6]=*(const __attribute__((address_space(3))) bf16x8*)(kp+6144); kf[7]=*(const __attribute__((address_space(3))) bf16x8*)(kp+6656);
}
__device__ __forceinline__ void kload2(bf16x8*kf,lds_cptr kp,int j){ kf[2*j]=*(const __attribute__((address_space(3))) bf16x8*)(kp+j*2048); kf[2*j+1]=*(const __attribute__((address_space(3))) bf16x8*)(kp+j*2048+512); }
__device__ __forceinline__ s16x4 vtr(lds_cptr p){ return __builtin_bit_cast(s16x4,__builtin_amdgcn_ds_read_tr16_b64_v4i16((__attribute__((address_space(3))) v4i16_t*)p)); }
__device__ __forceinline__ float rowmax(const f32x16&p0,const f32x16&p1){
  float a=max3f(p0[0],p0[1],p1[0]),b=max3f(p0[2],p0[3],p1[1]);a=max3f(a,p1[2],p1[3]);
  #pragma unroll
  for(int r=4;r<16;r+=4){a=max3f(a,p0[r],p0[r+1]);b=max3f(b,p0[r+2],p0[r+3]);a=max3f(a,p1[r],p1[r+1]);b=max3f(b,p1[r+2],p1[r+3]);}
  const float m=max2f(a,b);
  auto rr=__builtin_amdgcn_permlane32_swap(__float_as_uint(m),__float_as_uint(m),false,false);
  return max2f(__uint_as_float(rr[0]),__uint_as_float(rr[1]));
}
__device__ __forceinline__ void pv(f32x16*o,int vb,bf16x8 pa0,bf16x8 pa1,bf16x8 pa2,bf16x8 pa3){
  #pragma unroll
  for(int d0=0;d0<2;++d0){s16x4 lo[4],hi[4];
    #pragma unroll
    for(int ks=0;ks<4;++ks){
      asm volatile("ds_read_b64_tr_b16 %0,%1 offset:%c2":"=&v"(lo[ks]):"v"(vb),"i"(d0*4096+ks*1024):"memory");
      asm volatile("ds_read_b64_tr_b16 %0,%1 offset:%c2":"=&v"(hi[ks]):"v"(vb),"i"(d0*4096+ks*1024+512):"memory");}
    asm volatile("s_waitcnt lgkmcnt(0)":::"memory");SBAR();
    #define PK(k) (bf16x8){lo[k][0],lo[k][1],lo[k][2],lo[k][3],hi[k][0],hi[k][1],hi[k][2],hi[k][3]}
    o[d0]=__builtin_amdgcn_mfma_f32_32x32x16_bf16(pa0,PK(0),o[d0],0,0,0);
    o[d0]=__builtin_amdgcn_mfma_f32_32x32x16_bf16(pa1,PK(1),o[d0],0,0,0);
    o[d0]=__builtin_amdgcn_mfma_f32_32x32x16_bf16(pa2,PK(2),o[d0],0,0,0);
    o[d0]=__builtin_amdgcn_mfma_f32_32x32x16_bf16(pa3,PK(3),o[d0],0,0,0);
    #undef PK
  }
}

#ifndef ATTN_STORE16
#define ATTN_STORE16(p,v) (*(u32x4*)(p)=(v))
#endif
template<int THRL> __device__ __forceinline__ void attn_unit(int qb,const bf16*Qh,const bf16*Kh,const bf16*Vh,bf16*Oh,int pq,int pk,int pv_,int po,char*shm,int wave_s){
  int tid_=wave_s*64+lane_id_v(); asm volatile("":"+v"(tid_)); const int tid=tid_,lane=tid&63,r32=lane&31,hi=lane>>5; const int wid=__builtin_amdgcn_readfirstlane(tid>>6);
  const int q0=qb*QB;
  const bf16*Qw=Qh+(long)(q0+wid*QBLK)*pq;
  const unsigned lds0=(unsigned)(uintptr_t)shm;
  float*wsf=(float*)(shm+LDS_WS)+wid*64;
  const bf16*ksrc=Kh+(long)lane*pk+wid*8;
  const bf16*vsrc=Vh+(long)(16*(wid&3)+(lane>>2))*pv_+(wid>>2)*32+(lane&3)*8;
  const unsigned kdst=lds0+LDS_K+wid*1024, vdst=lds0+LDS_V+wid*1024;
  #define DMA_K(t,slot) glds16(ksrc+(long)(t)*KVBLK*pk,(unsigned)__builtin_amdgcn_readfirstlane(kdst+(slot)))
  #define DMA_V(t,slot) glds16(vsrc+(long)(t)*KVBLK*pv_,(unsigned)__builtin_amdgcn_readfirstlane(vdst+(slot)))
  const int vb0=(int)(lds0+LDS_V)+((lane>>4)&1)*32+(lane&3)*8+(4*hi+((lane&15)>>2))*64;
  const char*Kbase=shm+LDS_K; bf16x8 kf[8];
  const lds_cptr shm3=(lds_cptr)shm; const lds_cptr kp0=shm3+LDS_K+hi*1024+r32*16; const lds_cptr vp0=shm3+LDS_V+((lane>>4)&1)*32+(lane&3)*8+(4*hi+((lane&15)>>2))*64;
  constexpr int NT=SEQ/KVBLK;
  DMA_K(0,0);DMA_V(0,0);DMA_K(1,SLOTB);
  bf16x8 qr[4];
  #pragma unroll
  for(int d0=0;d0<4;++d0)qr[d0]=*reinterpret_cast<const bf16x8*>(&Qw[(long)r32*pq+d0*16+hi*8]);
  float mhat=0.f,l_reg=0.f;f32x16 o[2];o[0]=f32x16{};o[1]=f32x16{};f32x16 negm=f32x16{};asm volatile("":"+v"(negm));

  #define CMASK(P0,P1,t) do{}while(0)
  bool resc=false;
  #define START(P0,P1) do{ const float rm=rowmax(P0,P1); resc=false; \
    { const float dl=rm; mhat=fadd_s(mhat,dl); \
      _Pragma("unroll") for(int r=0;r<16;++r){P0[r]=fsub_s(P0[r],dl);P1[r]=fsub_s(P1[r],dl);} \
      _Pragma("unroll") for(int r=0;r<16;++r)negm[r]=-mhat; asm volatile("":"+v"(negm)); } \
    _Pragma("unroll") for(int r=0;r<16;++r)P0[r]=__builtin_amdgcn_exp2f(P0[r]); }while(0)
  #define RESC() do{ if(resc){ asm volatile("s_waitcnt lgkmcnt(0)":::"memory"); \
      _Pragma("unroll") for(int d_=0;d_<2;++d_) _Pragma("unroll") for(int r=0;r<16;++r)o[d_][r]*=wsf[crow(r,hi)]; } }while(0)
  f32x16 pA0,pA1,pB0,pB1;
  int sl_prev=0,sl_cur=0,sl_next=SLOTB;
  #define ROT() do{sl_prev=sl_cur;sl_cur=sl_next;sl_next=(sl_next==(NSLOT-1)*SLOTB)?0:sl_next+SLOTB;}while(0)
  DMA_K(2,2*SLOTB);
  WAIT_BAR(3);
  qkt(pA0,pA1,Kbase,qr,negm,r32,hi);asm volatile("s_nop 15\n\ts_nop 7":"+v"(pA0),"+v"(pA1));CMASK(pA0,pA1,0);
  START(pA0,pA1);
  _Pragma("unroll") for(int r=0;r<16;++r)pA1[r]=__builtin_amdgcn_exp2f(pA1[r]);
  WAIT_BAR(0);
  DMA_K(3,0);DMA_V(1,SLOTB);
  ROT();
  kload8(kf,kp0+sl_cur);
  WAIT_BAR(2);
  s16x4 vlo[8],vhi[8]; u32x4 pw0,pw1,pw2,pw3;
  #define PKW(P,B) cvtpk_s(P[B],P[B+1])
  #define PAF(k) __builtin_bit_cast(bf16x8,pw##k)
  #define VFR(i) (bf16x8){vlo[i][0],vlo[i][1],vlo[i][2],vlo[i][3],vhi[i][0],vhi[i][1],vhi[i][2],vhi[i][3]}
  #define PIN(x) asm volatile("":"+v"(x))
  #define MX3(a,b,c) __builtin_fmaxf(__builtin_fmaxf((a),(b)),(c))
  #define GAPA(MF,A0,A1,A2,A3,W0,W1,PW) do{ MF; sacc+=A0; sacc+=A1; sacc+=A2; sacc+=A3; PIN(sacc); W0; W1; PIN(PW); SBAR(); }while(0)
  #define EX(v) __builtin_amdgcn_exp2f(v)
  #define GAPB(MF,X,B) do{ MF; X[B]=EX(X[B]); X[B+1]=EX(X[B+1]); X[B+2]=EX(X[B+2]); X[B+3]=EX(X[B+3]); PIN(X); SBAR(); }while(0)
  #define VRD(i) do{ vlo[i]=vtr(vp_+(((i)>>2)*4096+((i)&3)*1024)); vhi[i]=vtr(vp_+(((i)>>2)*4096+((i)&3)*1024+512)); }while(0)
  #define KRD(G,j) do{ if(G){ kload2(kf,kp0+sl_next,j); SBAR(); } }while(0)
  #define STEP(C0,C1,P0,P1,t,GK,GV,GL) do{ SBAR(); \
    const lds_cptr vp_=vp0+sl_prev; \
    VRD(0); SBAR(); float sacc=(P0[0]+P0[1]); \
    GAPA(C0=__builtin_amdgcn_mfma_f32_32x32x16_bf16(kf[0],qr[0],negm,0,0,0), P0[2],P0[3],P0[4],P0[5],     pw0[0]=PKW(P0,0), pw0[1]=PKW(P0,2), pw0); \
    VRD(4); SBAR(); GAPA(C1=__builtin_amdgcn_mfma_f32_32x32x16_bf16(kf[1],qr[0],negm,0,0,0), P0[6],P0[7],P0[8],P0[9],     pw0[2]=PKW(P0,4), pw0[3]=PKW(P0,6), pw0); \
    VRD(1); SBAR(); GAPA(C0=__builtin_amdgcn_mfma_f32_32x32x16_bf16(kf[2],qr[1],C0,0,0,0),   P0[10],P0[11],P0[12],P0[13], pw1[0]=PKW(P0,8), pw1[1]=PKW(P0,10), pw1); \
    VRD(5); SBAR(); GAPA(C1=__builtin_amdgcn_mfma_f32_32x32x16_bf16(kf[3],qr[1],C1,0,0,0),   P0[14],P0[15],P1[0],P1[1],   pw1[2]=PKW(P0,12),pw1[3]=PKW(P0,14), pw1); \
    VRD(2); SBAR(); GAPA(C0=__builtin_amdgcn_mfma_f32_32x32x16_bf16(kf[4],qr[2],C0,0,0,0),   P1[2],P1[3],P1[4],P1[5],     pw2[0]=PKW(P1,0), pw2[1]=PKW(P1,2), pw2); \
    VRD(6); SBAR(); GAPA(C1=__builtin_amdgcn_mfma_f32_32x32x16_bf16(kf[5],qr[2],C1,0,0,0),   P1[6],P1[7],P1[8],P1[9],     pw2[2]=PKW(P1,4), pw2[3]=PKW(P1,6), pw2); \
    VRD(3); SBAR(); GAPA(C0=__builtin_amdgcn_mfma_f32_32x32x16_bf16(kf[6],qr[3],C0,0,0,0),   P1[10],P1[11],P1[12],P1[13], pw3[0]=PKW(P1,8), pw3[1]=PKW(P1,10), pw3); \
    VRD(7); SBAR(); GAPA(C1=__builtin_amdgcn_mfma_f32_32x32x16_bf16(kf[7],qr[3],C1,0,0,0),   P1[14],P1[15],0.f,0.f,       pw3[2]=PKW(P1,12),pw3[3]=PKW(P1,14), pw3); \
    l_reg+=sacc; \
    if(GK){DMA_K((t)+3,sl_cur);} if(GV){DMA_V((t)+1,sl_next);} \
    CMASK(C0,C1,t); \
    { float a=MX3(C0[0],C0[1],C1[0]),b=MX3(C0[2],C0[3],C1[1]); a=MX3(a,C1[2],C1[3]); \
      _Pragma("unroll") for(int r=4;r<16;r+=4){a=MX3(a,C0[r],C0[r+1]);b=MX3(b,C0[r+2],C0[r+3]);a=MX3(a,C1[r],C1[r+1]);b=MX3(b,C1[r+2],C1[r+3]);} \
      float rm=__builtin_fmaxf(a,b); { auto rr=__builtin_amdgcn_permlane32_swap(__float_as_uint(rm),__float_as_uint(rm),false,false); rm=__builtin_fmaxf(__uint_as_float(rr[0]),__uint_as_float(rr[1])); } \
      resc=false; \
      if(__builtin_expect(__any(rm>(float)THRL),0)){ const float dl=__builtin_fmaxf(rm,0.f); mhat+=dl; \
        _Pragma("unroll") for(int r=0;r<16;++r){C0[r]-=dl;C1[r]-=dl;} \
        _Pragma("unroll") for(int r=0;r<16;++r)negm[r]=-mhat; asm volatile("":"+v"(negm)); \
        const float f=__builtin_amdgcn_exp2f(-dl); l_reg*=f; if(hi==0)wsf[r32]=f; resc=true; } } \
    SBAR(); \
    GAPB(o[0]=__builtin_amdgcn_mfma_f32_32x32x16_bf16(PAF(0),VFR(0),o[0],0,0,0), C0,0); \
    GAPB(o[1]=__builtin_amdgcn_mfma_f32_32x32x16_bf16(PAF(0),VFR(4),o[1],0,0,0), C0,4); \
    KRD(GL,0); GAPB(o[0]=__builtin_amdgcn_mfma_f32_32x32x16_bf16(PAF(1),VFR(1),o[0],0,0,0), C0,8); \
    KRD(GL,1); GAPB(o[1]=__builtin_amdgcn_mfma_f32_32x32x16_bf16(PAF(1),VFR(5),o[1],0,0,0), C0,12); \
    KRD(GL,2); GAPB(o[0]=__builtin_amdgcn_mfma_f32_32x32x16_bf16(PAF(2),VFR(2),o[0],0,0,0), C1,0); \
    KRD(GL,3); GAPB(o[1]=__builtin_amdgcn_mfma_f32_32x32x16_bf16(PAF(2),VFR(6),o[1],0,0,0), C1,4); \
    GAPB(o[0]=__builtin_amdgcn_mfma_f32_32x32x16_bf16(PAF(3),VFR(3),o[0],0,0,0), C1,8); \
    GAPB(o[1]=__builtin_amdgcn_mfma_f32_32x32x16_bf16(PAF(3),VFR(7),o[1],0,0,0), C1,12); \
    }while(0)
  int t=1;
  #undef CMASK
  #define CMASK(P0,P1,t) do{}while(0)
  for(;t+5<NT;t+=2){
    STEP(pB0,pB1,pA0,pA1,t,true,true,true);     WAIT_BAR(2); RESC(); ROT();
    STEP(pA0,pA1,pB0,pB1,t+1,true,true,true);   WAIT_BAR(2); RESC(); ROT();
  }
  #undef CMASK
  #define CMASK(P0,P1,t) do{}while(0)
  #define ENDW(tt) do{ if((tt)+3<NT){WAIT_BAR(2);} else if((tt)+2<NT){WAIT_BAR(1);} else {WAIT_BAR(0);} }while(0)
  for(;t+1<NT;t+=2){
    STEP(pB0,pB1,pA0,pA1,t,(t+3<NT),(t+1<NT),(t+1<NT));       ENDW(t);   RESC(); ROT();
    STEP(pA0,pA1,pB0,pB1,t+1,(t+4<NT),(t+2<NT),(t+2<NT));     ENDW(t+1); RESC(); ROT();
  }
  STEP(pB0,pB1,pA0,pA1,NT-1,false,false,false); RESC();
  { float sacc=pB0[0]+pB0[1]; _Pragma("unroll") for(int r=2;r<16;++r)sacc+=pB0[r]; _Pragma("unroll") for(int r=0;r<16;++r)sacc+=pB1[r]; l_reg+=sacc;
    pw0=(u32x4){PKW(pB0,0),PKW(pB0,2),PKW(pB0,4),PKW(pB0,6)};pw1=(u32x4){PKW(pB0,8),PKW(pB0,10),PKW(pB0,12),PKW(pB0,14)};pw2=(u32x4){PKW(pB1,0),PKW(pB1,2),PKW(pB1,4),PKW(pB1,6)};pw3=(u32x4){PKW(pB1,8),PKW(pB1,10),PKW(pB1,12),PKW(pB1,14)};
    SBAR(); pv(o,vb0+sl_cur,PAF(0),PAF(1),PAF(2),PAF(3)); }
  #undef PKW
  #undef PAF
  #undef VFR
  #undef PIN
  #undef MX3
  #undef GAPA
  #undef GAPB
  #undef EX
  #undef VRD
  #undef KRD
  #undef STEP
  #undef ENDW
  {auto rr=__builtin_amdgcn_permlane32_swap(__float_as_uint(l_reg),__float_as_uint(l_reg),false,false);l_reg=__uint_as_float(rr[0])+__uint_as_float(rr[1]);}
  if(hi==0)wsf[32+r32]=l_reg;asm volatile("s_waitcnt lgkmcnt(0)":::"memory");
  float rli[16];
  #pragma unroll
  for(int r=0;r<16;++r)rli[r]=__builtin_amdgcn_rcpf(wsf[32+crow(r,hi)]);
  bf16*Ow=Oh+(long)(q0+wid*QBLK)*po;
  { bf16*stg=(bf16*)(shm+LDS_OST)+wid*2048;
    #pragma unroll
    for(int r=0;r<16;++r){const int orow=crow(r,hi);
      #pragma unroll
      for(int d0=0;d0<2;++d0)stg[orow*64+d0*32+r32]=__float2bfloat16(o[d0][r]*rli[r]);}
    asm volatile("s_waitcnt lgkmcnt(0)":::"memory");
    #pragma unroll
    for(int i=0;i<4;++i){const int row=i*8+(lane>>3),ch=lane&7; const u32x4 v=*(const u32x4*)(stg+row*64+ch*8); ATTN_STORE16(Ow+(long)row*po+ch*8,v);} }
  asm volatile("s_waitcnt lgkmcnt(0)\n\ts_barrier":::"memory");
  #undef DMA_K
  #undef DMA_V
  #undef CMASK
  #undef START
  #undef RESC
  #undef ROT
}
#undef SBAR
#undef WAIT_BAR
}
namespace attn128 {
using bf16 = __hip_bfloat16;
using bf16x8 = __attribute__((ext_vector_type(8))) short;
using s16x4  = __attribute__((ext_vector_type(4))) short;
using f32x16 = __attribute__((ext_vector_type(16))) float;
using u32x4  = __attribute__((ext_vector_type(4))) unsigned;
constexpr int NW = 8, QBLK = 32, KVBLK = 64, SEQ = 8192;
constexpr float THR = 8.f;
constexpr size_t SHM_V = KVBLK * 128 * 2, SHM_K = KVBLK * 64 * 2, SHM_ATTN = 2 * SHM_V + 2 * SHM_K + NW * 64 * 4;
#define KSWZ64(row, colB) ((row) * 128 + ((colB) ^ ((((row) >> 1) & 7) << 4)))
#define SBAR() __builtin_amdgcn_sched_barrier(0)
__device__ __forceinline__ int crow(int r, int hi) { return (r & 3) + 8 * (r >> 2) + 4 * hi; }
__device__ __forceinline__ unsigned cvtpk(float lo, float hi) { unsigned r; asm volatile("v_cvt_pk_bf16_f32 %0, %1, %2" : "=v"(r) : "v"(lo), "v"(hi)); return r; }
__device__ __forceinline__ void partialSM(f32x16& p0, f32x16& p1, float& m_reg, float& mn, float& alpha) {
  float pmax = p0[0];
#pragma unroll
  for (int r = 1; r < 16; ++r) pmax = fmaxf(pmax, p0[r]);
#pragma unroll
  for (int r = 0; r < 16; ++r) pmax = fmaxf(pmax, p1[r]);
  { auto rr = __builtin_amdgcn_permlane32_swap(__float_as_uint(pmax), __float_as_uint(pmax), false, false);
    pmax = fmaxf(__uint_as_float(rr[0]), __uint_as_float(rr[1])); }
  if (__builtin_expect(__all(pmax - m_reg <= THR), 1)) { mn = m_reg; alpha = 1.f; }
  else { mn = fmaxf(m_reg, pmax); alpha = __builtin_amdgcn_exp2f(m_reg - mn); m_reg = mn; }
#pragma unroll
  for (int r = 0; r < 16; ++r) p0[r] = p0[r] - mn;
#pragma unroll
  for (int r = 0; r < 16; ++r) p1[r] = p1[r] - mn;
#pragma unroll
  for (int r = 0; r < 16; ++r) p0[r] = __builtin_amdgcn_exp2f(p0[r]);
}
__device__ __forceinline__ void finishSM(f32x16& p0, f32x16& p1, float alpha, float& l_reg, bf16x8& pa0, bf16x8& pa1, bf16x8& pa2, bf16x8& pa3) {
#pragma unroll
  for (int r = 0; r < 16; ++r) p1[r] = __builtin_amdgcn_exp2f(p1[r]);
  float ps = 0;
#pragma unroll
  for (int r = 0; r < 16; ++r) ps += p0[r];
#pragma unroll
  for (int r = 0; r < 16; ++r) ps += p1[r];
  { auto rr = __builtin_amdgcn_permlane32_swap(__float_as_uint(ps), __float_as_uint(ps), false, false);
    ps = __uint_as_float(rr[0]) + __uint_as_float(rr[1]); }
  l_reg = l_reg * alpha + ps;
#define PK4(P, BASE, OUT) do { unsigned a0 = cvtpk(P[BASE + 0], P[BASE + 1]), a1 = cvtpk(P[BASE + 2], P[BASE + 3]);   \
    unsigned b0 = cvtpk(P[BASE + 4], P[BASE + 5]), b1 = cvtpk(P[BASE + 6], P[BASE + 7]);                              \
    auto r0 = __builtin_amdgcn_permlane32_swap(a0, b0, false, false); auto r1 = __builtin_amdgcn_permlane32_swap(a1, b1, false, false); \
    u32x4 w = {r0[0], r1[0], r0[1], r1[1]}; OUT = *reinterpret_cast<bf16x8*>(&w); } while (0)
  PK4(p0, 0, pa0); PK4(p0, 8, pa1); PK4(p1, 0, pa2); PK4(p1, 8, pa3);
#undef PK4
}
__device__ __forceinline__ void qkt(f32x16& p0, f32x16& p1, const char* Ks, const bf16x8* qr, int r32, int hi) {
  p0 = f32x16{}; p1 = f32x16{};
#pragma unroll
  for (int d0 = 0; d0 < 4; ++d0) { const int cb = (d0 * 16 + hi * 8) * 2;
    bf16x8 b0 = *reinterpret_cast<const bf16x8*>(Ks + KSWZ64(r32, cb));
    bf16x8 b1 = *reinterpret_cast<const bf16x8*>(Ks + KSWZ64(32 + r32, cb));
    p0 = __builtin_amdgcn_mfma_f32_32x32x16_bf16(b0, qr[d0], p0, 0, 0, 0);
    p1 = __builtin_amdgcn_mfma_f32_32x32x16_bf16(b1, qr[d0], p1, 0, 0, 0); }
}
__device__ __forceinline__ int v_st(int k, int c) { const int kk = (k & ~0xC) | ((k & 4) << 1) | ((k & 8) >> 1); return ((kk >> 3) * 4 + (c >> 5)) * 512 + ((kk & 7) * 32 + (c & 31)) * 2; }
__device__ __forceinline__ int v_rd_base(int lane) { return ((lane & 3) << 3) | (((lane >> 2) & 3) << 6) | (((lane >> 4) & 1) << 5) | (((lane >> 5) & 1) << 8); }
constexpr int v_rd_off(int d0, int ks, int half) { return d0 * 512 + ks * 4096 + half * 2048; }
template <int OFF> __device__ __forceinline__ s16x4 tr_read(int vb) { s16x4 r; asm volatile("ds_read_b64_tr_b16 %0, %1 offset:%2" : "=&v"(r) : "v"(vb), "i"(OFF) : "memory"); return r; }
template <int D0> __device__ __forceinline__ void pv_one(f32x16& od, int vb, bf16x8 pa0, bf16x8 pa1, bf16x8 pa2, bf16x8 pa3) {
  const s16x4 l0 = tr_read<v_rd_off(D0, 0, 0)>(vb), h0 = tr_read<v_rd_off(D0, 0, 1)>(vb), l1 = tr_read<v_rd_off(D0, 1, 0)>(vb), h1 = tr_read<v_rd_off(D0, 1, 1)>(vb);
  const s16x4 l2 = tr_read<v_rd_off(D0, 2, 0)>(vb), h2 = tr_read<v_rd_off(D0, 2, 1)>(vb), l3 = tr_read<v_rd_off(D0, 3, 0)>(vb), h3 = tr_read<v_rd_off(D0, 3, 1)>(vb);
  asm volatile("s_waitcnt lgkmcnt(0)" ::: "memory"); SBAR();
#define PK(L, H) (bf16x8){L[0], L[1], L[2], L[3], H[0], H[1], H[2], H[3]}
  od = __builtin_amdgcn_mfma_f32_32x32x16_bf16(pa0, PK(l0, h0), od, 0, 0, 0);
  od = __builtin_amdgcn_mfma_f32_32x32x16_bf16(pa1, PK(l1, h1), od, 0, 0, 0);
  od = __builtin_amdgcn_mfma_f32_32x32x16_bf16(pa2, PK(l2, h2), od, 0, 0, 0);
  od = __builtin_amdgcn_mfma_f32_32x32x16_bf16(pa3, PK(l3, h3), od, 0, 0, 0);
#undef PK
}
__device__ __forceinline__ void pv_d0(f32x16* o, int vb, bf16x8 pa0, bf16x8 pa1, bf16x8 pa2, bf16x8 pa3) {
  pv_one<0>(o[0], vb, pa0, pa1, pa2, pa3); pv_one<1>(o[1], vb, pa0, pa1, pa2, pa3); pv_one<2>(o[2], vb, pa0, pa1, pa2, pa3); pv_one<3>(o[3], vb, pa0, pa1, pa2, pa3);
}
__device__ __forceinline__ void attn128_unit(int qb, const bf16* __restrict__ Qh, const bf16* __restrict__ Kh, const bf16* __restrict__ Vh, bf16* __restrict__ Oh,
                                             int pq, int pk, int pv_, int po, char* lds, int wave_s) {
  int tid_ = wave_s * 64 + lane_id_v(); asm volatile("" : "+v"(tid_));
  const int tid = tid_, wid = wave_s, lane = tid & 63, r32 = lane & 31, hi = lane >> 5;
  char* V_lds = lds; char* K_lds = lds + 2 * SHM_V;
  float* ws = (float*)(lds + 2 * SHM_V + 2 * SHM_K) + wid * 64; float* li_l = ws; float* al_l = ws + 32;
  float m_reg = -1e30f, l_reg = 0; f32x16 o[4] = {}; bf16x8 qr[4];
  const bf16* Qw = Qh + (long)(qb * 256 + wid * QBLK + r32) * pq + hi * 8;
#pragma unroll
  for (int d0 = 0; d0 < 4; ++d0) qr[d0] = *reinterpret_cast<const bf16x8*>(Qw + d0 * 16);
  const int sr = tid >> 4, sc = (tid & 15) * 8, vst0 = v_st(sr, sc), vst1 = v_st(32 + sr, sc);
  const int kr = tid >> 3, kc = (tid & 7) * 8, kst = KSWZ64(kr, kc * 2);
  const int vb0 = (int)(uintptr_t)V_lds + v_rd_base(lane);
  struct { bf16x8 vs0, vs1, ks0; } sr_[2];
#define SLOAD(i, k0) do { sr_[i].vs0 = *reinterpret_cast<const bf16x8*>(&Vh[(long)((k0) + sr) * pv_ + sc]); sr_[i].vs1 = *reinterpret_cast<const bf16x8*>(&Vh[(long)((k0) + 32 + sr) * pv_ + sc]); \
    sr_[i].ks0 = *reinterpret_cast<const bf16x8*>(&Kh[(long)((k0) + kr) * pk + kc]); } while (0)
#define SWRITE(b, i) do { *(bf16x8*)(V_lds + (b) * SHM_V + vst0) = sr_[i].vs0; *(bf16x8*)(V_lds + (b) * SHM_V + vst1) = sr_[i].vs1; \
    *(bf16x8*)(K_lds + (b) * SHM_K + kst) = sr_[i].ks0; } while (0)
#define SWAIT() asm volatile("s_waitcnt vmcnt(3)" ::: "memory")
#define RESC(a) do { if (__any((a) < 1.f)) { if (hi == 0) al_l[r32] = (a); asm volatile("s_waitcnt lgkmcnt(0)" ::: "memory"); \
    _Pragma("unroll") for (int d = 0; d < 4; ++d) _Pragma("unroll") for (int r = 0; r < 16; ++r) o[d][r] *= al_l[crow(r, hi)]; } } while (0)
  f32x16 pA0, pA1, pB0, pB1; float mnA, mnB, alA, alB; bf16x8 pa0, pa1, pa2, pa3; constexpr int NT = SEQ / KVBLK;
  constexpr int SE = 0, SO = 1;
  SLOAD(SE, 0); asm volatile("s_waitcnt vmcnt(0)" ::: "memory"); SWRITE(0, SE); __syncthreads();
  qkt(pA0, pA1, K_lds, qr, r32, hi); partialSM(pA0, pA1, m_reg, mnA, alA);
  SLOAD(SO, KVBLK); SLOAD(SE, 2 * KVBLK);
  SWAIT(); SWRITE(1, SO); __syncthreads();
  for (int j = 1; j + 1 < NT; j += 2) {
    SBAR(); qkt(pB0, pB1, K_lds + SHM_K, qr, r32, hi);
    finishSM(pA0, pA1, alA, l_reg, pa0, pa1, pa2, pa3); SBAR();
    SLOAD(SO, (j + 2) * KVBLK); SBAR();
    pv_d0(o, vb0, pa0, pa1, pa2, pa3); partialSM(pB0, pB1, m_reg, mnB, alB);
    __syncthreads(); SWAIT(); SWRITE(0, SE);
    RESC(alB); __syncthreads();
    SBAR(); qkt(pA0, pA1, K_lds, qr, r32, hi);
    finishSM(pB0, pB1, alB, l_reg, pa0, pa1, pa2, pa3); SBAR();
    if (j + 3 < NT) SLOAD(SE, (j + 3) * KVBLK); SBAR();
    pv_d0(o, vb0 + (int)SHM_V, pa0, pa1, pa2, pa3); partialSM(pA0, pA1, m_reg, mnA, alA);
    __syncthreads(); SWAIT(); SWRITE(1, SO);
    RESC(alA); __syncthreads();
  }
  SBAR(); qkt(pB0, pB1, K_lds + SHM_K, qr, r32, hi);
  finishSM(pA0, pA1, alA, l_reg, pa0, pa1, pa2, pa3); SBAR();
  pv_d0(o, vb0, pa0, pa1, pa2, pa3); partialSM(pB0, pB1, m_reg, mnB, alB);
  __syncthreads(); RESC(alB);
  finishSM(pB0, pB1, alB, l_reg, pa0, pa1, pa2, pa3); SBAR();
  pv_d0(o, vb0 + (int)SHM_V, pa0, pa1, pa2, pa3);
  if (hi == 0) li_l[r32] = l_reg; asm volatile("s_waitcnt lgkmcnt(0)" ::: "memory");
  float rli[16];
#pragma unroll
  for (int r = 0; r < 16; ++r) rli[r] = __builtin_amdgcn_rcpf(li_l[crow(r, hi)]);
  bf16* Ow = Oh + (long)(qb * 256 + wid * QBLK) * po;
#pragma unroll
  for (int r = 0; r < 16; ++r) { const int orow = crow(r, hi);
#pragma unroll
    for (int d0 = 0; d0 < 4; ++d0) Ow[(long)orow * po + d0 * 32 + r32] = __float2bfloat16(o[d0][r] * rli[r]); }
  __syncthreads();
#undef SLOAD
#undef SWRITE
#undef SWAIT
#undef RESC
}
#undef KSWZ64
#undef SBAR
}
#define LAS __attribute__((address_space(3)))
#define XB_TMO      128
#define XB_XCNT(j)  (256  + 64 * (j))
#define XB_XSUB(j)  (1280 + 64 * (j))
#define XB_XGEN(j)  (2304 + 64 * (j))
#define XB_TOP      3328
#define XB_TOPGEN   3392
#define XCD_BAR_WORDS 3456
#define XB_SPIN_CAP (1u << 18)

__device__ __forceinline__ unsigned xb_ld(unsigned* p)              { return __hip_atomic_load(p, __ATOMIC_RELAXED, __HIP_MEMORY_SCOPE_AGENT); }
__device__ __forceinline__ unsigned xb_add(unsigned* p, unsigned v) { return __hip_atomic_fetch_add(p, v, __ATOMIC_RELAXED, __HIP_MEMORY_SCOPE_AGENT); }
__device__ __forceinline__ unsigned xb_xcc_id() { return (unsigned)__builtin_amdgcn_s_getreg((3 << 11) | 20) & 0xFu; }
#define XB_SPIN(cond, bar) do { unsigned _sp = 0; while (cond) { __builtin_amdgcn_s_sleep(1); \
    if ((++_sp & 255u) == 0u) { if (xb_ld(&(bar)[XB_TMO])) break; if (_sp > XB_SPIN_CAP) { atomicAdd(&(bar)[XB_TMO], 1u); break; } } } } while (0)

struct XcdBarrier {
    unsigned* bar; unsigned x;
    volatile LAS unsigned* st; bool leader;
};

__device__ __forceinline__ XcdBarrier xcd_barrier_post(unsigned* bar, volatile LAS unsigned* st, bool leader) {
    XcdBarrier b; b.bar = bar; b.x = xb_xcc_id(); b.st = st; b.leader = leader;
    if (leader) (void)xb_add(&bar[XB_XCNT(b.x)], 1u);
    return b;
}
__device__ __forceinline__ void xcd_barrier_complete(unsigned* bar, unsigned x, unsigned& nloc, unsigned& nx) {
    const unsigned G = gridDim.x * gridDim.y * gridDim.z;
    unsigned sum, cnt, mine, sp = 0u;
    for (;;) {
        sum = 0u; cnt = 0u; mine = 0u;
#pragma unroll
        for (unsigned j = 0; j < 16; ++j) { const unsigned c = xb_ld(&bar[XB_XCNT(j)]); sum += c; cnt += (c > 0u) ? 1u : 0u; mine = (j == x) ? c : mine; }
        if (sum == G) break;
        __builtin_amdgcn_s_sleep(1);
        if ((++sp & 255u) == 0u) { if (xb_ld(&bar[XB_TMO])) break; if (sp > XB_SPIN_CAP) { atomicAdd(&bar[XB_TMO], 1u); break; } }
    }
    nloc = mine > 0u ? mine : 1u; nx = cnt > 0u ? cnt : 1u;
}

__device__ __forceinline__ void xcd_barrier(const XcdBarrier& b) {
    asm volatile("s_waitcnt vmcnt(0)" ::: "memory");
    __syncthreads();
    if (b.leader) {
        unsigned* bar = b.bar;
        __builtin_amdgcn_s_waitcnt(0);
        unsigned nloc = b.st[0], nx = b.st[1];
        if (nloc == 0u) { xcd_barrier_complete(bar, b.x, nloc, nx); b.st[0] = nloc; b.st[1] = nx; }
        const unsigned old = xb_add(&bar[XB_XSUB(b.x)], 1u);
        const unsigned gen = old / nloc;
        if (old + 1u == (gen + 1u) * nloc) {
            __builtin_amdgcn_fence(__ATOMIC_RELEASE, "agent");
            asm volatile("s_waitcnt vmcnt(0)" ::: "memory");
            const unsigned og = xb_add(&bar[XB_TOP], 1u);
            const unsigned tg = og / nx;
            if (og + 1u == (tg + 1u) * nx) xb_add(&bar[XB_TOPGEN], 1u);
            else XB_SPIN(xb_ld(&bar[XB_TOPGEN]) == tg, bar);
            __builtin_amdgcn_fence(__ATOMIC_ACQUIRE, "agent");
            xb_add(&bar[XB_XGEN(b.x)], 1u);
            asm volatile("s_waitcnt vmcnt(0)" ::: "memory");
        } else {
            XB_SPIN(xb_ld(&bar[XB_XGEN(b.x)]) == gen, bar);
            __builtin_amdgcn_fence(__ATOMIC_ACQUIRE, "agent");
            asm volatile("s_waitcnt vmcnt(0)" ::: "memory");
        }
    }
    __syncthreads();
}
#undef LAS
namespace cg = cooperative_groups;
#ifndef NCHUNK_DEF
#define NCHUNK_DEF 3
#endif
constexpr int NWAVES = 8;
constexpr int SEQ = 8192, DM = 1024, MC = 16384  , NCHUNK = NCHUNK_DEF, NPROJ = 6656, DFF = 2816, NUP = 2 * DFF, PLE = 256;
constexpr int C_AQ = 0, C_AK = 1024, C_AV = 2048, C_BQ = 3072, C_BK = 4096, C_BV = 4352, C_GA = 4608, C_GB = 5632;
constexpr float EPS = 1e-6f;
constexpr float QSCALE = 0.125f * 1.4426950408889634f;
constexpr size_t MiB = 1u << 20;
constexpr size_t WS_SS = 0;
constexpr size_t WS_TABA = 1 * MiB;
constexpr size_t WS_TABX = 1 * MiB + 512 * 1024;
constexpr size_t WS_WIN = 2 * MiB, WS_WA = 15 * MiB, WS_WB = 17 * MiB, WS_WOUT = 19 * MiB, WS_WUP = 21 * MiB, WS_WDN = 32 * MiB, WS_WPLE = 38 * MiB, WS_WPG = 39 * MiB;
constexpr size_t WS_XN = 42 * MiB;
constexpr size_t WS_PB = 74 * MiB;
constexpr size_t WS_PROJ = 82 * MiB;
constexpr size_t WS_U = WS_PROJ;
constexpr size_t WS_SG = WS_PROJ;
constexpr size_t WS_OA1 = 290 * MiB, WS_OA2 = 322 * MiB, WS_OB = 354 * MiB, WS_MG = 386 * MiB;
constexpr size_t WS_ACT = WS_OA1;
constexpr size_t WS_END = 418 * MiB;
constexpr int LDS_BYTES = 147456, MISC_OFF = 131072 + 320;
constexpr size_t WS_BAR = 1 * MiB + 768 * 1024;

#define GAS __attribute__((address_space(1)))
#define LAS __attribute__((address_space(3)))
typedef unsigned short bf16_t;
typedef unsigned v4u __attribute__((ext_vector_type(4)));
typedef unsigned v2u __attribute__((ext_vector_type(2)));
typedef float f32x4 __attribute__((ext_vector_type(4)));
#define LDS_WAIT() asm volatile("s_waitcnt lgkmcnt(0)" ::: "memory")
__device__ __forceinline__ unsigned f2bf(float f) { unsigned u = __builtin_bit_cast(unsigned, f); return (u + 0x7fffu + ((u >> 16) & 1u)) >> 16; }
__device__ __forceinline__ unsigned pk2(float lo, float hi) { return f2bf(lo) | (f2bf(hi) << 16); }
__device__ __forceinline__ float wave_sum(float v, int lane) {
#pragma unroll
    for (int o = 1; o < 64; o <<= 1) v += shx(v, lane, o);
    return v;
}
__device__ __forceinline__ void unpack16(const v4u a, const v4u b, float (&x)[16]) {
    x[0] = pg8::bf_lo(a.x); x[1] = pg8::bf_hi(a.x); x[2] = pg8::bf_lo(a.y); x[3] = pg8::bf_hi(a.y); x[4] = pg8::bf_lo(a.z); x[5] = pg8::bf_hi(a.z); x[6] = pg8::bf_lo(a.w); x[7] = pg8::bf_hi(a.w);
    x[8] = pg8::bf_lo(b.x); x[9] = pg8::bf_hi(b.x); x[10] = pg8::bf_lo(b.y); x[11] = pg8::bf_hi(b.y); x[12] = pg8::bf_lo(b.z); x[13] = pg8::bf_hi(b.z); x[14] = pg8::bf_lo(b.w); x[15] = pg8::bf_hi(b.w);
}
__device__ __forceinline__ void pack16(const float (&x)[16], v4u& a, v4u& b) {
    a.x = pk2(x[0], x[1]); a.y = pk2(x[2], x[3]); a.z = pk2(x[4], x[5]); a.w = pk2(x[6], x[7]);
    b.x = pk2(x[8], x[9]); b.y = pk2(x[10], x[11]); b.z = pk2(x[12], x[13]); b.w = pk2(x[14], x[15]);
}

__device__ __forceinline__ void p0_transpose_item(const float* W, int K, int N, bf16_t* WT, LAS float* scr, int item, int lane) {
    const int nblk = N / 32, kb = item / nblk, nb = item % nblk, k0 = 64 * kb, n0 = 32 * nb;
#pragma unroll 8
    for (int i = 0; i < 32; ++i) { const int kk = 2 * i + (lane >> 5); scr[kk * 33 + (lane & 31)] = W[(size_t)(k0 + kk) * N + n0 + (lane & 31)]; }
    LDS_WAIT(); asm volatile("" ::: "memory");
    const int c = lane & 7;
#pragma unroll
    for (int j = 0; j < 4; ++j) { const int n = (lane >> 3) + 8 * j; const LAS float* s = scr + (8 * c) * 33 + n;
        v4u o; o.x = pk2(s[0 * 33], s[1 * 33]); o.y = pk2(s[2 * 33], s[3 * 33]); o.z = pk2(s[4 * 33], s[5 * 33]); o.w = pk2(s[6 * 33], s[7 * 33]);
        *(GAS v4u*)(WT + (size_t)(n0 + n) * K + k0 + 8 * c) = o; }
    LDS_WAIT(); asm volatile("" ::: "memory");
}

struct Ctx {
    int vcu, G, wave_s;
};
__device__ __forceinline__ unsigned long long karg(int i) { const __attribute__((address_space(4))) unsigned long long* ka = (const __attribute__((address_space(4))) unsigned long long*)__builtin_amdgcn_kernarg_segment_ptr(); asm volatile("" : "+s"(ka)); return ka[i]; }
#define KIN(i) ((const float*)karg(i))
#define KOUT() ((float*)karg(25))
#define KWS() ((unsigned char*)karg(26))

__device__ __forceinline__ void phase_prologue(const Ctx& F, LAS unsigned char* lds) {
    int tid_ = F.wave_s * 64 + lane_id_v(); asm volatile("" : "+v"(tid_)); const int tid = tid_, lane = tid & 63, wave = F.wave_s, gw = F.vcu * NWAVES + wave, NGW = F.G * NWAVES; (void)lane; (void)gw; (void)NGW;
    unsigned char* const ws = KWS(); (void)ws;
    const int gt = F.vcu * (NWAVES * 64) + tid, NGT = F.G * NWAVES * 64;
    float* ss = (float*)(ws + WS_SS);
    for (int i = gt; i < 9 * MC; i += NGT) ss[i] = 0.f;
    {
        float* tab = (float*)(ws + WS_TABA);
        for (int i = gt; i < SEQ * 8; i += NGT) { const int pos = i >> 3, k = i & 7;
            const float inv = k == 0 ? 1.0f : k == 1 ? 0.19392274474868576f : k == 2 ? 0.03760603093086393f : k == 3 ? 0.007292664737217109f : k == 4 ? 0.001414213562373095f : k == 5 ? 0.0002742481756762073f : k == 6 ? 5.318295896944988e-05f : 1.031338537721246e-05f;
            const float ang = (float)pos * inv; double rev = (double)ang * 0.15915494309189535; rev -= __builtin_floor(rev); const float r = (float)rev;
            tab[pos * 16 + k] = __builtin_amdgcn_cosf(r); tab[pos * 16 + 8 + k] = __builtin_amdgcn_sinf(r); }
    }
    {
        float* tab = (float*)(ws + WS_TABX);
        for (int i = gt; i < 128 * 16; i += NGT) { const int pos = i >> 4, k = i & 15;
            const float inv = __builtin_amdgcn_exp2f(-(float)k * (13.287712379549449f / 16.0f));
            const float ang = (float)pos * inv; double rev = (double)ang * 0.15915494309189535; rev -= __builtin_floor(rev); const float r = (float)rev;
            tab[pos * 32 + k] = __builtin_amdgcn_cosf(r); tab[pos * 32 + 16 + k] = __builtin_amdgcn_sinf(r); }
    }
    LAS float* scr = (LAS float*)(lds + wave * 16384);
    constexpr int I_IN = (DM / 64) * (NPROJ / 32), I_SQ = (DM / 64) * (DM / 32), I_UP = (DM / 64) * (NUP / 32), I_DN = (DFF / 64) * (DM / 32), I_PLE = (PLE / 64) * (DM / 32);
    constexpr int NITEMS = I_IN + 4 * I_SQ + I_UP + I_DN + I_PLE;
    for (int it = gw; it < NITEMS; it += NGW) {
        int r = it;
        if (r < I_IN) { p0_transpose_item(KIN(5), DM, NPROJ, (bf16_t*)(ws + WS_WIN), scr, r, lane); continue; } r -= I_IN;
        if (r < I_SQ) { p0_transpose_item(KIN(11), DM, DM, (bf16_t*)(ws + WS_WA), scr, r, lane); continue; } r -= I_SQ;
        if (r < I_SQ) { p0_transpose_item(KIN(14), DM, DM, (bf16_t*)(ws + WS_WB), scr, r, lane); continue; } r -= I_SQ;
        if (r < I_SQ) { p0_transpose_item(KIN(15), DM, DM, (bf16_t*)(ws + WS_WOUT), scr, r, lane); continue; } r -= I_SQ;
        if (r < I_SQ) { p0_transpose_item(KIN(23), DM, DM, (bf16_t*)(ws + WS_WPG), scr, r, lane); continue; } r -= I_SQ;
        if (r < I_UP) { p0_transpose_item(KIN(17), DM, NUP, (bf16_t*)(ws + WS_WUP), scr, r, lane); continue; } r -= I_UP;
        if (r < I_DN) { p0_transpose_item(KIN(20), DFF, DM, (bf16_t*)(ws + WS_WDN), scr, r, lane); continue; } r -= I_DN;
        p0_transpose_item(KIN(21), PLE, DM, (bf16_t*)(ws + WS_WPLE), scr, r, lane);
    }
}

__device__ __forceinline__ void phase_prep(const Ctx& F, const float* x, const float* p) {
    int tid_ = F.wave_s * 64 + lane_id_v(); asm volatile("" : "+v"(tid_)); const int tid = tid_, lane = tid & 63, wave = F.wave_s, gw = F.vcu * NWAVES + wave, NGW = F.G * NWAVES; (void)lane; (void)gw; (void)NGW;
    unsigned char* const ws = KWS(); (void)ws;
    const float* g = KIN(4);
    bf16_t* XN = (bf16_t*)(ws + WS_XN); bf16_t* PB = (bf16_t*)(ws + WS_PB);
    f32x4 gv[4];
#pragma unroll
    for (int j = 0; j < 4; ++j) gv[j] = ((const f32x4*)g)[lane + 64 * j];
    for (int m = gw; m < MC; m += NGW) {
        const f32x4* xr = (const f32x4*)(x + (size_t)m * DM) + lane;
        f32x4 v[4]; float s = 0.f;
#pragma unroll
        for (int j = 0; j < 4; ++j) { v[j] = xr[64 * j]; s += (v[j].x * v[j].x + v[j].y * v[j].y) + (v[j].z * v[j].z + v[j].w * v[j].w); }
        const f32x4 pv = ((const f32x4*)(p + (size_t)m * PLE))[lane];
        const float rstd = __builtin_amdgcn_rsqf(wave_sum(s, lane) * (1.f / DM) + EPS);
        v2u* o8 = (v2u*)(XN + (size_t)m * DM) + lane;
#pragma unroll
        for (int j = 0; j < 4; ++j) { const f32x4 y = v[j] * rstd * gv[j]; v2u w; w.x = pk2(y.x, y.y); w.y = pk2(y.z, y.w); o8[64 * j] = w; }
        { v2u w; w.x = pk2(pv.x, pv.y); w.y = pk2(pv.z, pv.w); ((v2u*)(PB + (size_t)m * PLE))[lane] = w; }
    }
}

__device__ __forceinline__ void phase_rope(const Ctx& F) {
    int tid_ = F.wave_s * 64 + lane_id_v(); asm volatile("" : "+v"(tid_)); const int tid = tid_, lane = tid & 63, wave = F.wave_s, gw = F.vcu * NWAVES + wave, NGW = F.G * NWAVES; (void)lane; (void)gw; (void)NGW;
    unsigned char* const ws = KWS(); (void)ws;
    bf16_t* PROJ = (bf16_t*)(ws + WS_PROJ);
    const float* tabA = (const float*)(ws + WS_TABA); const float* tabX = (const float*)(ws + WS_TABX);
    const int q4 = lane & 3;
    float gq[16], gk[16];
#pragma unroll
    for (int k = 0; k < 16; ++k) { gq[k] = KIN(12)[q4 * 16 + k]; gk[k] = KIN(13)[q4 * 16 + k]; }
    for (int m = gw; m < MC; m += NGW) {
        const int t = m & (SEQ - 1);
        bf16_t* row = PROJ + (size_t)m * NPROJ;
        float c8[8], s8[8];
        { const f32x4* tp = (const f32x4*)(tabA + t * 16); const f32x4 a = tp[0], b = tp[1], c = tp[2], d = tp[3];
          c8[0] = a.x; c8[1] = a.y; c8[2] = a.z; c8[3] = a.w; c8[4] = b.x; c8[5] = b.y; c8[6] = b.z; c8[7] = b.w;
          s8[0] = c.x; s8[1] = c.y; s8[2] = c.z; s8[3] = c.w; s8[4] = d.x; s8[5] = d.y; s8[6] = d.z; s8[7] = d.w; }
        {
            v4u* pp = (v4u*)(row + C_AQ + lane * 16); v4u a = pp[0], b = pp[1]; float x[16]; unpack16(a, b, x);
            if (q4 == 0) {
#pragma unroll
                for (int i = 0; i < 8; ++i) { const float x1 = x[i], x2 = x[8 + i]; x[i] = x1 * c8[i] - x2 * s8[i]; x[8 + i] = x2 * c8[i] + x1 * s8[i]; } }
#pragma unroll
            for (int i = 0; i < 16; ++i) x[i] *= QSCALE;
            pack16(x, a, b); pp[0] = a; pp[1] = b;
        }
        if (q4 == 0) {
            v4u* pp = (v4u*)(row + C_AK + lane * 16); v4u a = pp[0], b = pp[1]; float x[16]; unpack16(a, b, x);
#pragma unroll
            for (int i = 0; i < 8; ++i) { const float x1 = x[i], x2 = x[8 + i]; x[i] = x1 * c8[i] - x2 * s8[i]; x[8 + i] = x2 * c8[i] + x1 * s8[i]; }
            pack16(x, a, b); pp[0] = a; pp[1] = b;
        }
        float cx[16], sx[16];
        { const int pos = (q4 < 2) ? (t >> 6) : (t & 63); const f32x4* tp = (const f32x4*)(tabX + pos * 32);
#pragma unroll
          for (int j = 0; j < 4; ++j) { const f32x4 a = tp[j], b = tp[4 + j]; cx[4 * j] = a.x; cx[4 * j + 1] = a.y; cx[4 * j + 2] = a.z; cx[4 * j + 3] = a.w; sx[4 * j] = b.x; sx[4 * j + 1] = b.y; sx[4 * j + 2] = b.z; sx[4 * j + 3] = b.w; } }
        const float sgn = (q4 & 1) ? 1.f : -1.f;
        {
            v4u* pp = (v4u*)(row + C_BQ + lane * 16); v4u a = pp[0], b = pp[1]; float x[16]; unpack16(a, b, x);
            float s = 0.f;
#pragma unroll
            for (int i = 0; i < 16; ++i) s += x[i] * x[i];
            s += shx(s, lane, 1); s += shx(s, lane, 2);
            const float r = __builtin_amdgcn_rsqf(s * (1.f / 64.f) + EPS);
#pragma unroll
            for (int i = 0; i < 16; ++i) x[i] = x[i] * r * gq[i];
#pragma unroll
            for (int i = 0; i < 16; ++i) { const float o = shx(x[i], lane, 1); x[i] = (x[i] * cx[i] + sgn * o * sx[i]) * QSCALE; }
            pack16(x, a, b); pp[0] = a; pp[1] = b;
        }
        {
            v4u* pp = (v4u*)(row + C_BK + (lane & 15) * 16); v4u a = pp[0], b = pp[1]; float x[16]; unpack16(a, b, x);
            float s = 0.f;
#pragma unroll
            for (int i = 0; i < 16; ++i) s += x[i] * x[i];
            s += shx(s, lane, 1); s += shx(s, lane, 2);
            const float r = __builtin_amdgcn_rsqf(s * (1.f / 64.f) + EPS);
#pragma unroll
            for (int i = 0; i < 16; ++i) x[i] = x[i] * r * gk[i];
#pragma unroll
            for (int i = 0; i < 16; ++i) { const float o = shx(x[i], lane, 1); x[i] = x[i] * cx[i] + sgn * o * sx[i]; }
            asm volatile("" ::: "memory");
            if (lane < 16) { pack16(x, a, b); pp[0] = a; pp[1] = b; }
        }
    }
}

__device__ __forceinline__ void phase_attn(const Ctx& F, char* lds) {
    using abf = attn_body::bf16;
    unsigned char* const ws = KWS();
    abf* PROJ = (abf*)(ws + WS_PROJ); abf* OA1 = (abf*)(ws + WS_OA1); abf* OA2 = (abf*)(ws + WS_OA2); abf* OB = (abf*)(ws + WS_OB);
    for (int i = 0;; ++i) {
        const int L = i * F.G + F.vcu; if (L >= 2048) break;
        const int i4 = (L >> 8) & 3, v = L & 255, g = v >> 3, s = v & 7, qb = i4 * 8 + s;
        if (L < 1024) { const int qd = g >> 2, mem = g & 3, b = qd >> 2, kvh = qd & 3, qh = kvh * 4 + mem; const size_t r0 = (size_t)b * SEQ;
            attn_body::attn_unit<8>(qb, PROJ + r0 * NPROJ + C_BQ + qh * 64, PROJ + r0 * NPROJ + C_BK + kvh * 64, PROJ + r0 * NPROJ + C_BV + kvh * 64, OB + r0 * DM + qh * 64, NPROJ, NPROJ, NPROJ, DM, lds, F.wave_s);
        } else { const int bh = g >> 1, j = g & 1, b = bh >> 3, h = bh & 7; const size_t r0 = (size_t)b * SEQ;
            attn128::attn128_unit(qb, PROJ + r0 * NPROJ + C_AQ + h * 128 + j * 64, PROJ + r0 * NPROJ + C_AK + h * 128 + j * 64, PROJ + r0 * NPROJ + C_AV + h * 128, (j ? OA2 : OA1) + r0 * DM + h * 128, NPROJ, NPROJ, NPROJ, DM, lds, F.wave_s); }
    }
}

__device__ __forceinline__ void phase_diffnorm(const Ctx& F) {
    int tid_ = F.wave_s * 64 + lane_id_v(); asm volatile("" : "+v"(tid_)); const int tid = tid_, lane = tid & 63, wave = F.wave_s, gw = F.vcu * NWAVES + wave, NGW = F.G * NWAVES; (void)lane; (void)gw; (void)NGW;
    unsigned char* const ws = KWS(); (void)ws;
    bf16_t* OA1 = (bf16_t*)(ws + WS_OA1); const bf16_t* OA2 = (const bf16_t*)(ws + WS_OA2);
    const float s1 = wave_sum(KIN(6)[lane] * KIN(7)[lane], lane), s2 = wave_sum(KIN(8)[lane] * KIN(9)[lane], lane);
    const float lam = __expf(s1) - __expf(s2) + 0.2f;
    float gd[16];
#pragma unroll
    for (int k = 0; k < 16; ++k) gd[k] = KIN(10)[(lane & 7) * 16 + k] * 0.8f;
    for (int m = gw; m < MC; m += NGW) {
        v4u* pp = (v4u*)(OA1 + (size_t)m * DM + lane * 16); const v4u* p2 = (const v4u*)(OA2 + (size_t)m * DM + lane * 16);
        v4u a = pp[0], b = pp[1]; const v4u c = p2[0], d = p2[1]; float x[16], y[16]; unpack16(a, b, x); unpack16(c, d, y);
        float s = 0.f;
#pragma unroll
        for (int i = 0; i < 16; ++i) { x[i] = x[i] - lam * y[i]; s += x[i] * x[i]; }
        s += shx(s, lane, 1); s += shx(s, lane, 2); s += shx(s, lane, 4);
        const float r = __builtin_amdgcn_rsqf(s * (1.f / 128.f) + EPS);
#pragma unroll
        for (int i = 0; i < 16; ++i) x[i] = x[i] * r * gd[i];
        pack16(x, a, b); pp[0] = a; pp[1] = b;
    }
}

__device__ __forceinline__ float gelu_tanh(float x) { const float u = x + 0.044715f * x * x * x; return x * __builtin_amdgcn_rcpf(1.0f + __builtin_amdgcn_exp2f(-2.302208198f * u)); }
__device__ __forceinline__ void ld8(const bf16_t* p, float (&x)[8]) { const v4u a = *(const v4u*)p; x[0] = pg8::bf_lo(a.x); x[1] = pg8::bf_hi(a.x); x[2] = pg8::bf_lo(a.y); x[3] = pg8::bf_hi(a.y); x[4] = pg8::bf_lo(a.z); x[5] = pg8::bf_hi(a.z); x[6] = pg8::bf_lo(a.w); x[7] = pg8::bf_hi(a.w); }
__device__ __forceinline__ void phase_conv(const Ctx& F) {
    int tid_ = F.wave_s * 64 + lane_id_v(); asm volatile("" : "+v"(tid_)); const int tid = tid_, lane = tid & 63, wave = F.wave_s, gw = F.vcu * NWAVES + wave, NGW = F.G * NWAVES; (void)lane; (void)gw; (void)NGW;
    unsigned char* const ws = KWS(); (void)ws;
    const bf16_t* U = (const bf16_t*)(ws + WS_U); bf16_t* ACT = (bf16_t*)(ws + WS_ACT);
    const float* cw = KIN(18); const float* cb = KIN(19);
    const int gt = F.vcu * (NWAVES * 64) + tid, NGT = F.G * NWAVES * 64;
    constexpr int NCG = DFF / 8, RUN = 16, NITEM = (MC / RUN) * NCG;
    for (int it = gt; it < NITEM; it += NGT) {
        const int cgi = it % NCG, run = it / NCG, ch0 = cgi * 8, t0 = run * RUN;
        float wg[3][8], wv[3][8], bg[8], bv[8];
#pragma unroll
        for (int k = 0; k < 3; ++k) { const f32x4 a = *(const f32x4*)(cw + k * NUP + ch0), b = *(const f32x4*)(cw + k * NUP + ch0 + 4), c = *(const f32x4*)(cw + k * NUP + DFF + ch0), d = *(const f32x4*)(cw + k * NUP + DFF + ch0 + 4);
            wg[k][0] = a.x; wg[k][1] = a.y; wg[k][2] = a.z; wg[k][3] = a.w; wg[k][4] = b.x; wg[k][5] = b.y; wg[k][6] = b.z; wg[k][7] = b.w;
            wv[k][0] = c.x; wv[k][1] = c.y; wv[k][2] = c.z; wv[k][3] = c.w; wv[k][4] = d.x; wv[k][5] = d.y; wv[k][6] = d.z; wv[k][7] = d.w; }
        { const f32x4 a = *(const f32x4*)(cb + ch0), b = *(const f32x4*)(cb + ch0 + 4), c = *(const f32x4*)(cb + DFF + ch0), d = *(const f32x4*)(cb + DFF + ch0 + 4);
          bg[0] = a.x; bg[1] = a.y; bg[2] = a.z; bg[3] = a.w; bg[4] = b.x; bg[5] = b.y; bg[6] = b.z; bg[7] = b.w; bv[0] = c.x; bv[1] = c.y; bv[2] = c.z; bv[3] = c.w; bv[4] = d.x; bv[5] = d.y; bv[6] = d.z; bv[7] = d.w; }
        float pg_[8], pv_[8], cg_[8], cv_[8], ng_[8], nv_[8];
        const bf16_t* up = U + (size_t)t0 * NUP + ch0;
        if ((t0 & (SEQ - 1)) == 0) {
#pragma unroll
            for (int k = 0; k < 8; ++k) { pg_[k] = 0.f; pv_[k] = 0.f; }
        } else { ld8(up - NUP, pg_); ld8(up - NUP + DFF, pv_); }
        ld8(up, cg_); ld8(up + DFF, cv_);
#pragma unroll 4
        for (int i = 0; i < RUN; ++i) {
            const int t = t0 + i;
            if ((t & (SEQ - 1)) == SEQ - 1) {
#pragma unroll
                for (int k = 0; k < 8; ++k) { ng_[k] = 0.f; nv_[k] = 0.f; }
            } else { ld8(up + (size_t)(i + 1) * NUP, ng_); ld8(up + (size_t)(i + 1) * NUP + DFF, nv_); }
            float o[8];
#pragma unroll
            for (int k = 0; k < 8; ++k) { const float ug = pg_[k] * wg[0][k] + cg_[k] * wg[1][k] + ng_[k] * wg[2][k] + bg[k]; const float uv = pv_[k] * wv[0][k] + cv_[k] * wv[1][k] + nv_[k] * wv[2][k] + bv[k]; o[k] = gelu_tanh(ug) * uv; }
            v4u w; w.x = pk2(o[0], o[1]); w.y = pk2(o[2], o[3]); w.z = pk2(o[4], o[5]); w.w = pk2(o[6], o[7]);
            *(v4u*)(ACT + (size_t)t * DFF + ch0) = w;
#pragma unroll
            for (int k = 0; k < 8; ++k) { pg_[k] = cg_[k]; pv_[k] = cv_[k]; cg_[k] = ng_[k]; cv_[k] = nv_[k]; }
        }
    }
}

__device__ __forceinline__ void phase_final(const Ctx& F, float* out, const float* ss3) {
    int tid_ = F.wave_s * 64 + lane_id_v(); asm volatile("" : "+v"(tid_)); const int tid = tid_, lane = tid & 63, wave = F.wave_s, gw = F.vcu * NWAVES + wave, NGW = F.G * NWAVES; (void)lane; (void)gw; (void)NGW;
    unsigned char* const ws = KWS(); (void)ws;
    const float* g = KIN(24);
    f32x4 gv[4];
#pragma unroll
    for (int j = 0; j < 4; ++j) gv[j] = ((const f32x4*)g)[lane + 64 * j];
    for (int m = gw; m < MC; m += NGW) {
        f32x4* xr = (f32x4*)(out + (size_t)m * DM) + lane;
        const float r = __builtin_amdgcn_rsqf(ss3[m] * (1.f / DM) + EPS);
#pragma unroll
        for (int j = 0; j < 4; ++j) xr[64 * j] = xr[64 * j] * r * gv[j];
    }
}

struct Args { const float* in[25]; float* out; unsigned char* ws; };

template <int c> __device__ __forceinline__ void run_chunk(const Ctx& F, unsigned char* lds, const XcdBarrier& gbar) {
    LAS unsigned char* L = (LAS unsigned char*)lds;
    const int bid = (int)blockIdx.x;
#define WSP(T, off) ((T*)(ws + (off)))
#define XC() ((c == 0) ? KIN(0) : KIN(1) + (size_t)(c - 1) * MC * DM)
#define OUTC() (KOUT() + (size_t)c * MC * DM)
#define SSP(k) ((float*)(ws + WS_SS) + (size_t)(c * 3 + (k)) * MC)
#ifndef SKIP_GB
        {
            unsigned char* const ws = KWS(); pg8::Gemm g{WSP(bf16_t, WS_XN), (const bf16_t*)(ws + WS_WIN), MC, NPROJ, DM}; pg8::StaticOrder S; S.init(MC, NPROJ, F.G, bid);
            pg8::EpiProj E{WSP(bf16_t, WS_PROJ), NPROJ, C_GA / 256};
            pg8::gemm_phase<pg8::EpiProj, pg8::StaticOrder, PG8_ALIGN, PG8_SP2>(L, g, S, E, F.wave_s);
        }
#endif
        xcd_barrier(gbar);
#ifndef SKIP_EW
        phase_rope(F);
#endif
        xcd_barrier(gbar);
#ifndef SKIP_ATTN
        phase_attn(F, (char*)lds);
#endif
        xcd_barrier(gbar);
#ifndef SKIP_EW
        phase_diffnorm(F);
#endif
        xcd_barrier(gbar);
#ifndef SKIP_GF
        {
            unsigned char* const ws = KWS(); pg8::Gemm g{WSP(bf16_t, WS_OA1), (const bf16_t*)(ws + WS_WA), MC, DM, DM}; pg8::StaticOrder S; S.init(MC, DM, F.G, bid);
            pg8::EpiT1 E{WSP(bf16_t, WS_PROJ) + C_GA, NPROJ, OUTC(), DM};
            pg8::gemm_phase<pg8::EpiT1, pg8::StaticOrder, PG8_ALIGN, PG8_SP2>(L, g, S, E, F.wave_s);
        }
#endif
        xcd_barrier(gbar);
#ifndef SKIP_GG
        {
            unsigned char* const ws = KWS(); pg8::Gemm g{WSP(bf16_t, WS_OB), (const bf16_t*)(ws + WS_WB), MC, DM, DM}; pg8::StaticOrder S; S.init(MC, DM, F.G, bid);
            pg8::EpiMerge E{WSP(bf16_t, WS_PROJ) + C_GB, NPROJ, OUTC(), DM, WSP(bf16_t, WS_MG), DM};
            pg8::gemm_phase<pg8::EpiMerge, pg8::StaticOrder, PG8_ALIGN, PG8_SP2>(L, g, S, E, F.wave_s);
        }
#endif
        xcd_barrier(gbar);
#ifndef SKIP_GH
        {
            unsigned char* const ws = KWS(); pg8::Gemm g{WSP(bf16_t, WS_MG), (const bf16_t*)(ws + WS_WOUT), MC, DM, DM}; pg8::StaticOrder S; S.init(MC, DM, F.G, bid);
            pg8::EpiResid<false, true> E{XC(), OUTC(), nullptr, WSP(bf16_t, WS_XN), KIN(16), SSP(0), DM};
            pg8::gemm_phase<pg8::EpiResid<false, true>, pg8::StaticOrder, PG8_ALIGN, PG8_SP2>(L, g, S, E, F.wave_s);
        }
#endif
        xcd_barrier(gbar);
#ifndef SKIP_GI
        {
            unsigned char* const ws = KWS(); pg8::Gemm g{WSP(bf16_t, WS_XN), (const bf16_t*)(ws + WS_WUP), MC, NUP, DM}; pg8::StaticOrder S; S.init(MC, NUP, F.G, bid);
            pg8::EpiScale<false> E{SSP(0), 1.f / DM, EPS, WSP(bf16_t, WS_U), nullptr, NUP};
            pg8::gemm_phase<pg8::EpiScale<false>, pg8::StaticOrder, PG8_ALIGN, PG8_SP2>(L, g, S, E, F.wave_s);
        }
#endif
        xcd_barrier(gbar);
#ifndef SKIP_CONV
        phase_conv(F);
#endif
        xcd_barrier(gbar);
#ifndef SKIP_GK
        {
            unsigned char* const ws = KWS(); pg8::Gemm g{WSP(bf16_t, WS_ACT), (const bf16_t*)(ws + WS_WDN), MC, DM, DFF}; pg8::StaticOrder S; S.init(MC, DM, F.G, bid);
            float* const oc = OUTC(); pg8::EpiResid<false, true> E{oc, oc, nullptr, WSP(bf16_t, WS_XN), KIN(22), SSP(1), DM};
            pg8::gemm_phase<pg8::EpiResid<false, true>, pg8::StaticOrder, PG8_ALIGN, PG8_SP2>(L, g, S, E, F.wave_s);
        }
#endif
        xcd_barrier(gbar);
#ifndef SKIP_GL
        {
            unsigned char* const ws = KWS(); pg8::Gemm g{WSP(bf16_t, WS_XN), (const bf16_t*)(ws + WS_WPG), MC, DM, DM}; pg8::StaticOrder S; S.init(MC, DM, F.G, bid);
            pg8::EpiScale<true> E{SSP(1), 1.f / DM, EPS, nullptr, WSP(float, WS_SG), DM};
            pg8::gemm_phase<pg8::EpiScale<true>, pg8::StaticOrder, PG8_ALIGN, PG8_SP2>(L, g, S, E, F.wave_s);
        }
#endif
        xcd_barrier(gbar);
#ifndef SKIP_GM
        {
            unsigned char* const ws = KWS(); pg8::Gemm g{WSP(bf16_t, WS_PB), (const bf16_t*)(ws + WS_WPLE), MC, DM, PLE}; pg8::StaticOrder S; S.init(MC, DM, F.G, bid);
            float* const oc = OUTC(); pg8::EpiResid<true, false> E{oc, oc, WSP(float, WS_SG), nullptr, nullptr, SSP(2), DM};
            pg8::gemm_phase<pg8::EpiResid<true, false>, pg8::StaticOrder, PG8_ALIGN, PG8_SP2>(L, g, S, E, F.wave_s);
        }
#endif
        xcd_barrier(gbar);
#ifndef SKIP_EW
        { unsigned char* const ws = KWS(); phase_final(F, OUTC(), SSP(2)); }
#endif
        if (c + 1 < NCHUNK) { phase_prep(F, KIN(1) + (size_t)c * MC * DM, KIN(3) + (size_t)c * MC * PLE); xcd_barrier(gbar); }
}

__global__ void __launch_bounds__(NWAVES * 64, 2) mk_fwd(Args args) {
    extern __shared__ __attribute__((aligned(16))) unsigned char lds[];
    cg::grid_group grid = cg::this_grid();
    Ctx F;
    F.wave_s = __builtin_amdgcn_readfirstlane((int)threadIdx.x >> 6);
    if (threadIdx.x < 32) ((volatile LAS unsigned*)((LAS unsigned char*)lds + MISC_OFF))[threadIdx.x] = 0u;
    __syncthreads();
    const XcdBarrier gbar = xcd_barrier_post((unsigned*)(KWS() + WS_BAR), (volatile LAS unsigned*)((LAS unsigned char*)lds + MISC_OFF) + 8, threadIdx.x == 0);
    F.G = gridDim.x; { const int bx = blockIdx.x; F.vcu = (F.G % 8 == 0) ? (bx % 8) * (F.G / 8) + bx / 8 : bx; }
    (void)args;
    LAS unsigned char* L = (LAS unsigned char*)lds;
#ifndef SKIP_EW
    phase_prologue(F, L);
    phase_prep(F, KIN(0), KIN(2));
#endif
    grid.sync();
    run_chunk<0>(F, lds, gbar);
#ifndef ONE_CHUNK
    run_chunk<1>(F, lds, gbar);
    run_chunk<2>(F, lds, gbar);
#endif
}

extern "C" void kernel_launch(void* const* d_in, const int* in_sizes, int n_in, void* d_out, int out_size, void* d_ws, size_t ws_size, hipStream_t stream) {
    static int grid = 0;
    if (grid == 0) {
        if (n_in != 25 || ws_size < WS_END) { fprintf(stderr, "kernel_launch: unexpected inputs (n_in %d, ws %zu)\n", n_in, ws_size); grid = -1; return; }
        int dev = 0, cus = 0, per_cu = 0;
        hipGetDevice(&dev); hipDeviceGetAttribute(&cus, hipDeviceAttributeMultiprocessorCount, dev);
        hipFuncSetAttribute((const void*)mk_fwd, hipFuncAttributeMaxDynamicSharedMemorySize, LDS_BYTES);
        hipOccupancyMaxActiveBlocksPerMultiprocessor(&per_cu, (const void*)mk_fwd, NWAVES * 64, LDS_BYTES);
        (void)hipGetLastError();
        if (per_cu < 1) per_cu = 1;
        grid = cus;
    }
    if (grid < 0) return;
    if (hipMemsetAsync((char*)d_ws + WS_BAR, 0, 16384, stream) != hipSuccess) { fprintf(stderr, "kernel_launch: memset failed\n"); return; }
    Args a{};
    for (int i = 0; i < 25; ++i) a.in[i] = (const float*)d_in[i];
    a.out = (float*)d_out; a.ws = (unsigned char*)d_ws;
    void* kargs[] = {&a};
    hipError_t e = hipLaunchCooperativeKernel((const void*)mk_fwd, dim3(grid), dim3(NWAVES * 64), kargs, LDS_BYTES, stream);
    if (e != hipSuccess) fprintf(stderr, "cooperative launch failed: %s (grid %d)\n", hipGetErrorString(e), grid);
}
```

```cpp
#include <hip/hip_runtime.h>
#include <hip/hip_cooperative_groups.h>
#include <cstdio>
#include <cstdint>
__device__ __forceinline__ int lane_id_v() { int l; asm volatile("v_mbcnt_lo_u32_b32 %0, -1, 0\n\tv_mbcnt_hi_u32_b32 %0, -1, %0" : "=v"(l)); return l; }
__device__ __forceinline__ float shx(float v, int lane, int m) { return __int_as_float(__builtin_amdgcn_ds_bpermute((lane ^ m) << 2, __float_as_int(v))); }
namespace pg8 {
#define PG8_LAS __attribute__((address_space(3)))
typedef unsigned short bf16_t;
typedef short bf16x8 __attribute__((ext_vector_type(8)));
typedef float f32x4 __attribute__((ext_vector_type(4)));
typedef unsigned u32x4 __attribute__((ext_vector_type(4)));
constexpr int BM = 256, BK = 64, HALF = 128, HTB = HALF * BK * 2  , STAGE_BYTES = 8 * HTB, NXCD = 8, WGM = 8;

__host__ __device__ __forceinline__ int lds_byte(int r, int c) { const int st = (r >> 4) * 2 + (c >> 5), rr = r & 15, cc = c & 31, ob = rr * 64 + cc * 2; return st * 1024 + (ob ^ (((ob >> 9) & 1) << 5)); }
__host__ __device__ __forceinline__ void stage_rc(int b, int& R, int& C) { const int st = b / 1024, sb = b % 1024, swz = sb ^ (((sb >> 9) & 1) << 5); R = (st >> 1) * 16 + swz / 64; C = (st & 1) * 32 + (swz % 64) / 2; }
__host__ __device__ __forceinline__ int perm32(int rho) { const int n = rho >> 4, i = rho & 15; return 8 * (i >> 2) + 4 * n + (i & 3); }

struct Unit { int pm, pn; };
struct Gemm { const bf16_t* A; const bf16_t* Bt; int M, N, K; };

struct StaticOrder {
    int nM, nN, nwg, G, c;
    __host__ __device__ void init(int M, int N, int G_, int c_) { nM = M / BM; nN = N / BM; nwg = nM * nN; G = G_; c = c_; }
    __host__ __device__ bool next(int i, Unit& u) const {
        const long L = (long)i * G + c; if (L >= nwg) return false;
        int wgid = (int)L; { const int q = nwg / NXCD, r = nwg % NXCD, xcd = wgid % NXCD, off = wgid / NXCD; wgid = (xcd < r ? xcd * (q + 1) : r * (q + 1) + (xcd - r) * q) + off; }
        const int nig = WGM * nN, gid = wgid / nig, fm = gid * WGM, gsz = (nM - fm) < WGM ? (nM - fm) : WGM;
        u.pm = fm + ((wgid % nig) % gsz); u.pn = (wgid % nig) / gsz; return true;
    }
    __device__ __forceinline__ void a_ready(const Unit&) const {}
    __device__ __forceinline__ void done(const Unit&) const {}
};

__device__ __forceinline__ unsigned cvt_pk_bf16(float lo, float hi) { unsigned r; asm volatile("v_cvt_pk_bf16_f32 %0, %1, %2" : "=v"(r) : "v"(lo), "v"(hi)); return r; }
typedef float f32x2 __attribute__((ext_vector_type(2)));
__device__ __forceinline__ f32x2 gelu_pk(f32x2 v) {
    const f32x2 av = __builtin_elementwise_abs(v), d = av * 0.2316418882f + 1.0f;
    f32x2 t; t.x = __builtin_amdgcn_rcpf(d.x); t.y = __builtin_amdgcn_rcpf(d.y);
    f32x2 q = t * 0.5307027145f + (-0.7265760135f); q = q * t + 0.7107068705f; q = q * t + (-0.142248368f); q = q * t + 0.127414796f; q = q * t;
    const f32x2 s = (v * v) * (-0.72134752044f);
    f32x2 e; e.x = __builtin_amdgcn_exp2f(s.x); e.y = __builtin_amdgcn_exp2f(s.y);
    const f32x2 m = v * (q * e), r = v - m;
    f32x2 o; o.x = v.x < 0.f ? m.x : r.x; o.y = v.y < 0.f ? m.y : r.y; return o;
}

template <int ACT  > struct EpiBf16 {
    static constexpr bool PERM = true, AFTER_DRAIN = false; static_assert(ACT == 0 || ACT == 1, "EpiBf16: ACT is 0 (none) or 1 (gelu_pk)");
    bf16_t* O; int ldc; const float* bias; int split_cols; size_t split_stride; float scale0;
    __device__ __forceinline__ void operator()(const f32x4 (&acc)[2][2][4][2], const Unit& u, int wr, int wc, int fr, int fq) const {
        const int row0 = u.pm * BM + wr * 64 + fr; int colt = u.pn * BM; bf16_t* base = O;
        float sc = 1.f; if (split_cols) { const int t = colt / split_cols; base += (size_t)t * split_stride; colt -= t * split_cols; if (t == 0) sc = scale0; }
        const int col0 = colt + wc * 32 + 8 * fq, bcol0 = u.pn * BM + wc * 32 + 8 * fq;
        f32x4 bv[2][2];
#pragma unroll
        for (int bj = 0; bj < 2; ++bj)
#pragma unroll
            for (int n = 0; n < 2; ++n) bv[bj][n] = bias ? *(const f32x4*)(bias + bcol0 + bj * HALF + 4 * n) : (f32x4){0.f, 0.f, 0.f, 0.f};
#pragma unroll
        for (int ai = 0; ai < 2; ++ai)
#pragma unroll
            for (int m = 0; m < 4; ++m) { bf16_t* rowp = base + (size_t)(row0 + ai * HALF + m * 16) * ldc + col0;
#pragma unroll
                for (int bj = 0; bj < 2; ++bj) { f32x4 v0 = acc[ai][bj][m][0] + bv[bj][0], v1 = acc[ai][bj][m][1] + bv[bj][1];
                    if (ACT == 1) { f32x2 a = gelu_pk((f32x2){v0[0], v0[1]}), b = gelu_pk((f32x2){v0[2], v0[3]}), c = gelu_pk((f32x2){v1[0], v1[1]}), d = gelu_pk((f32x2){v1[2], v1[3]});
                        v0 = (f32x4){a.x, a.y, b.x, b.y}; v1 = (f32x4){c.x, c.y, d.x, d.y}; }
                    v0 = v0 * sc; v1 = v1 * sc; u32x4 w; w.x = cvt_pk_bf16(v0[0], v0[1]); w.y = cvt_pk_bf16(v0[2], v0[3]); w.z = cvt_pk_bf16(v1[0], v1[1]); w.w = cvt_pk_bf16(v1[2], v1[3]);
                    *(u32x4*)(rowp + bj * HALF) = w; } }
    }
};

__device__ __forceinline__ float sigm(float x) { return __builtin_amdgcn_rcpf(1.0f + __builtin_amdgcn_exp2f(-1.4426950408889634f * x)); }
__device__ __forceinline__ float bf_lo(unsigned w) { return __uint_as_float(w << 16); }
__device__ __forceinline__ float bf_hi(unsigned w) { return __uint_as_float(w & 0xffff0000u); }
__device__ __forceinline__ u32x4 pack8(const f32x4 v0, const f32x4 v1) { u32x4 w; w.x = cvt_pk_bf16(v0[0], v0[1]); w.y = cvt_pk_bf16(v0[2], v0[3]); w.z = cvt_pk_bf16(v1[0], v1[1]); w.w = cvt_pk_bf16(v1[2], v1[3]); return w; }
__device__ __forceinline__ void unpack8(const u32x4 g, f32x4& a, f32x4& b) { a = (f32x4){bf_lo(g.x), bf_hi(g.x), bf_lo(g.y), bf_hi(g.y)}; b = (f32x4){bf_lo(g.z), bf_hi(g.z), bf_lo(g.w), bf_hi(g.w)}; }

struct EpiProj {
    static constexpr bool PERM = true, AFTER_DRAIN = false;
    bf16_t* O; int ldc; int sig_pn; int scale_pn; float scale;
    __device__ __forceinline__ void operator()(const f32x4 (&acc)[2][2][4][2], const Unit& u, int wr, int wc, int fr, int fq) const {
        const int row0 = u.pm * BM + wr * 64 + fr, col0 = u.pn * BM + wc * 32 + 8 * fq; const bool sg = u.pn >= sig_pn; const float sc = u.pn < scale_pn ? scale : 1.0f;
#pragma unroll
        for (int ai = 0; ai < 2; ++ai)
#pragma unroll
            for (int m = 0; m < 4; ++m) { bf16_t* rowp = O + (size_t)(row0 + ai * HALF + m * 16) * ldc + col0;
#pragma unroll
                for (int bj = 0; bj < 2; ++bj) { f32x4 v0 = acc[ai][bj][m][0] * sc, v1 = acc[ai][bj][m][1] * sc;
                    if (sg) {
#pragma unroll
                        for (int k = 0; k < 4; ++k) { v0[k] = sigm(v0[k]); v1[k] = sigm(v1[k]); } }
                    *(u32x4*)(rowp + bj * HALF) = pack8(v0, v1); } }
    }
};
struct EpiT1 {
    static constexpr bool PERM = true, AFTER_DRAIN = false;
    const bf16_t* G; int ldg; bf16_t* T; int ldt;
    __device__ __forceinline__ void operator()(const f32x4 (&acc)[2][2][4][2], const Unit& u, int wr, int wc, int fr, int fq) const {
        const int row0 = u.pm * BM + wr * 64 + fr, col0 = u.pn * BM + wc * 32 + 8 * fq;
#pragma unroll
        for (int ai = 0; ai < 2; ++ai)
#pragma unroll
            for (int m = 0; m < 4; ++m) { const size_t row = (size_t)(row0 + ai * HALF + m * 16);
#pragma unroll
                for (int bj = 0; bj < 2; ++bj) { const u32x4 g = *(const u32x4*)(G + row * ldg + col0 + bj * HALF); f32x4 g0, g1; unpack8(g, g0, g1);
                    *(u32x4*)(T + row * ldt + col0 + bj * HALF) = pack8(acc[ai][bj][m][0] * g0, acc[ai][bj][m][1] * g1); } }
    }
};
struct EpiMerge {
    static constexpr bool PERM = true, AFTER_DRAIN = false;
    const bf16_t* G; int ldg; const bf16_t* T; int ldt; bf16_t* O; int ldo;
    __device__ __forceinline__ void operator()(const f32x4 (&acc)[2][2][4][2], const Unit& u, int wr, int wc, int fr, int fq) const {
        const int row0 = u.pm * BM + wr * 64 + fr, col0 = u.pn * BM + wc * 32 + 8 * fq;
#pragma unroll
        for (int ai = 0; ai < 2; ++ai)
#pragma unroll
            for (int m = 0; m < 4; ++m) { const size_t row = (size_t)(row0 + ai * HALF + m * 16);
#pragma unroll
                for (int bj = 0; bj < 2; ++bj) { const u32x4 g = *(const u32x4*)(G + row * ldg + col0 + bj * HALF); f32x4 g0, g1; unpack8(g, g0, g1);
                    const u32x4 tv = *(const u32x4*)(T + row * ldt + col0 + bj * HALF); f32x4 t0, t1; unpack8(tv, t0, t1);
                    *(u32x4*)(O + row * ldo + col0 + bj * HALF) = pack8(t0 + acc[ai][bj][m][0] * g0, t1 + acc[ai][bj][m][1] * g1); } }
    }
};
template <bool MUL, bool XN> struct EpiResid {
    static constexpr bool PERM = true, AFTER_DRAIN = false;
    const float* base; float* out; const float* mul; bf16_t* xn; const float* gain; float* ss; int ld;
    __device__ __forceinline__ void operator()(const f32x4 (&acc)[2][2][4][2], const Unit& u, int wr, int wc, int fr, int fq) const {
        const int row0 = u.pm * BM + wr * 64 + fr, col0 = u.pn * BM + wc * 32 + 8 * fq;
        f32x4 gv[2][2];
#pragma unroll
        for (int bj = 0; bj < 2; ++bj) { if (XN) { gv[bj][0] = *(const f32x4*)(gain + col0 + bj * HALF); gv[bj][1] = *(const f32x4*)(gain + col0 + bj * HALF + 4); } else { gv[bj][0] = (f32x4){0.f, 0.f, 0.f, 0.f}; gv[bj][1] = gv[bj][0]; } }
#pragma unroll
        for (int ai = 0; ai < 2; ++ai) {
            f32x4 pre[4][2][2];
#pragma unroll
            for (int m = 0; m < 4; ++m)
#pragma unroll
                for (int bj = 0; bj < 2; ++bj) { const size_t p = (size_t)(row0 + ai * HALF + m * 16) * ld + col0 + bj * HALF; pre[m][bj][0] = *(const f32x4*)(base + p); pre[m][bj][1] = *(const f32x4*)(base + p + 4); }
            asm volatile("" ::: "memory");
#pragma unroll
            for (int m = 0; m < 4; ++m) { const size_t row = (size_t)(row0 + ai * HALF + m * 16); float s = 0.f;
#pragma unroll
                for (int bj = 0; bj < 2; ++bj) { const size_t p = row * ld + col0 + bj * HALF;
                    f32x4 v0 = acc[ai][bj][m][0], v1 = acc[ai][bj][m][1];
                    if (MUL) { v0 = v0 * *(const f32x4*)(mul + p); v1 = v1 * *(const f32x4*)(mul + p + 4); }
                    v0 = v0 + pre[m][bj][0]; v1 = v1 + pre[m][bj][1];
                    *(f32x4*)(out + p) = v0; *(f32x4*)(out + p + 4) = v1;
                    s += (v0[0] * v0[0] + v0[1] * v0[1]) + (v0[2] * v0[2] + v0[3] * v0[3]) + (v1[0] * v1[0] + v1[1] * v1[1]) + (v1[2] * v1[2] + v1[3] * v1[3]);
                    if (XN) *(u32x4*)(xn + p) = pack8(v0 * gv[bj][0], v1 * gv[bj][1]); }
                { const int ln = fr + 16 * fq; s += shx(s, ln, 16); s += shx(s, ln, 32); }
                if (fq == 0) ss[row * 16 + u.pn * 4 + wc] = s; }
            asm volatile("" ::: "memory");
        }
    }
};
template <bool BB> struct EpiResidB {
    static constexpr bool PERM = true, AFTER_DRAIN = false;
    const void* base; bf16_t* hs; float* ss; int ld;
    __device__ __forceinline__ void operator()(const f32x4 (&acc)[2][2][4][2], const Unit& u, int wr, int wc, int fr, int fq) const {
        const int row0 = u.pm * BM + wr * 64 + fr, col0 = u.pn * BM + wc * 32 + 8 * fq;
#pragma unroll
        for (int ai = 0; ai < 2; ++ai) {
            f32x4 pre[4][2][2];
#pragma unroll
            for (int m = 0; m < 4; ++m)
#pragma unroll
                for (int bj = 0; bj < 2; ++bj) { const size_t p = (size_t)(row0 + ai * HALF + m * 16) * ld + col0 + bj * HALF;
                    if (BB) { const u32x4 b = *(const u32x4*)((const bf16_t*)base + p); unpack8(b, pre[m][bj][0], pre[m][bj][1]); }
                    else { pre[m][bj][0] = *(const f32x4*)((const float*)base + p); pre[m][bj][1] = *(const f32x4*)((const float*)base + p + 4); } }
            asm volatile("" ::: "memory");
#pragma unroll
            for (int m = 0; m < 4; ++m) { const size_t row = (size_t)(row0 + ai * HALF + m * 16); float s = 0.f;
#pragma unroll
                for (int bj = 0; bj < 2; ++bj) { const size_t p = row * ld + col0 + bj * HALF;
                    const f32x4 v0 = acc[ai][bj][m][0] + pre[m][bj][0], v1 = acc[ai][bj][m][1] + pre[m][bj][1];
                    *(u32x4*)(hs + p) = pack8(v0, v1);
                    s += (v0[0] * v0[0] + v0[1] * v0[1]) + (v0[2] * v0[2] + v0[3] * v0[3]) + (v1[0] * v1[0] + v1[1] * v1[1]) + (v1[2] * v1[2] + v1[3] * v1[3]);
}
                { const int ln = fr + 16 * fq; s += shx(s, ln, 16); s += shx(s, ln, 32); }
                if (fq == 0) ss[row * 16 + u.pn * 4 + wc] = s; }
            asm volatile("" ::: "memory");
        }
    }
};
template <bool SIG> struct EpiScale {
    static constexpr bool PERM = true, AFTER_DRAIN = false;
    const float* ss; float inv_n, eps; bf16_t* O; float* F; int ldc;
    __device__ __forceinline__ void operator()(const f32x4 (&acc)[2][2][4][2], const Unit& u, int wr, int wc, int fr, int fq) const {
        const int row0 = u.pm * BM + wr * 64 + fr, col0 = u.pn * BM + wc * 32 + 8 * fq;
#pragma unroll
        for (int ai = 0; ai < 2; ++ai)
#pragma unroll
            for (int m = 0; m < 4; ++m) { const size_t row = (size_t)(row0 + ai * HALF + m * 16); const f32x4* sp = (const f32x4*)(ss + row * 16); const f32x4 sa = (sp[0] + sp[1]) + (sp[2] + sp[3]); const float r = __builtin_amdgcn_rsqf(((sa[0] + sa[1]) + (sa[2] + sa[3])) * inv_n + eps);
#pragma unroll
                for (int bj = 0; bj < 2; ++bj) { f32x4 v0 = acc[ai][bj][m][0] * r, v1 = acc[ai][bj][m][1] * r; const size_t p = row * ldc + col0 + bj * HALF;
                    if (SIG) {
#pragma unroll
                        for (int k = 0; k < 4; ++k) { v0[k] = sigm(v0[k]); v1[k] = sigm(v1[k]); }
                        *(f32x4*)(F + p) = v0; *(f32x4*)(F + p + 4) = v1;
                    } else *(u32x4*)(O + p) = pack8(v0, v1); } }
    }
};

struct EpiPle {
    static constexpr bool PERM = true, AFTER_DRAIN = false;
    const float* ss2; float inv_n, eps; const bf16_t* E; const bf16_t* hs; bf16_t* ho; float* ss3; int ld;
    __device__ __forceinline__ void operator()(const f32x4 (&acc)[2][2][4][2], const Unit& u, int wr, int wc, int fr, int fq) const {
        const int row0 = u.pm * BM + wr * 64 + fr, col0 = u.pn * BM + wc * 32 + 8 * fq;
#pragma unroll
        for (int ai = 0; ai < 2; ++ai)
#pragma unroll
          for (int mp = 0; mp < 2; ++mp) {
            f32x4 pre[2][2][2]; u32x4 ev[2][2]; f32x4 sv[2][4];
#pragma unroll
            for (int mm = 0; mm < 2; ++mm) { const size_t row = (size_t)(row0 + ai * HALF + (2 * mp + mm) * 16); const f32x4* sp = (const f32x4*)(ss2 + row * 16); sv[mm][0] = sp[0]; sv[mm][1] = sp[1]; sv[mm][2] = sp[2]; sv[mm][3] = sp[3];
#pragma unroll
                for (int bj = 0; bj < 2; ++bj) { const size_t p = row * ld + col0 + bj * HALF; { const u32x4 hb = *(const u32x4*)(hs + p); unpack8(hb, pre[mm][bj][0], pre[mm][bj][1]); } ev[mm][bj] = *(const u32x4*)(E + p); } }
            asm volatile("" ::: "memory");
#pragma unroll
            for (int mm = 0; mm < 2; ++mm) { const int m = 2 * mp + mm; const size_t row = (size_t)(row0 + ai * HALF + m * 16); float s = 0.f;
                const f32x4 sa = (sv[mm][0] + sv[mm][1]) + (sv[mm][2] + sv[mm][3]); const float r = __builtin_amdgcn_rsqf(((sa[0] + sa[1]) + (sa[2] + sa[3])) * inv_n + eps);
#pragma unroll
                for (int bj = 0; bj < 2; ++bj) { const size_t p = row * ld + col0 + bj * HALF;
                    f32x4 e0, e1; unpack8(ev[mm][bj], e0, e1);
                    f32x4 v0 = acc[ai][bj][m][0] * r, v1 = acc[ai][bj][m][1] * r;
#pragma unroll
                    for (int k = 0; k < 4; ++k) { v0[k] = sigm(v0[k]); v1[k] = sigm(v1[k]); }
                    v0 = v0 * e0 + pre[mm][bj][0]; v1 = v1 * e1 + pre[mm][bj][1];
                    *(u32x4*)(ho + p) = pack8(v0, v1);
                    s += (v0[0] * v0[0] + v0[1] * v0[1]) + (v0[2] * v0[2] + v0[3] * v0[3]) + (v1[0] * v1[0] + v1[1] * v1[1]) + (v1[2] * v1[2] + v1[3] * v1[3]); }
                { const int ln = fr + 16 * fq; s += shx(s, ln, 16); s += shx(s, ln, 32); }
                if (fq == 0) ss3[row * 16 + u.pn * 4 + wc] = s; }
            asm volatile("" ::: "memory");
          }
    }
};

template <class Epi, class Sched, bool ALIGN_EPI = false, bool SP2 = false>
__device__ __forceinline__ void gemm_phase(PG8_LAS unsigned char* lds, const Gemm g, const Sched& S, const Epi& E, int wave_s) {
    int tid_ = wave_s * 64 + lane_id_v(); asm volatile("" : "+v"(tid_));
    const int tid = tid_, wid = __builtin_amdgcn_readfirstlane(tid >> 6), lane = tid & 63, wr = wid >> 2, wc = wid & 3, fr = lane & 15, fq = lane >> 4;
    const int K = g.K, nt = K / BK;
    unsigned voffA[2], voffB[2];
#pragma unroll
    for (int i = 0; i < 2; ++i) { int R, C; stage_rc(tid * 16 + i * 8192, R, C); const int Rb = Epi::PERM ? ((R & ~31) + perm32(R & 31)) : R;
        voffA[i] = (unsigned)(R * K + C) * 2u; voffB[i] = (unsigned)(Rb * K + C) * 2u; }
    const size_t kstep = (size_t)(BK * 2);
    const size_t hstep = (size_t)HALF * K * 2;
    const size_t tstep = 2 * hstep;
    const unsigned ldsw = (unsigned)wid * 1024u;
    const int aoff = lds_byte(wr * 64 + fr, fq * 8), boff = lds_byte(wc * 32 + fr, fq * 8);
#define PG8_SA(b, h) (((b) * 2 + (h)) * HTB)
#define PG8_SB(b, h) ((4 + (b) * 2 + (h)) * HTB)
#define PG8_STAGE(bufoff, gbase, voff) do { _Pragma("unroll") for (int _i = 0; _i < 2; ++_i) \
        __builtin_amdgcn_global_load_lds((const unsigned*)((const char*)(gbase) + (voff)[_i]), (PG8_LAS unsigned*)(lds + (bufoff) + ldsw + _i * 8192), 16, 0, 0); } while (0)
#define PG8_LDA(dst, b, h) do { _Pragma("unroll") for (int m = 0; m < 4; ++m) _Pragma("unroll") for (int k = 0; k < 2; ++k) dst[m][k] = *(const PG8_LAS bf16x8*)(lds + PG8_SA(b, h) + aoff + m * 2048 + k * 1024); } while (0)
#define PG8_LDB(dst, b, h) do { _Pragma("unroll") for (int n = 0; n < 2; ++n) _Pragma("unroll") for (int k = 0; k < 2; ++k) dst[n][k] = *(const PG8_LAS bf16x8*)(lds + PG8_SB(b, h) + boff + n * 2048 + k * 1024); } while (0)
#define PG8_MMA(ai, bj, At, Bt) do { __builtin_amdgcn_s_setprio(1); _Pragma("unroll") for (int m = 0; m < 4; ++m) _Pragma("unroll") for (int n = 0; n < 2; ++n) _Pragma("unroll") for (int k = 0; k < 2; ++k) \
        acc[ai][bj][m][n] = __builtin_amdgcn_mfma_f32_16x16x32_bf16(Bt[n][k], At[m][k], acc[ai][bj][m][n], 0, 0, 0); __builtin_amdgcn_s_setprio(0); } while (0)
#define PG8_WAIT_V(n) asm volatile("s_waitcnt vmcnt(" #n ")" ::: "memory")
#define PG8_WAIT_L(n) asm volatile("s_waitcnt lgkmcnt(" #n ")" ::: "memory")
#define PG8_BAR __builtin_amdgcn_s_barrier()
#define PG8_SCHED __builtin_amdgcn_sched_barrier(0)
    Unit cur, nxt; int ui = 0;
    if (!S.next(0, cur)) return;
    f32x4 acc[2][2][4][2];
#pragma unroll
    for (int a = 0; a < 2; ++a)
#pragma unroll
        for (int b = 0; b < 2; ++b)
#pragma unroll
            for (int m = 0; m < 4; ++m)
#pragma unroll
                for (int n = 0; n < 2; ++n) acc[a][b][m][n] = (f32x4){0.f, 0.f, 0.f, 0.f};
    bf16x8 At[4][2], B0[2][2], B1[2][2];
    const char* cA = (const char*)g.A + (size_t)cur.pm * tstep; const char* cB = (const char*)g.Bt + (size_t)cur.pn * tstep;
    S.a_ready(cur);
    if constexpr (SP2) {
        PG8_STAGE(PG8_SB(0, 0), cB, voffB); PG8_STAGE(PG8_SB(0, 1), cB + hstep, voffB); PG8_STAGE(PG8_SA(0, 0), cA, voffA); PG8_STAGE(PG8_SA(0, 1), cA + hstep, voffA);
        if (wr == 1) PG8_BAR;
        PG8_WAIT_V(2); PG8_BAR;
        PG8_STAGE(PG8_SB(1, 0), cB + kstep, voffB); PG8_STAGE(PG8_SA(1, 0), cA + kstep, voffA); PG8_STAGE(PG8_SB(1, 1), cB + hstep + kstep, voffB);
        PG8_WAIT_V(6); PG8_BAR;
    } else {
        PG8_STAGE(PG8_SB(0, 0), cB, voffB); PG8_STAGE(PG8_SA(0, 0), cA, voffA); PG8_STAGE(PG8_SB(0, 1), cB + hstep, voffB); PG8_STAGE(PG8_SA(0, 1), cA + hstep, voffA);
        if (wr == 1) PG8_BAR;
        PG8_WAIT_V(4); PG8_BAR;
        PG8_STAGE(PG8_SB(1, 0), cB + kstep, voffB); PG8_STAGE(PG8_SA(1, 0), cA + kstep, voffA); PG8_STAGE(PG8_SB(1, 1), cB + hstep + kstep, voffB);
        PG8_WAIT_V(6); PG8_BAR;
    }
    for (;;) {
        const bool has_next = S.next(ui + 1, nxt);
        const char* nA = has_next ? (const char*)g.A + (size_t)nxt.pm * tstep : cA; const char* nB = has_next ? (const char*)g.Bt + (size_t)nxt.pn * tstep : cB;
        for (int t = 0; t < nt; t += 2) {
            const bool last = (t == nt - 2);
            const char* a1 = cA + (size_t)(t + 1) * kstep;
            const char* a2 = last ? nA : cA + (size_t)(t + 2) * kstep; const char* b2 = last ? nB : cB + (size_t)(t + 2) * kstep;
            const char* a3 = a2 + kstep; const char* b3 = b2 + kstep;
            if (last && has_next) S.a_ready(nxt);
            if constexpr (SP2) {
            PG8_LDB(B0, 0, 0); PG8_LDB(B1, 0, 1); PG8_SCHED; PG8_LDA(At, 0, 0); PG8_STAGE(PG8_SA(1, 1), a1 + hstep, voffA);
            PG8_WAIT_V(8); PG8_WAIT_L(0); PG8_BAR; PG8_MMA(0, 0, At, B0); PG8_MMA(0, 1, At, B1); PG8_BAR; PG8_SCHED;
            PG8_LDA(At, 0, 1); PG8_STAGE(PG8_SB(0, 0), b2, voffB); PG8_STAGE(PG8_SB(0, 1), b2 + hstep, voffB); PG8_STAGE(PG8_SA(0, 0), a2, voffA);
            PG8_WAIT_V(8); PG8_WAIT_L(0); PG8_BAR; PG8_MMA(1, 0, At, B0); PG8_MMA(1, 1, At, B1); PG8_BAR; PG8_SCHED;
            PG8_LDB(B0, 1, 0); PG8_LDB(B1, 1, 1); PG8_SCHED; PG8_LDA(At, 1, 0); PG8_STAGE(PG8_SA(0, 1), a2 + hstep, voffA);
            PG8_WAIT_V(8); PG8_WAIT_L(0); PG8_BAR; PG8_MMA(0, 0, At, B0); PG8_MMA(0, 1, At, B1); PG8_BAR; PG8_SCHED;
            PG8_LDA(At, 1, 1); PG8_STAGE(PG8_SB(1, 0), b3, voffB); PG8_STAGE(PG8_SB(1, 1), b3 + hstep, voffB); PG8_STAGE(PG8_SA(1, 0), a3, voffA);
            PG8_WAIT_V(8); PG8_WAIT_L(0); PG8_BAR; PG8_MMA(1, 0, At, B0); PG8_MMA(1, 1, At, B1); PG8_BAR; PG8_SCHED;
            } else {
            PG8_LDB(B0, 0, 0); PG8_SCHED; PG8_LDA(At, 0, 0); PG8_STAGE(PG8_SA(1, 1), a1 + hstep, voffA);
            PG8_WAIT_L(8); PG8_BAR; PG8_WAIT_L(0); PG8_MMA(0, 0, At, B0); PG8_BAR; PG8_SCHED;
            PG8_LDB(B1, 0, 1); PG8_STAGE(PG8_SB(0, 0), b2, voffB);
            PG8_BAR; PG8_WAIT_L(0); PG8_MMA(0, 1, At, B1); PG8_BAR;
            PG8_LDA(At, 0, 1); PG8_STAGE(PG8_SA(0, 0), a2, voffA);
            PG8_BAR; PG8_WAIT_L(0); PG8_MMA(1, 0, At, B0); PG8_BAR; PG8_SCHED;
            PG8_STAGE(PG8_SB(0, 1), b2 + hstep, voffB);
            PG8_WAIT_V(6); PG8_BAR; PG8_MMA(1, 1, At, B1); PG8_BAR;
            PG8_LDB(B0, 1, 0); PG8_SCHED; PG8_LDA(At, 1, 0); PG8_STAGE(PG8_SA(0, 1), a2 + hstep, voffA);
            PG8_WAIT_L(8); PG8_BAR; PG8_WAIT_L(0); PG8_MMA(0, 0, At, B0); PG8_BAR; PG8_SCHED;
            PG8_LDB(B1, 1, 1); PG8_STAGE(PG8_SB(1, 0), b3, voffB);
            PG8_BAR; PG8_WAIT_L(0); PG8_MMA(0, 1, At, B1); PG8_BAR;
            PG8_LDA(At, 1, 1); PG8_STAGE(PG8_SA(1, 0), a3, voffA);
            PG8_BAR; PG8_WAIT_L(0); PG8_MMA(1, 0, At, B0); PG8_BAR; PG8_SCHED;
            PG8_STAGE(PG8_SB(1, 1), b3 + hstep, voffB);
            PG8_WAIT_V(6); PG8_BAR; PG8_MMA(1, 1, At, B1); PG8_BAR;
            }
        }
        if constexpr (ALIGN_EPI) { if (wr == 0) PG8_BAR; }
        if constexpr (!Epi::AFTER_DRAIN) { E(acc, cur, wr, wc, fr, fq); S.done(cur); }
        if (!has_next) break;
#pragma unroll
        for (int a = 0; a < 2; ++a)
#pragma unroll
            for (int b = 0; b < 2; ++b)
#pragma unroll
                for (int m = 0; m < 4; ++m)
#pragma unroll
                    for (int n = 0; n < 2; ++n) acc[a][b][m][n] = (f32x4){0.f, 0.f, 0.f, 0.f};
        cur = nxt; cA = nA; cB = nB; ++ui;
        if constexpr (ALIGN_EPI) { if (wr == 1) PG8_BAR; }
    }
    PG8_WAIT_V(0);
    if constexpr (!ALIGN_EPI) { if (wr == 0) PG8_BAR; }
    PG8_BAR;
    if constexpr (Epi::AFTER_DRAIN) { E.fused(acc, cur, wr, wc, fr, fq, lds, wid, lane); S.done(cur); }
#undef PG8_SA
#undef PG8_SB
#undef PG8_STAGE
#undef PG8_LDA
#undef PG8_LDB
#undef PG8_MMA
#undef PG8_WAIT_V
#undef PG8_WAIT_L
#undef PG8_BAR
#undef PG8_SCHED
}
}

#ifndef PG8_SP2
#define PG8_SP2 true
#endif
#ifndef PG8_ALIGN
#define PG8_ALIGN true
#endif
#include <hip/hip_bf16.h>
#include <cmath>
#include <hip/hip_bf16.h>
#include <cmath>
namespace attn_body {
using bf16=__hip_bfloat16;
using bf16x8=__attribute__((ext_vector_type(8)))short;
using s16x4=__attribute__((ext_vector_type(4)))short;
using f32x16=__attribute__((ext_vector_type(16)))float;
using u32x4=__attribute__((ext_vector_type(4)))unsigned;
constexpr int BATCH=2,NHEAD=16,SEQ=8192,D=64,DM=NHEAD*D;
constexpr int NW=8,QBLK=32,QB=QBLK*NW,KVBLK=64,NQB=SEQ/QB;
constexpr int ATTN_PITCH=DM, ATTN_UNIT_ROWS=QB;
__device__ __forceinline__ int crow(int r,int hi){return (r&3)+8*(r>>2)+4*hi;}
#define SBAR() __builtin_amdgcn_sched_barrier(0)
__device__ __forceinline__ void cmask(f32x16&p0,f32x16&p1,int jb,int qrel,int hi){
  const float NEG=-INFINITY; int kb=64*jb+4*hi;
  #pragma unroll
  for(int r=0;r<16;++r){int kv=kb+(r&3)+8*(r>>2); if(kv>qrel)p0[r]=NEG; if(kv+32>qrel)p1[r]=NEG;}
}

constexpr int NSLOT=3, SLOTB=8192;
constexpr int LDS_K=0, LDS_V=NSLOT*SLOTB, LDS_WS=2*NSLOT*SLOTB, LDS_OST=LDS_WS+NW*64*4, LDS_BYTES=LDS_OST+NW*4096;
constexpr float C2=0.125f*1.4426950408889634f;
__device__ __forceinline__ void glds16(const void*gsrc,unsigned lds_dst){unsigned keep;
  asm volatile("s_mov_b32 %0, m0\n\ts_mov_b32 m0, %2\n\ts_nop 0\n\tglobal_load_lds_dwordx4 %1, off\n\ts_mov_b32 m0, %0":"=&s"(keep):"v"(gsrc),"s"(lds_dst):"memory");}
__device__ __forceinline__ float max3f(float a,float b,float c){float r;asm("v_max3_f32 %0, %1, %2, %3":"=v"(r):"v"(a),"v"(b),"v"(c));return r;}
__device__ __forceinline__ float max2f(float a,float b){float r;asm("v_max_f32_e32 %0, %1, %2":"=v"(r):"v"(a),"v"(b));return r;}
__device__ __forceinline__ float fadd_s(float a,float b){float r;asm("v_add_f32_e32 %0, %1, %2":"=v"(r):"v"(a),"v"(b));return r;}
__device__ __forceinline__ float fsub_s(float a,float b){float r;asm("v_sub_f32_e32 %0, %1, %2":"=v"(r):"v"(a),"v"(b));return r;}
typedef float f32x2_t __attribute__((ext_vector_type(2))); typedef __bf16 bf16x2_t __attribute__((ext_vector_type(2)));
__device__ __forceinline__ unsigned cvtpk_s(float lo,float hi){f32x2_t v={lo,hi};bf16x2_t b=__builtin_convertvector(v,bf16x2_t);return __builtin_bit_cast(unsigned,b);}
#define WAIT_BAR(N) asm volatile("s_waitcnt vmcnt(" #N ") lgkmcnt(0)\n\ts_barrier":::"memory")

__device__ __forceinline__ void qkt(f32x16&p0,f32x16&p1,const char*Kslot,const bf16x8*qr,const f32x16&negm,int r32,int hi){
  const char*kb=Kslot+hi*1024+r32*16;
  #pragma unroll
  for(int d0=0;d0<4;++d0){
    const bf16x8 b0=*reinterpret_cast<const bf16x8*>(kb+d0*2048);
    const bf16x8 b1=*reinterpret_cast<const bf16x8*>(kb+d0*2048+512);
    if(d0==0){p0=__builtin_amdgcn_mfma_f32_32x32x16_bf16(b0,qr[0],negm,0,0,0);p1=__builtin_amdgcn_mfma_f32_32x32x16_bf16(b1,qr[0],negm,0,0,0);}
    else{p0=__builtin_amdgcn_mfma_f32_32x32x16_bf16(b0,qr[d0],p0,0,0,0);p1=__builtin_amdgcn_mfma_f32_32x32x16_bf16(b1,qr[d0],p1,0,0,0);}}
}
typedef __attribute__((address_space(3))) const char* lds_cptr;
typedef short v4i16_t __attribute__((ext_vector_type(4)));
__device__ __forceinline__ void kload8(bf16x8*kf,lds_cptr kp){
  kf[0]=*(const __attribute__((address_space(3))) bf16x8*)(kp);      kf[1]=*(const __attribute__((address_space(3))) bf16x8*)(kp+512);
  kf[2]=*(const __attribute__((address_space(3))) bf16x8*)(kp+2048); kf[3]=*(const __attribute__((address_space(3))) bf16x8*)(kp+2560);
  kf[4]=*(const __attribute__((address_space(3))) bf16x8*)(kp+4096); kf[5]=*(const __attribute__((address_space(3))) bf16x8*)(kp+4608);
  kf[6]=*(const __attribute__((address_space(3))) bf16x8*)(kp+6144); kf[7]=*(const __attribute__((address_space(3))) bf16x8*)(kp+6656);
}
__device__ __forceinline__ void kload2(bf16x8*kf,lds_cptr kp,int j){ kf[2*j]=*(const __attribute__((address_space(3))) bf16x8*)(kp+j*2048); kf[2*j+1]=*(const __attribute__((address_space(3))) bf16x8*)(kp+j*2048+512); }
__device__ __forceinline__ s16x4 vtr(lds_cptr p){ return __builtin_bit_cast(s16x4,__builtin_amdgcn_ds_read_tr16_b64_v4i16((__attribute__((address_space(3))) v4i16_t*)p)); }
__device__ __forceinline__ float rowmax(const f32x16&p0,const f32x16&p1){
  float a=max3f(p0[0],p0[1],p1[0]),b=max3f(p0[2],p0[3],p1[1]);a=max3f(a,p1[2],p1[3]);
  #pragma unroll
  for(int r=4;r<16;r+=4){a=max3f(a,p0[r],p0[r+1]);b=max3f(b,p0[r+2],p0[r+3]);a=max3f(a,p1[r],p1[r+1]);b=max3f(b,p1[r+2],p1[r+3]);}
  const float m=max2f(a,b);
  auto rr=__builtin_amdgcn_permlane32_swap(__float_as_uint(m),__float_as_uint(m),false,false);
  return max2f(__uint_as_float(rr[0]),__uint_as_float(rr[1]));
}
__device__ __forceinline__ void pv(f32x16*o,int vb,bf16x8 pa0,bf16x8 pa1,bf16x8 pa2,bf16x8 pa3){
  #pragma unroll
  for(int d0=0;d0<2;++d0){s16x4 lo[4],hi[4];
    #pragma unroll
    for(int ks=0;ks<4;++ks){
      asm volatile("ds_read_b64_tr_b16 %0,%1 offset:%c2":"=&v"(lo[ks]):"v"(vb),"i"(d0*4096+ks*1024):"memory");
      asm volatile("ds_read_b64_tr_b16 %0,%1 offset:%c2":"=&v"(hi[ks]):"v"(vb),"i"(d0*4096+ks*1024+512):"memory");}
    asm volatile("s_waitcnt lgkmcnt(0)":::"memory");SBAR();
    #define PK(k) (bf16x8){lo[k][0],lo[k][1],lo[k][2],lo[k][3],hi[k][0],hi[k][1],hi[k][2],hi[k][3]}
    o[d0]=__builtin_amdgcn_mfma_f32_32x32x16_bf16(pa0,PK(0),o[d0],0,0,0);
    o[d0]=__builtin_amdgcn_mfma_f32_32x32x16_bf16(pa1,PK(1),o[d0],0,0,0);
    o[d0]=__builtin_amdgcn_mfma_f32_32x32x16_bf16(pa2,PK(2),o[d0],0,0,0);
    o[d0]=__builtin_amdgcn_mfma_f32_32x32x16_bf16(pa3,PK(3),o[d0],0,0,0);
    #undef PK
  }
}

#ifndef ATTN_STORE16
#define ATTN_STORE16(p,v) (*(u32x4*)(p)=(v))
#endif
template<int THRL> __device__ __forceinline__ void attn_unit(int qb,const bf16*Qh,const bf16*Kh,const bf16*Vh,bf16*Oh,int pq,int pk,int pv_,int po,char*shm,int wave_s){
  int tid_=wave_s*64+lane_id_v(); asm volatile("":"+v"(tid_)); const int tid=tid_,lane=tid&63,r32=lane&31,hi=lane>>5; const int wid=__builtin_amdgcn_readfirstlane(tid>>6);
  const int q0=qb*QB;
  const bf16*Qw=Qh+(long)(q0+wid*QBLK)*pq;
  const unsigned lds0=(unsigned)(uintptr_t)shm;
  float*wsf=(float*)(shm+LDS_WS)+wid*64;
  const bf16*ksrc=Kh+(long)lane*pk+wid*8;
  const bf16*vsrc=Vh+(long)(16*(wid&3)+(lane>>2))*pv_+(wid>>2)*32+(lane&3)*8;
  const unsigned kdst=lds0+LDS_K+wid*1024, vdst=lds0+LDS_V+wid*1024;
  #define DMA_K(t,slot) glds16(ksrc+(long)(t)*KVBLK*pk,(unsigned)__builtin_amdgcn_readfirstlane(kdst+(slot)))
  #define DMA_V(t,slot) glds16(vsrc+(long)(t)*KVBLK*pv_,(unsigned)__builtin_amdgcn_readfirstlane(vdst+(slot)))
  const int vb0=(int)(lds0+LDS_V)+((lane>>4)&1)*32+(lane&3)*8+(4*hi+((lane&15)>>2))*64;
  const char*Kbase=shm+LDS_K; bf16x8 kf[8];
  const lds_cptr shm3=(lds_cptr)shm; const lds_cptr kp0=shm3+LDS_K+hi*1024+r32*16; const lds_cptr vp0=shm3+LDS_V+((lane>>4)&1)*32+(lane&3)*8+(4*hi+((lane&15)>>2))*64;
  constexpr int NT=SEQ/KVBLK;
  DMA_K(0,0);DMA_V(0,0);DMA_K(1,SLOTB);
  bf16x8 qr[4];
  #pragma unroll
  for(int d0=0;d0<4;++d0)qr[d0]=*reinterpret_cast<const bf16x8*>(&Qw[(long)r32*pq+d0*16+hi*8]);
  float mhat=0.f,l_reg=0.f;f32x16 o[2];o[0]=f32x16{};o[1]=f32x16{};f32x16 negm=f32x16{};asm volatile("":"+v"(negm));

  #define CMASK(P0,P1,t) do{}while(0)
  bool resc=false;
  #define START(P0,P1) do{ const float rm=rowmax(P0,P1); resc=false; \
    { const float dl=rm; mhat=fadd_s(mhat,dl); \
      _Pragma("unroll") for(int r=0;r<16;++r){P0[r]=fsub_s(P0[r],dl);P1[r]=fsub_s(P1[r],dl);} \
      _Pragma("unroll") for(int r=0;r<16;++r)negm[r]=-mhat; asm volatile("":"+v"(negm)); } \
    _Pragma("unroll") for(int r=0;r<16;++r)P0[r]=__builtin_amdgcn_exp2f(P0[r]); }while(0)
  #define RESC() do{ if(resc){ asm volatile("s_waitcnt lgkmcnt(0)":::"memory"); \
      _Pragma("unroll") for(int d_=0;d_<2;++d_) _Pragma("unroll") for(int r=0;r<16;++r)o[d_][r]*=wsf[crow(r,hi)]; } }while(0)
  f32x16 pA0,pA1,pB0,pB1;
  int sl_prev=0,sl_cur=0,sl_next=SLOTB;
  #define ROT() do{sl_prev=sl_cur;sl_cur=sl_next;sl_next=(sl_next==(NSLOT-1)*SLOTB)?0:sl_next+SLOTB;}while(0)
  DMA_K(2,2*SLOTB);
  WAIT_BAR(3);
  qkt(pA0,pA1,Kbase,qr,negm,r32,hi);asm volatile("s_nop 15\n\ts_nop 7":"+v"(pA0),"+v"(pA1));CMASK(pA0,pA1,0);
  START(pA0,pA1);
  _Pragma("unroll") for(int r=0;r<16;++r)pA1[r]=__builtin_amdgcn_exp2f(pA1[r]);
  WAIT_BAR(0);
  DMA_K(3,0);DMA_V(1,SLOTB);
  ROT();
  kload8(kf,kp0+sl_cur);
  WAIT_BAR(2);
  s16x4 vlo[8],vhi[8]; u32x4 pw0,pw1,pw2,pw3;
  #define PKW(P,B) cvtpk_s(P[B],P[B+1])
  #define PAF(k) __builtin_bit_cast(bf16x8,pw##k)
  #define VFR(i) (bf16x8){vlo[i][0],vlo[i][1],vlo[i][2],vlo[i][3],vhi[i][0],vhi[i][1],vhi[i][2],vhi[i][3]}
  #define PIN(x) asm volatile("":"+v"(x))
  #define MX3(a,b,c) __builtin_fmaxf(__builtin_fmaxf((a),(b)),(c))
  #define GAPA(MF,A0,A1,A2,A3,W0,W1,PW) do{ MF; sacc+=A0; sacc+=A1; sacc+=A2; sacc+=A3; PIN(sacc); W0; W1; PIN(PW); SBAR(); }while(0)
  #define EX(v) __builtin_amdgcn_exp2f(v)
  #define GAPB(MF,X,B) do{ MF; X[B]=EX(X[B]); X[B+1]=EX(X[B+1]); X[B+2]=EX(X[B+2]); X[B+3]=EX(X[B+3]); PIN(X); SBAR(); }while(0)
  #define VRD(i) do{ vlo[i]=vtr(vp_+(((i)>>2)*4096+((i)&3)*1024)); vhi[i]=vtr(vp_+(((i)>>2)*4096+((i)&3)*1024+512)); }while(0)
  #define KRD(G,j) do{ if(G){ kload2(kf,kp0+sl_next,j); SBAR(); } }while(0)
  #define STEP(C0,C1,P0,P1,t,GK,GV,GL) do{ SBAR(); \
    const lds_cptr vp_=vp0+sl_prev; \
    VRD(0); SBAR(); float sacc=(P0[0]+P0[1]); \
    GAPA(C0=__builtin_amdgcn_mfma_f32_32x32x16_bf16(kf[0],qr[0],negm,0,0,0), P0[2],P0[3],P0[4],P0[5],     pw0[0]=PKW(P0,0), pw0[1]=PKW(P0,2), pw0); \
    VRD(4); SBAR(); GAPA(C1=__builtin_amdgcn_mfma_f32_32x32x16_bf16(kf[1],qr[0],negm,0,0,0), P0[6],P0[7],P0[8],P0[9],     pw0[2]=PKW(P0,4), pw0[3]=PKW(P0,6), pw0); \
    VRD(1); SBAR(); GAPA(C0=__builtin_amdgcn_mfma_f32_32x32x16_bf16(kf[2],qr[1],C0,0,0,0),   P0[10],P0[11],P0[12],P0[13], pw1[0]=PKW(P0,8), pw1[1]=PKW(P0,10), pw1); \
    VRD(5); SBAR(); GAPA(C1=__builtin_amdgcn_mfma_f32_32x32x16_bf16(kf[3],qr[1],C1,0,0,0),   P0[14],P0[15],P1[0],P1[1],   pw1[2]=PKW(P0,12),pw1[3]=PKW(P0,14), pw1); \
    VRD(2); SBAR(); GAPA(C0=__builtin_amdgcn_mfma_f32_32x32x16_bf16(kf[4],qr[2],C0,0,0,0),   P1[2],P1[3],P1[4],P1[5],     pw2[0]=PKW(P1,0), pw2[1]=PKW(P1,2), pw2); \
    VRD(6); SBAR(); GAPA(C1=__builtin_amdgcn_mfma_f32_32x32x16_bf16(kf[5],qr[2],C1,0,0,0),   P1[6],P1[7],P1[8],P1[9],     pw2[2]=PKW(P1,4), pw2[3]=PKW(P1,6), pw2); \
    VRD(3); SBAR(); GAPA(C0=__builtin_amdgcn_mfma_f32_32x32x16_bf16(kf[6],qr[3],C0,0,0,0),   P1[10],P1[11],P1[12],P1[13], pw3[0]=PKW(P1,8), pw3[1]=PKW(P1,10), pw3); \
    VRD(7); SBAR(); GAPA(C1=__builtin_amdgcn_mfma_f32_32x32x16_bf16(kf[7],qr[3],C1,0,0,0),   P1[14],P1[15],0.f,0.f,       pw3[2]=PKW(P1,12),pw3[3]=PKW(P1,14), pw3); \
    l_reg+=sacc; \
    if(GK){DMA_K((t)+3,sl_cur);} if(GV){DMA_V((t)+1,sl_next);} \
    CMASK(C0,C1,t); \
    { float a=MX3(C0[0],C0[1],C1[0]),b=MX3(C0[2],C0[3],C1[1]); a=MX3(a,C1[2],C1[3]); \
      _Pragma("unroll") for(int r=4;r<16;r+=4){a=MX3(a,C0[r],C0[r+1]);b=MX3(b,C0[r+2],C0[r+3]);a=MX3(a,C1[r],C1[r+1]);b=MX3(b,C1[r+2],C1[r+3]);} \
      float rm=__builtin_fmaxf(a,b); { auto rr=__builtin_amdgcn_permlane32_swap(__float_as_uint(rm),__float_as_uint(rm),false,false); rm=__builtin_fmaxf(__uint_as_float(rr[0]),__uint_as_float(rr[1])); } \
      resc=false; \
      if(__builtin_expect(__any(rm>(float)THRL),0)){ const float dl=__builtin_fmaxf(rm,0.f); mhat+=dl; \
        _Pragma("unroll") for(int r=0;r<16;++r){C0[r]-=dl;C1[r]-=dl;} \
        _Pragma("unroll") for(int r=0;r<16;++r)negm[r]=-mhat; asm volatile("":"+v"(negm)); \
        const float f=__builtin_amdgcn_exp2f(-dl); l_reg*=f; if(hi==0)wsf[r32]=f; resc=true; } } \
    SBAR(); \
    GAPB(o[0]=__builtin_amdgcn_mfma_f32_32x32x16_bf16(PAF(0),VFR(0),o[0],0,0,0), C0,0); \
    GAPB(o[1]=__builtin_amdgcn_mfma_f32_32x32x16_bf16(PAF(0),VFR(4),o[1],0,0,0), C0,4); \
    KRD(GL,0); GAPB(o[0]=__builtin_amdgcn_mfma_f32_32x32x16_bf16(PAF(1),VFR(1),o[0],0,0,0), C0,8); \
    KRD(GL,1); GAPB(o[1]=__builtin_amdgcn_mfma_f32_32x32x16_bf16(PAF(1),VFR(5),o[1],0,0,0), C0,12); \
    KRD(GL,2); GAPB(o[0]=__builtin_amdgcn_mfma_f32_32x32x16_bf16(PAF(2),VFR(2),o[0],0,0,0), C1,0); \
    KRD(GL,3); GAPB(o[1]=__builtin_amdgcn_mfma_f32_32x32x16_bf16(PAF(2),VFR(6),o[1],0,0,0), C1,4); \
    GAPB(o[0]=__builtin_amdgcn_mfma_f32_32x32x16_bf16(PAF(3),VFR(3),o[0],0,0,0), C1,8); \
    GAPB(o[1]=__builtin_amdgcn_mfma_f32_32x32x16_bf16(PAF(3),VFR(7),o[1],0,0,0), C1,12); \
    }while(0)
  int t=1;
  #undef CMASK
  #define CMASK(P0,P1,t) do{}while(0)
  for(;t+5<NT;t+=2){
    STEP(pB0,pB1,pA0,pA1,t,true,true,true);     WAIT_BAR(2); RESC(); ROT();
    STEP(pA0,pA1,pB0,pB1,t+1,true,true,true);   WAIT_BAR(2); RESC(); ROT();
  }
  #undef CMASK
  #define CMASK(P0,P1,t) do{}while(0)
  #define ENDW(tt) do{ if((tt)+3<NT){WAIT_BAR(2);} else if((tt)+2<NT){WAIT_BAR(1);} else {WAIT_BAR(0);} }while(0)
  for(;t+1<NT;t+=2){
    STEP(pB0,pB1,pA0,pA1,t,(t+3<NT),(t+1<NT),(t+1<NT));       ENDW(t);   RESC(); ROT();
    STEP(pA0,pA1,pB0,pB1,t+1,(t+4<NT),(t+2<NT),(t+2<NT));     ENDW(t+1); RESC(); ROT();
  }
  STEP(pB0,pB1,pA0,pA1,NT-1,false,false,false); RESC();
  { float sacc=pB0[0]+pB0[1]; _Pragma("unroll") for(int r=2;r<16;++r)sacc+=pB0[r]; _Pragma("unroll") for(int r=0;r<16;++r)sacc+=pB1[r]; l_reg+=sacc;
    pw0=(u32x4){PKW(pB0,0),PKW(pB0,2),PKW(pB0,4),PKW(pB0,6)};pw1=(u32x4){PKW(pB0,8),PKW(pB0,10),PKW(pB0,12),PKW(pB0,14)};pw2=(u32x4){PKW(pB1,0),PKW(pB1,2),PKW(pB1,4),PKW(pB1,6)};pw3=(u32x4){PKW(pB1,8),PKW(pB1,10),PKW(pB1,12),PKW(pB1,14)};
    SBAR(); pv(o,vb0+sl_cur,PAF(0),PAF(1),PAF(2),PAF(3)); }
  #undef PKW
  #undef PAF
  #undef VFR
  #undef PIN
  #undef MX3
  #undef GAPA
  #undef GAPB
  #undef EX
  #undef VRD
  #undef KRD
  #undef STEP
  #undef ENDW
  {auto rr=__builtin_amdgcn_permlane32_swap(__float_as_uint(l_reg),__float_as_uint(l_reg),false,false);l_reg=__uint_as_float(rr[0])+__uint_as_float(rr[1]);}
  if(hi==0)wsf[32+r32]=l_reg;asm volatile("s_waitcnt lgkmcnt(0)":::"memory");
  float rli[16];
  #pragma unroll
  for(int r=0;r<16;++r)rli[r]=__builtin_amdgcn_rcpf(wsf[32+crow(r,hi)]);
  bf16*Ow=Oh+(long)(q0+wid*QBLK)*po;
  { bf16*stg=(bf16*)(shm+LDS_OST)+wid*2048;
    #pragma unroll
    for(int r=0;r<16;++r){const int orow=crow(r,hi);
      #pragma unroll
      for(int d0=0;d0<2;++d0)stg[orow*64+d0*32+r32]=__float2bfloat16(o[d0][r]*rli[r]);}
    asm volatile("s_waitcnt lgkmcnt(0)":::"memory");
    #pragma unroll
    for(int i=0;i<4;++i){const int row=i*8+(lane>>3),ch=lane&7; const u32x4 v=*(const u32x4*)(stg+row*64+ch*8); ATTN_STORE16(Ow+(long)row*po+ch*8,v);} }
  asm volatile("s_waitcnt lgkmcnt(0)\n\ts_barrier":::"memory");
  #undef DMA_K
  #undef DMA_V
  #undef CMASK
  #undef START
  #undef RESC
  #undef ROT
}
#undef SBAR
#undef WAIT_BAR
}
namespace attn128 {
using bf16 = __hip_bfloat16;
using bf16x8 = __attribute__((ext_vector_type(8))) short;
using s16x4  = __attribute__((ext_vector_type(4))) short;
using f32x16 = __attribute__((ext_vector_type(16))) float;
using u32x4  = __attribute__((ext_vector_type(4))) unsigned;
constexpr int NW = 8, QBLK = 32, KVBLK = 64, SEQ = 8192;
constexpr float THR = 8.f;
constexpr size_t SHM_V = KVBLK * 128 * 2, SHM_K = KVBLK * 64 * 2, SHM_ATTN = 2 * SHM_V + 2 * SHM_K + NW * 64 * 4;
#define KSWZ64(row, colB) ((row) * 128 + ((colB) ^ ((((row) >> 1) & 7) << 4)))
#define SBAR() __builtin_amdgcn_sched_barrier(0)
#define WGBAR() asm volatile("s_waitcnt lgkmcnt(0)\n\ts_barrier" ::: "memory")
__device__ __forceinline__ int crow(int r, int hi) { return (r & 3) + 8 * (r >> 2) + 4 * hi; }
__device__ __forceinline__ unsigned cvtpk(float lo, float hi) { unsigned r; asm volatile("v_cvt_pk_bf16_f32 %0, %1, %2" : "=v"(r) : "v"(lo), "v"(hi)); return r; }
template <bool FIRST> __device__ __forceinline__ void partialSM(f32x16& p0, f32x16& p1, float& m_reg, f32x16& negm, float& alpha) {
  float pmax = p0[0];
#pragma unroll
  for (int r = 1; r < 16; ++r) pmax = fmaxf(pmax, p0[r]);
#pragma unroll
  for (int r = 0; r < 16; ++r) pmax = fmaxf(pmax, p1[r]);
  { auto rr = __builtin_amdgcn_permlane32_swap(__float_as_uint(pmax), __float_as_uint(pmax), false, false);
    pmax = fmaxf(__uint_as_float(rr[0]), __uint_as_float(rr[1])); }
  if (!FIRST && __builtin_expect(__all(pmax <= THR), 1)) { alpha = 1.f; }
  else { const float d = FIRST ? pmax : fmaxf(pmax, 0.f); alpha = FIRST ? 1.f : __builtin_amdgcn_exp2f(-d); m_reg += d;
#pragma unroll
    for (int r = 0; r < 16; ++r) { p0[r] -= d; p1[r] -= d; }
#pragma unroll
    for (int r = 0; r < 16; ++r) negm[r] = -m_reg;
    asm volatile("" : "+v"(negm)); }
#pragma unroll
  for (int r = 0; r < 16; ++r) p0[r] = __builtin_amdgcn_exp2f(p0[r]);
}
__device__ __forceinline__ void finishSM(f32x16& p0, f32x16& p1, float alpha, float& l_reg, bf16x8& pa0, bf16x8& pa1, bf16x8& pa2, bf16x8& pa3) {
#pragma unroll
  for (int r = 0; r < 16; ++r) p1[r] = __builtin_amdgcn_exp2f(p1[r]);
  float ps = 0;
#pragma unroll
  for (int r = 0; r < 16; ++r) ps += p0[r];
#pragma unroll
  for (int r = 0; r < 16; ++r) ps += p1[r];
  { auto rr = __builtin_amdgcn_permlane32_swap(__float_as_uint(ps), __float_as_uint(ps), false, false);
    ps = __uint_as_float(rr[0]) + __uint_as_float(rr[1]); }
  l_reg = l_reg * alpha + ps;
#define PK4(P, BASE, OUT) do { unsigned a0 = cvtpk(P[BASE + 0], P[BASE + 1]), a1 = cvtpk(P[BASE + 2], P[BASE + 3]);   \
    unsigned b0 = cvtpk(P[BASE + 4], P[BASE + 5]), b1 = cvtpk(P[BASE + 6], P[BASE + 7]);                              \
    auto r0 = __builtin_amdgcn_permlane32_swap(a0, b0, false, false); auto r1 = __builtin_amdgcn_permlane32_swap(a1, b1, false, false); \
    u32x4 w = {r0[0], r1[0], r0[1], r1[1]}; OUT = *reinterpret_cast<bf16x8*>(&w); } while (0)
  PK4(p0, 0, pa0); PK4(p0, 8, pa1); PK4(p1, 0, pa2); PK4(p1, 8, pa3);
#undef PK4
}
__device__ __forceinline__ void qkt(f32x16& p0, f32x16& p1, const char* Ks, const bf16x8* qr, const f32x16& negm, int r32, int hi) {
  p0 = negm; p1 = negm;
#pragma unroll
  for (int d0 = 0; d0 < 4; ++d0) { const int cb = (d0 * 16 + hi * 8) * 2;
    bf16x8 b0 = *reinterpret_cast<const bf16x8*>(Ks + KSWZ64(r32, cb));
    bf16x8 b1 = *reinterpret_cast<const bf16x8*>(Ks + KSWZ64(32 + r32, cb));
    p0 = __builtin_amdgcn_mfma_f32_32x32x16_bf16(b0, qr[d0], p0, 0, 0, 0);
    p1 = __builtin_amdgcn_mfma_f32_32x32x16_bf16(b1, qr[d0], p1, 0, 0, 0); }
}
__device__ __forceinline__ int v_st(int k, int c) { const int kk = (k & ~0xC) | ((k & 4) << 1) | ((k & 8) >> 1); return ((kk >> 3) * 4 + (c >> 5)) * 512 + ((kk & 7) * 32 + (c & 31)) * 2; }
__device__ __forceinline__ int v_rd_base(int lane) { return ((lane & 3) << 3) | (((lane >> 2) & 3) << 6) | (((lane >> 4) & 1) << 5) | (((lane >> 5) & 1) << 8); }
constexpr int v_rd_off(int d0, int ks, int half) { return d0 * 512 + ks * 4096 + half * 2048; }
template <int OFF> __device__ __forceinline__ s16x4 tr_read(int vb) { s16x4 r; asm volatile("ds_read_b64_tr_b16 %0, %1 offset:%2" : "=&v"(r) : "v"(vb), "i"(OFF) : "memory"); return r; }
template <int D0> __device__ __forceinline__ void pv_one(f32x16& od, int vb, bf16x8 pa0, bf16x8 pa1, bf16x8 pa2, bf16x8 pa3) {
  const s16x4 l0 = tr_read<v_rd_off(D0, 0, 0)>(vb), h0 = tr_read<v_rd_off(D0, 0, 1)>(vb), l1 = tr_read<v_rd_off(D0, 1, 0)>(vb), h1 = tr_read<v_rd_off(D0, 1, 1)>(vb);
  const s16x4 l2 = tr_read<v_rd_off(D0, 2, 0)>(vb), h2 = tr_read<v_rd_off(D0, 2, 1)>(vb), l3 = tr_read<v_rd_off(D0, 3, 0)>(vb), h3 = tr_read<v_rd_off(D0, 3, 1)>(vb);
  asm volatile("s_waitcnt lgkmcnt(0)" ::: "memory"); SBAR();
#define PK(L, H) (bf16x8){L[0], L[1], L[2], L[3], H[0], H[1], H[2], H[3]}
  od = __builtin_amdgcn_mfma_f32_32x32x16_bf16(pa0, PK(l0, h0), od, 0, 0, 0);
  od = __builtin_amdgcn_mfma_f32_32x32x16_bf16(pa1, PK(l1, h1), od, 0, 0, 0);
  od = __builtin_amdgcn_mfma_f32_32x32x16_bf16(pa2, PK(l2, h2), od, 0, 0, 0);
  od = __builtin_amdgcn_mfma_f32_32x32x16_bf16(pa3, PK(l3, h3), od, 0, 0, 0);
#undef PK
}
#define PV_RD(F, D0) do { F[0] = tr_read<v_rd_off(D0, 0, 0)>(vb); F[1] = tr_read<v_rd_off(D0, 0, 1)>(vb); F[2] = tr_read<v_rd_off(D0, 1, 0)>(vb); F[3] = tr_read<v_rd_off(D0, 1, 1)>(vb); \
    F[4] = tr_read<v_rd_off(D0, 2, 0)>(vb); F[5] = tr_read<v_rd_off(D0, 2, 1)>(vb); F[6] = tr_read<v_rd_off(D0, 3, 0)>(vb); F[7] = tr_read<v_rd_off(D0, 3, 1)>(vb); } while (0)
#define PV_PK(L, H) (bf16x8){L[0], L[1], L[2], L[3], H[0], H[1], H[2], H[3]}
#define PV_MF(OD, F) do { OD = __builtin_amdgcn_mfma_f32_32x32x16_bf16(pa0, PV_PK(F[0], F[1]), OD, 0, 0, 0); OD = __builtin_amdgcn_mfma_f32_32x32x16_bf16(pa1, PV_PK(F[2], F[3]), OD, 0, 0, 0); \
    OD = __builtin_amdgcn_mfma_f32_32x32x16_bf16(pa2, PV_PK(F[4], F[5]), OD, 0, 0, 0); OD = __builtin_amdgcn_mfma_f32_32x32x16_bf16(pa3, PV_PK(F[6], F[7]), OD, 0, 0, 0); } while (0)
__device__ __forceinline__ void pv_d0(f32x16* o, int vb, bf16x8 pa0, bf16x8 pa1, bf16x8 pa2, bf16x8 pa3) {
  s16x4 fa[8], fb[8];
  PV_RD(fa, 0); PV_RD(fb, 1);
  asm volatile("s_waitcnt lgkmcnt(8)" ::: "memory"); SBAR();
  PV_MF(o[0], fa); SBAR();
  PV_RD(fa, 2);
  asm volatile("s_waitcnt lgkmcnt(8)" ::: "memory"); SBAR();
  PV_MF(o[1], fb); SBAR();
  PV_RD(fb, 3);
  asm volatile("s_waitcnt lgkmcnt(8)" ::: "memory"); SBAR();
  PV_MF(o[2], fa); SBAR();
  asm volatile("s_waitcnt lgkmcnt(0)" ::: "memory"); SBAR();
  PV_MF(o[3], fb);
}
#undef PV_RD
#undef PV_PK
#undef PV_MF
__device__ __forceinline__ void attn128_unit(int qb, const bf16* __restrict__ Qh0, const bf16* __restrict__ Kh0, const bf16* __restrict__ Vh, bf16* __restrict__ Oh,
                                             int pq, int pk, int pv_, int po, char* lds, int wave_s, float lam, const float* __restrict__ gdiff) {
#pragma nounroll
 for (int jmap = 0; jmap < 2; ++jmap) {
  const bf16* __restrict__ Qh = Qh0 + jmap * 64; const bf16* __restrict__ Kh = Kh0 + jmap * 64;
  int tid_ = wave_s * 64 + lane_id_v(); asm volatile("" : "+v"(tid_));
  const int tid = tid_, wid = wave_s, lane = tid & 63, r32 = lane & 31, hi = lane >> 5;
  char* V_lds = lds; char* K_lds = lds + 2 * SHM_V;
  float* ws = (float*)(lds + 2 * SHM_V + 2 * SHM_K) + wid * 64; float* li_l = ws; float* al_l = ws + 32;
  float m_reg = 0.f, l_reg = 0; bf16x8 qr[4];
  float z_ = 0.f; asm volatile("" : "+v"(z_));
  f32x16 negm, o[4];
#pragma unroll
  for (int r = 0; r < 16; ++r) { negm[r] = z_; o[0][r] = z_; o[1][r] = z_; o[2][r] = z_; o[3][r] = z_; }
  asm volatile("" : "+v"(negm));
  const bf16* Qw = Qh + (long)(qb * 256 + wid * QBLK + r32) * pq + hi * 8;
#pragma unroll
  for (int d0 = 0; d0 < 4; ++d0) qr[d0] = *reinterpret_cast<const bf16x8*>(Qw + d0 * 16);
  const int sr = tid >> 4, sc = (tid & 15) * 8, vst0 = v_st(sr, sc), vst1 = v_st(32 + sr, sc);
  const int kr = tid >> 3, kc = (tid & 7) * 8, kst = KSWZ64(kr, kc * 2);
  const int vb0 = (int)(uintptr_t)V_lds + v_rd_base(lane);
  struct { bf16x8 vs0, vs1, ks0; } sr_[2];
#define SLOAD(i, k0) do { sr_[i].vs0 = *reinterpret_cast<const bf16x8*>(&Vh[(long)((k0) + sr) * pv_ + sc]); sr_[i].vs1 = *reinterpret_cast<const bf16x8*>(&Vh[(long)((k0) + 32 + sr) * pv_ + sc]); \
    sr_[i].ks0 = *reinterpret_cast<const bf16x8*>(&Kh[(long)((k0) + kr) * pk + kc]); } while (0)
#define SWRITE(b, i) do { *(bf16x8*)(V_lds + (b) * SHM_V + vst0) = sr_[i].vs0; *(bf16x8*)(V_lds + (b) * SHM_V + vst1) = sr_[i].vs1; \
    *(bf16x8*)(K_lds + (b) * SHM_K + kst) = sr_[i].ks0; } while (0)
#define SWAIT() asm volatile("s_waitcnt vmcnt(3)" ::: "memory")
#define RESC(a) do { if (__any((a) < 1.f)) { if (hi == 0) al_l[r32] = (a); asm volatile("s_waitcnt lgkmcnt(0)" ::: "memory"); \
    _Pragma("unroll") for (int d = 0; d < 4; ++d) _Pragma("unroll") for (int r = 0; r < 16; ++r) o[d][r] *= al_l[crow(r, hi)]; } } while (0)
  f32x16 pA0, pA1, pB0, pB1; float alA, alB; bf16x8 pa0, pa1, pa2, pa3; constexpr int NT = SEQ / KVBLK;
  constexpr int SE = 0, SO = 1;
  SLOAD(SE, 0); asm volatile("s_waitcnt vmcnt(0)" ::: "memory"); SWRITE(0, SE); WGBAR();
  qkt(pA0, pA1, K_lds, qr, negm, r32, hi); partialSM<true>(pA0, pA1, m_reg, negm, alA);
  SLOAD(SO, KVBLK); SLOAD(SE, 2 * KVBLK);
  SWAIT(); SWRITE(1, SO); WGBAR();
  for (int j = 1; j + 1 < NT; j += 2) {
    SBAR(); qkt(pB0, pB1, K_lds + SHM_K, qr, negm, r32, hi);
    finishSM(pA0, pA1, alA, l_reg, pa0, pa1, pa2, pa3); SBAR();
    SLOAD(SO, (j + 2) * KVBLK); SBAR();
    pv_d0(o, vb0, pa0, pa1, pa2, pa3); partialSM<false>(pB0, pB1, m_reg, negm, alB);
    WGBAR(); SWAIT(); SWRITE(0, SE);
    RESC(alB); WGBAR();
    SBAR(); qkt(pA0, pA1, K_lds, qr, negm, r32, hi);
    finishSM(pB0, pB1, alB, l_reg, pa0, pa1, pa2, pa3); SBAR();
    if (j + 3 < NT) SLOAD(SE, (j + 3) * KVBLK); SBAR();
    pv_d0(o, vb0 + (int)SHM_V, pa0, pa1, pa2, pa3); partialSM<false>(pA0, pA1, m_reg, negm, alA);
    WGBAR(); SWAIT(); SWRITE(1, SO);
    RESC(alA); WGBAR();
  }
  SBAR(); qkt(pB0, pB1, K_lds + SHM_K, qr, negm, r32, hi);
  finishSM(pA0, pA1, alA, l_reg, pa0, pa1, pa2, pa3); SBAR();
  pv_d0(o, vb0, pa0, pa1, pa2, pa3); partialSM<false>(pB0, pB1, m_reg, negm, alB);
  WGBAR(); RESC(alB);
  finishSM(pB0, pB1, alB, l_reg, pa0, pa1, pa2, pa3); SBAR();
  pv_d0(o, vb0 + (int)SHM_V, pa0, pa1, pa2, pa3);
  if (hi == 0) li_l[r32] = l_reg; asm volatile("s_waitcnt lgkmcnt(0)" ::: "memory");
  float rli[16];
#pragma unroll
  for (int r = 0; r < 16; ++r) rli[r] = __builtin_amdgcn_rcpf(li_l[crow(r, hi)]);
  unsigned short* stash = (unsigned short*)(lds + SHM_ATTN) + wid * 4096;
  if (jmap == 0) {
#pragma unroll
    for (int r = 0; r < 16; ++r) { const int orow = crow(r, hi);
#pragma unroll
      for (int d0 = 0; d0 < 4; ++d0) { const bf16 v = __float2bfloat16(o[d0][r] * rli[r]); stash[orow * 128 + d0 * 32 + r32] = __builtin_bit_cast(unsigned short, v); } }
  } else {
    float ssq[16];
#pragma unroll
    for (int r = 0; r < 16; ++r) { const int orow = crow(r, hi); float q = 0.f;
#pragma unroll
      for (int d0 = 0; d0 < 4; ++d0) { const float o1 = __uint_as_float((unsigned)stash[orow * 128 + d0 * 32 + r32] << 16); const float v = o1 - lam * (o[d0][r] * rli[r]); o[d0][r] = v; q += v * v; }
      ssq[r] = q; }
#pragma unroll
    for (int msk = 1; msk < 32; msk <<= 1)
#pragma unroll
      for (int r = 0; r < 16; ++r) ssq[r] += shx(ssq[r], lane, msk);
    float gd[4];
#pragma unroll
    for (int d0 = 0; d0 < 4; ++d0) gd[d0] = gdiff[d0 * 32 + r32] * 0.8f;
    bf16* Ow = Oh + (long)(qb * 256 + wid * QBLK) * po;
#pragma unroll
    for (int r = 0; r < 16; ++r) { const int orow = crow(r, hi); const float rs = __builtin_amdgcn_rsqf(ssq[r] * (1.f / 128.f) + 1e-6f);
#pragma unroll
      for (int d0 = 0; d0 < 4; ++d0) Ow[(long)orow * po + d0 * 32 + r32] = __float2bfloat16(o[d0][r] * rs * gd[d0]); }
  }
  WGBAR();
 }
#undef SLOAD
#undef SWRITE
#undef SWAIT
#undef RESC
}
#undef KSWZ64
#undef SBAR
#undef WGBAR
}
#define LAS __attribute__((address_space(3)))
#define XB_TMO      128
#define XB_XCNT(j)  (256  + 64 * (j))
#define XB_XSUB(j)  (1280 + 64 * (j))
#define XB_XGEN(j)  (2304 + 64 * (j))
#define XB_TOP      3328
#define XB_TOPGEN   3392
#define XCD_BAR_WORDS 3456
#define XB_SPIN_CAP (1u << 18)

__device__ __forceinline__ unsigned xb_ld(unsigned* p)              { return __hip_atomic_load(p, __ATOMIC_RELAXED, __HIP_MEMORY_SCOPE_AGENT); }
__device__ __forceinline__ unsigned xb_add(unsigned* p, unsigned v) { return __hip_atomic_fetch_add(p, v, __ATOMIC_RELAXED, __HIP_MEMORY_SCOPE_AGENT); }
__device__ __forceinline__ unsigned xb_xcc_id() { return (unsigned)__builtin_amdgcn_s_getreg((3 << 11) | 20) & 0xFu; }
#define XB_SPIN(cond, bar) do { unsigned _sp = 0; while (cond) { __builtin_amdgcn_s_sleep(1); \
    if ((++_sp & 255u) == 0u) { if (xb_ld(&(bar)[XB_TMO])) break; if (_sp > XB_SPIN_CAP) { atomicAdd(&(bar)[XB_TMO], 1u); break; } } } } while (0)

struct XcdBarrier {
    unsigned* bar; unsigned x;
    volatile LAS unsigned* st; bool leader;
};

__device__ __forceinline__ XcdBarrier xcd_barrier_post(unsigned* bar, volatile LAS unsigned* st, bool leader) {
    XcdBarrier b; b.bar = bar; b.x = xb_xcc_id(); b.st = st; b.leader = leader;
    if (leader) (void)xb_add(&bar[XB_XCNT(b.x)], 1u);
    return b;
}
__device__ __forceinline__ void xcd_barrier_complete(unsigned* bar, unsigned x, unsigned& nloc, unsigned& nx) {
    const unsigned G = gridDim.x * gridDim.y * gridDim.z;
    unsigned sum, cnt, mine, sp = 0u;
    for (;;) {
        sum = 0u; cnt = 0u; mine = 0u;
#pragma unroll
        for (unsigned j = 0; j < 16; ++j) { const unsigned c = xb_ld(&bar[XB_XCNT(j)]); sum += c; cnt += (c > 0u) ? 1u : 0u; mine = (j == x) ? c : mine; }
        if (sum == G) break;
        __builtin_amdgcn_s_sleep(1);
        if ((++sp & 255u) == 0u) { if (xb_ld(&bar[XB_TMO])) break; if (sp > XB_SPIN_CAP) { atomicAdd(&bar[XB_TMO], 1u); break; } }
    }
    nloc = mine > 0u ? mine : 1u; nx = cnt > 0u ? cnt : 1u;
}

__device__ __forceinline__ void xcd_barrier(const XcdBarrier& b) {
    asm volatile("s_waitcnt vmcnt(0)" ::: "memory");
    __syncthreads();
    if (b.leader) {
        unsigned* bar = b.bar;
        __builtin_amdgcn_s_waitcnt(0);
        unsigned nloc = b.st[0], nx = b.st[1];
        if (nloc == 0u) { xcd_barrier_complete(bar, b.x, nloc, nx); b.st[0] = nloc; b.st[1] = nx; }
        const unsigned old = xb_add(&bar[XB_XSUB(b.x)], 1u);
        const unsigned gen = old / nloc;
        if (old + 1u == (gen + 1u) * nloc) {
            __builtin_amdgcn_fence(__ATOMIC_RELEASE, "agent");
            asm volatile("s_waitcnt vmcnt(0)" ::: "memory");
            const unsigned og = xb_add(&bar[XB_TOP], 1u);
            const unsigned tg = og / nx;
            if (og + 1u == (tg + 1u) * nx) xb_add(&bar[XB_TOPGEN], 1u);
            else XB_SPIN(xb_ld(&bar[XB_TOPGEN]) == tg, bar);
            __builtin_amdgcn_fence(__ATOMIC_ACQUIRE, "agent");
            xb_add(&bar[XB_XGEN(b.x)], 1u);
            asm volatile("s_waitcnt vmcnt(0)" ::: "memory");
        } else {
            XB_SPIN(xb_ld(&bar[XB_XGEN(b.x)]) == gen, bar);
            __builtin_amdgcn_fence(__ATOMIC_ACQUIRE, "agent");
            asm volatile("s_waitcnt vmcnt(0)" ::: "memory");
        }
    }
    __syncthreads();
}
#undef LAS
namespace cg = cooperative_groups;
#ifndef PG8_ALIGN1
#define PG8_ALIGN1 PG8_ALIGN
#endif
#ifndef PROBE_REP64
#define PROBE_REP64 1
#endif
#ifndef PROBE_REP128
#define PROBE_REP128 1
#endif
#ifndef NCHUNK_DEF
#define NCHUNK_DEF 3
#endif
constexpr int NWAVES = 8;
constexpr int SEQ = 8192, DM = 1024, MC = 16384  , NCHUNK = NCHUNK_DEF, NPROJ = 6656, DFF = 2816, NUP = 2 * DFF, PLE = 256;
constexpr int C_AQ = 0, C_AK = 1024, C_AV = 2048, C_BQ = 3072, C_BK = 4096, C_BV = 4352, C_GA = 4608, C_GB = 5632;
constexpr float EPS = 1e-6f;
constexpr float QSCALE = 0.125f * 1.4426950408889634f;
constexpr size_t MiB = 1u << 20;
constexpr size_t WS_SS = 420 * MiB;
constexpr size_t WS_TABA = 1 * MiB;
constexpr size_t WS_TABX = 1 * MiB + 512 * 1024;
constexpr size_t WS_WIN = 2 * MiB, WS_WA = 15 * MiB, WS_WB = 17 * MiB, WS_WOUT = 19 * MiB, WS_WUP = 21 * MiB, WS_WDN = 32 * MiB, WS_WPLE = 38 * MiB, WS_WPG = 39 * MiB;
constexpr size_t WS_XN = 42 * MiB;
constexpr size_t WS_PB = 74 * MiB;
constexpr size_t WS_PROJ = 82 * MiB;
constexpr size_t WS_U = WS_PROJ;
constexpr size_t WS_SG = WS_PROJ;
constexpr size_t WS_OA1 = 290 * MiB, WS_OA2 = 322 * MiB, WS_OB = 354 * MiB, WS_MG = WS_OA1  , WS_HS = 386 * MiB  ;
constexpr size_t WS_ACT = WS_OA1;
constexpr size_t WS_E = 424 * MiB;
constexpr size_t WS_XNB = 456 * MiB;
constexpr size_t WS_END = 488 * MiB;
constexpr int LDS_BYTES = 147456, MISC_OFF = 131072 + 320;
constexpr size_t WS_EPS = 1 * MiB + 800 * 1024;
constexpr size_t WS_BAR = 1 * MiB + 768 * 1024;

#define GAS __attribute__((address_space(1)))
#define LAS __attribute__((address_space(3)))
typedef unsigned short bf16_t;
typedef unsigned v4u __attribute__((ext_vector_type(4)));
typedef unsigned v2u __attribute__((ext_vector_type(2)));
typedef float f32x4 __attribute__((ext_vector_type(4)));
#define LDS_WAIT() asm volatile("s_waitcnt lgkmcnt(0)" ::: "memory")
__device__ __forceinline__ unsigned f2bf(float f) { unsigned u = __builtin_bit_cast(unsigned, f); return (u + 0x7fffu + ((u >> 16) & 1u)) >> 16; }
__device__ __forceinline__ unsigned pk2(float lo, float hi) { return f2bf(lo) | (f2bf(hi) << 16); }
__device__ __forceinline__ float wave_sum(float v, int lane) {
#pragma unroll
    for (int o = 1; o < 64; o <<= 1) v += shx(v, lane, o);
    return v;
}
__device__ __forceinline__ void unpack16(const v4u a, const v4u b, float (&x)[16]) {
    x[0] = pg8::bf_lo(a.x); x[1] = pg8::bf_hi(a.x); x[2] = pg8::bf_lo(a.y); x[3] = pg8::bf_hi(a.y); x[4] = pg8::bf_lo(a.z); x[5] = pg8::bf_hi(a.z); x[6] = pg8::bf_lo(a.w); x[7] = pg8::bf_hi(a.w);
    x[8] = pg8::bf_lo(b.x); x[9] = pg8::bf_hi(b.x); x[10] = pg8::bf_lo(b.y); x[11] = pg8::bf_hi(b.y); x[12] = pg8::bf_lo(b.z); x[13] = pg8::bf_hi(b.z); x[14] = pg8::bf_lo(b.w); x[15] = pg8::bf_hi(b.w);
}
__device__ __forceinline__ void pack16(const float (&x)[16], v4u& a, v4u& b) {
    a.x = pk2(x[0], x[1]); a.y = pk2(x[2], x[3]); a.z = pk2(x[4], x[5]); a.w = pk2(x[6], x[7]);
    b.x = pk2(x[8], x[9]); b.y = pk2(x[10], x[11]); b.z = pk2(x[12], x[13]); b.w = pk2(x[14], x[15]);
}

__device__ __forceinline__ void p0_transpose_item(const float* W, int K, int N, bf16_t* WT, LAS float* scr, int item, int lane, const float* kg = nullptr) {
    const int nblk = N / 32, kb = item / nblk, nb = item % nblk, k0 = 64 * kb, n0 = 32 * nb;
#pragma unroll 8
    for (int i = 0; i < 32; ++i) { const int kk = 2 * i + (lane >> 5); scr[kk * 33 + (lane & 31)] = W[(size_t)(k0 + kk) * N + n0 + (lane & 31)] * (kg ? kg[k0 + kk] : 1.0f); }
    LDS_WAIT(); asm volatile("" ::: "memory");
    const int c = lane & 7;
#pragma unroll
    for (int j = 0; j < 4; ++j) { const int n = (lane >> 3) + 8 * j; const LAS float* s = scr + (8 * c) * 33 + n;
        v4u o; o.x = pk2(s[0 * 33], s[1 * 33]); o.y = pk2(s[2 * 33], s[3 * 33]); o.z = pk2(s[4 * 33], s[5 * 33]); o.w = pk2(s[6 * 33], s[7 * 33]);
        *(GAS v4u*)(WT + (size_t)(n0 + n) * K + k0 + 8 * c) = o; }
    LDS_WAIT(); asm volatile("" ::: "memory");
}

struct Ctx {
    int vcu, G, wave_s;
};
__device__ __forceinline__ unsigned long long karg(int i) { const __attribute__((address_space(4))) unsigned long long* ka = (const __attribute__((address_space(4))) unsigned long long*)__builtin_amdgcn_kernarg_segment_ptr(); asm volatile("" : "+s"(ka)); return ka[i]; }
#define KIN(i) ((const float*)karg(i))
#define KOUT() ((float*)karg(25))
#define KWS() ((unsigned char*)karg(26))

__device__ __forceinline__ void phase_prologue(const Ctx& F, LAS unsigned char* lds) {
    int tid_ = F.wave_s * 64 + lane_id_v(); asm volatile("" : "+v"(tid_)); const int tid = tid_, lane = tid & 63, wave = F.wave_s, gw = F.vcu * NWAVES + wave, NGW = F.G * NWAVES; (void)lane; (void)gw; (void)NGW;
    unsigned char* const ws = KWS(); (void)ws;
    const int gt = F.vcu * (NWAVES * 64) + tid, NGT = F.G * NWAVES * 64;
    {
        float* tab = (float*)(ws + WS_TABA);
        for (int i = gt; i < SEQ * 8; i += NGT) { const int pos = i >> 3, k = i & 7;
            const float inv = k == 0 ? 1.0f : k == 1 ? 0.19392274474868576f : k == 2 ? 0.03760603093086393f : k == 3 ? 0.007292664737217109f : k == 4 ? 0.001414213562373095f : k == 5 ? 0.0002742481756762073f : k == 6 ? 5.318295896944988e-05f : 1.031338537721246e-05f;
            const float ang = (float)pos * inv; double rev = (double)ang * 0.15915494309189535; rev -= __builtin_floor(rev); const float r = (float)rev;
            tab[pos * 16 + k] = __builtin_amdgcn_cosf(r); tab[pos * 16 + 8 + k] = __builtin_amdgcn_sinf(r); }
    }
    {
        float* tab = (float*)(ws + WS_TABX);
        for (int i = gt; i < 128 * 16; i += NGT) { const int pos = i >> 4, k = i & 15;
            const float inv = __builtin_amdgcn_exp2f(-(float)k * (13.287712379549449f / 16.0f));
            const float ang = (float)pos * inv; double rev = (double)ang * 0.15915494309189535; rev -= __builtin_floor(rev); const float r = (float)rev;
            tab[pos * 32 + k] = __builtin_amdgcn_cosf(r); tab[pos * 32 + 16 + k] = __builtin_amdgcn_sinf(r); }
    }
    LAS float* scr = (LAS float*)(lds + wave * 16384);
    constexpr int I_IN = (DM / 64) * (NPROJ / 32), I_SQ = (DM / 64) * (DM / 32), I_UP = (DM / 64) * (NUP / 32), I_DN = (DFF / 64) * (DM / 32), I_PLE = (PLE / 64) * (DM / 32);
    constexpr int NITEMS = I_IN + 4 * I_SQ + I_UP + I_DN + I_PLE;
    for (int it = gw; it < NITEMS; it += NGW) {
        int r = it;
        if (r < I_IN) { p0_transpose_item(KIN(5), DM, NPROJ, (bf16_t*)(ws + WS_WIN), scr, r, lane); continue; } r -= I_IN;
        if (r < I_SQ) { p0_transpose_item(KIN(11), DM, DM, (bf16_t*)(ws + WS_WA), scr, r, lane); continue; } r -= I_SQ;
        if (r < I_SQ) { p0_transpose_item(KIN(14), DM, DM, (bf16_t*)(ws + WS_WB), scr, r, lane); continue; } r -= I_SQ;
        if (r < I_SQ) { p0_transpose_item(KIN(15), DM, DM, (bf16_t*)(ws + WS_WOUT), scr, r, lane); continue; } r -= I_SQ;
        if (r < I_SQ) { p0_transpose_item(KIN(23), DM, DM, (bf16_t*)(ws + WS_WPG), scr, r, lane, KIN(22)); continue; } r -= I_SQ;
        if (r < I_UP) { p0_transpose_item(KIN(17), DM, NUP, (bf16_t*)(ws + WS_WUP), scr, r, lane, KIN(16)); continue; } r -= I_UP;
        if (r < I_DN) { p0_transpose_item(KIN(20), DFF, DM, (bf16_t*)(ws + WS_WDN), scr, r, lane); continue; } r -= I_DN;
        p0_transpose_item(KIN(21), PLE, DM, (bf16_t*)(ws + WS_WPLE), scr, r, lane);
    }
}

__device__ __forceinline__ void phase_prep(const Ctx& F, const float* x, const float* p) {
    int tid_ = F.wave_s * 64 + lane_id_v(); asm volatile("" : "+v"(tid_)); const int tid = tid_, lane = tid & 63, wave = F.wave_s, gw = F.vcu * NWAVES + wave, NGW = F.G * NWAVES; (void)lane; (void)gw; (void)NGW;
    unsigned char* const ws = KWS(); (void)ws;
    const float* g = KIN(4);
    bf16_t* XN = (bf16_t*)(ws + WS_XN); bf16_t* PB = (bf16_t*)(ws + WS_PB);
    f32x4 gv[4];
#pragma unroll
    for (int j = 0; j < 4; ++j) gv[j] = ((const f32x4*)g)[lane + 64 * j];
    for (int m0 = gw * 4; m0 < MC; m0 += NGW * 4) {
        f32x4 v[4][4], pv[4];
#pragma unroll
        for (int r = 0; r < 4; ++r) { const f32x4* xr = (const f32x4*)(x + (size_t)(m0 + r) * DM) + lane;
#pragma unroll
            for (int j = 0; j < 4; ++j) v[r][j] = xr[64 * j];
            pv[r] = ((const f32x4*)(p + (size_t)(m0 + r) * PLE))[lane]; }
#pragma unroll
        for (int r = 0; r < 4; ++r) { float s = 0.f;
#pragma unroll
            for (int j = 0; j < 4; ++j) s += (v[r][j].x * v[r][j].x + v[r][j].y * v[r][j].y) + (v[r][j].z * v[r][j].z + v[r][j].w * v[r][j].w);
            const float rstd = __builtin_amdgcn_rsqf(wave_sum(s, lane) * (1.f / DM) + EPS);
            v2u* o8 = (v2u*)(XN + (size_t)(m0 + r) * DM) + lane;
#pragma unroll
            for (int j = 0; j < 4; ++j) { const f32x4 y = v[r][j] * rstd * gv[j]; v2u w; w.x = pk2(y.x, y.y); w.y = pk2(y.z, y.w); o8[64 * j] = w; }
            { v2u w; w.x = pk2(pv[r].x, pv[r].y); w.y = pk2(pv[r].z, pv[r].w); ((v2u*)(PB + (size_t)(m0 + r) * PLE))[lane] = w; } }
    }
}

__device__ __forceinline__ void phase_rope(const Ctx& F) {
    int tid_ = F.wave_s * 64 + lane_id_v(); asm volatile("" : "+v"(tid_)); const int tid = tid_, lane = tid & 63, wave = F.wave_s, gw = F.vcu * NWAVES + wave, NGW = F.G * NWAVES; (void)lane; (void)gw; (void)NGW;
    unsigned char* const ws = KWS(); (void)ws;
    bf16_t* PROJ = (bf16_t*)(ws + WS_PROJ);
    const float* tabA = (const float*)(ws + WS_TABA); const float* tabX = (const float*)(ws + WS_TABX);
    const int q4 = lane & 3;
    float gq[16], gk[16];
#pragma unroll
    for (int k = 0; k < 16; ++k) { gq[k] = KIN(12)[q4 * 16 + k]; gk[k] = KIN(13)[q4 * 16 + k]; }
    const float sgn = (q4 & 1) ? 1.f : -1.f;
    for (int m = gw; m < MC; m += NGW) {
        const int t = m & (SEQ - 1);
        bf16_t* row = PROJ + (size_t)m * NPROJ;
        v4u* paq = (v4u*)(row + C_AQ + (lane & ~3) * 16); v4u* pak = (v4u*)(row + C_AK + (lane & ~3) * 16); v4u* pbq = (v4u*)(row + C_BQ + lane * 16); v4u* pbk = (v4u*)(row + C_BK + (lane & 15) * 16);
        v4u aq0 = paq[0], aq1 = paq[1], ak0 = pak[0], ak1 = pak[1], bq0 = pbq[0], bq1 = pbq[1], bk0 = pbk[0], bk1 = pbk[1];
        float c8[8], s8[8], cx[16], sx[16];
        { const f32x4* tp = (const f32x4*)(tabA + t * 16); const f32x4 a = tp[0], b = tp[1], c = tp[2], d = tp[3];
          c8[0] = a.x; c8[1] = a.y; c8[2] = a.z; c8[3] = a.w; c8[4] = b.x; c8[5] = b.y; c8[6] = b.z; c8[7] = b.w;
          s8[0] = c.x; s8[1] = c.y; s8[2] = c.z; s8[3] = c.w; s8[4] = d.x; s8[5] = d.y; s8[6] = d.z; s8[7] = d.w; }
        { const int pos = (q4 < 2) ? (t >> 6) : (t & 63); const f32x4* tp = (const f32x4*)(tabX + pos * 32);
#pragma unroll
          for (int j = 0; j < 4; ++j) { const f32x4 a = tp[j], b = tp[4 + j]; cx[4 * j] = a.x; cx[4 * j + 1] = a.y; cx[4 * j + 2] = a.z; cx[4 * j + 3] = a.w; sx[4 * j] = b.x; sx[4 * j + 1] = b.y; sx[4 * j + 2] = b.z; sx[4 * j + 3] = b.w; } }
        asm volatile("" ::: "memory");
        if (q4 == 0) {
            float x[16]; unpack16(aq0, aq1, x);
#pragma unroll
            for (int i = 0; i < 8; ++i) { const float x1 = x[i], x2 = x[8 + i]; x[i] = x1 * c8[i] - x2 * s8[i]; x[8 + i] = x2 * c8[i] + x1 * s8[i]; }
            pack16(x, aq0, aq1); paq[0] = aq0; paq[1] = aq1;
        }
        {
            float x[16]; unpack16(ak0, ak1, x);
#pragma unroll
            for (int i = 0; i < 8; ++i) { const float x1 = x[i], x2 = x[8 + i]; x[i] = x1 * c8[i] - x2 * s8[i]; x[8 + i] = x2 * c8[i] + x1 * s8[i]; }
            if (q4 == 0) { pack16(x, ak0, ak1); pak[0] = ak0; pak[1] = ak1; }
        }
        {
            float x[16]; unpack16(bq0, bq1, x);
            float sq = 0.f;
#pragma unroll
            for (int i = 0; i < 16; ++i) sq += x[i] * x[i];
            sq += shx(sq, lane, 1); sq += shx(sq, lane, 2);
            const float r = __builtin_amdgcn_rsqf(sq * (1.f / 64.f) + EPS);
#pragma unroll
            for (int i = 0; i < 16; ++i) x[i] = x[i] * r * gq[i];
#pragma unroll
            for (int i = 0; i < 16; ++i) { const float o = shx(x[i], lane, 1); x[i] = (x[i] * cx[i] + sgn * o * sx[i]) * QSCALE; }
            pack16(x, bq0, bq1); pbq[0] = bq0; pbq[1] = bq1;
        }
        {
            float x[16]; unpack16(bk0, bk1, x);
            float sq = 0.f;
#pragma unroll
            for (int i = 0; i < 16; ++i) sq += x[i] * x[i];
            sq += shx(sq, lane, 1); sq += shx(sq, lane, 2);
            const float r = __builtin_amdgcn_rsqf(sq * (1.f / 64.f) + EPS);
#pragma unroll
            for (int i = 0; i < 16; ++i) x[i] = x[i] * r * gk[i];
#pragma unroll
            for (int i = 0; i < 16; ++i) { const float o = shx(x[i], lane, 1); x[i] = x[i] * cx[i] + sgn * o * sx[i]; }
            if (lane < 16) { pack16(x, bk0, bk1); pbk[0] = bk0; pbk[1] = bk1; }
        }
    }
}

__device__ __forceinline__ void phase_attn(const Ctx& F, char* lds) {
    using abf = attn_body::bf16;
    unsigned char* const ws = KWS();
    abf* PROJ = (abf*)(ws + WS_PROJ); abf* OA1 = (abf*)(ws + WS_OA1); abf* OB = (abf*)(ws + WS_OB);
    float lam;
    { const int lane = lane_id_v(); const float s1 = wave_sum(KIN(6)[lane] * KIN(7)[lane], lane), s2 = wave_sum(KIN(8)[lane] * KIN(9)[lane], lane); lam = __expf(s1) - __expf(s2) + 0.2f; }
    const float* gdiff = KIN(10);
    if (F.wave_s >= 4) __builtin_amdgcn_s_setprio(1);
    for (int i = 0;; ++i) {
        const int L = i * F.G + F.vcu; if (L >= 1536) break;
        if (L < 1024) { for (int rep = 0; rep < PROBE_REP64; ++rep) { const int i4 = (L >> 8) & 3, v = L & 255, g = v >> 3, s = v & 7, qb = i4 * 8 + s;
            const int qd = g >> 2, mem = g & 3, b = qd >> 2, kvh = qd & 3, qh = kvh * 4 + mem; const size_t r0 = (size_t)b * SEQ;
            attn_body::attn_unit<8>(qb, PROJ + r0 * NPROJ + C_BQ + qh * 64, PROJ + r0 * NPROJ + C_BK + kvh * 64, PROJ + r0 * NPROJ + C_BV + kvh * 64, OB + r0 * DM + qh * 64, NPROJ, NPROJ, NPROJ, DM, lds, F.wave_s); }
        } else { for (int rep = 0; rep < PROBE_REP128; ++rep) { const int idx = L - 1024, i4 = idx >> 8, v = idx & 255, g = v >> 3, s = v & 7;
            const int bh = g >> 1, qb = (g & 1) * 16 + i4 * 8 + s, b = bh >> 3, h = bh & 7; const size_t r0 = (size_t)b * SEQ;
            attn128::attn128_unit(qb, PROJ + r0 * NPROJ + C_AQ + h * 128, PROJ + r0 * NPROJ + C_AK + h * 128, PROJ + r0 * NPROJ + C_AV + h * 128, OA1 + r0 * DM + h * 128, NPROJ, NPROJ, NPROJ, DM, lds, F.wave_s, lam, gdiff); } }
    }
    __builtin_amdgcn_s_setprio(0);
}

__device__ __forceinline__ void phase_diffnorm(const Ctx& F) {
    int tid_ = F.wave_s * 64 + lane_id_v(); asm volatile("" : "+v"(tid_)); const int tid = tid_, lane = tid & 63, wave = F.wave_s, gw = F.vcu * NWAVES + wave, NGW = F.G * NWAVES; (void)lane; (void)gw; (void)NGW;
    unsigned char* const ws = KWS(); (void)ws;
    bf16_t* OA1 = (bf16_t*)(ws + WS_OA1); const bf16_t* OA2 = (const bf16_t*)(ws + WS_OA2);
    const float s1 = wave_sum(KIN(6)[lane] * KIN(7)[lane], lane), s2 = wave_sum(KIN(8)[lane] * KIN(9)[lane], lane);
    const float lam = __expf(s1) - __expf(s2) + 0.2f;
    float gd[16];
#pragma unroll
    for (int k = 0; k < 16; ++k) gd[k] = KIN(10)[(lane & 7) * 16 + k] * 0.8f;
    for (int m0 = gw * 4; m0 < MC; m0 += NGW * 4) {
        v4u a[4], b[4], c[4], d[4];
#pragma unroll
        for (int r = 0; r < 4; ++r) { const v4u* pp = (const v4u*)(OA1 + (size_t)(m0 + r) * DM + lane * 16); const v4u* p2 = (const v4u*)(OA2 + (size_t)(m0 + r) * DM + lane * 16); a[r] = pp[0]; b[r] = pp[1]; c[r] = p2[0]; d[r] = p2[1]; }
        asm volatile("" ::: "memory");
#pragma unroll
        for (int r = 0; r < 4; ++r) {
            float x[16], y[16]; unpack16(a[r], b[r], x); unpack16(c[r], d[r], y);
            float s = 0.f;
#pragma unroll
            for (int i = 0; i < 16; ++i) { x[i] = x[i] - lam * y[i]; s += x[i] * x[i]; }
            s += shx(s, lane, 1); s += shx(s, lane, 2); s += shx(s, lane, 4);
            const float rr = __builtin_amdgcn_rsqf(s * (1.f / 128.f) + EPS);
#pragma unroll
            for (int i = 0; i < 16; ++i) x[i] = x[i] * rr * gd[i];
            v4u oa, ob; pack16(x, oa, ob); v4u* pp = (v4u*)(OA1 + (size_t)(m0 + r) * DM + lane * 16); pp[0] = oa; pp[1] = ob;
        }
    }
}

__device__ __forceinline__ float gelu_tanh(float x) { const float u = x + 0.044715f * x * x * x; return x * __builtin_amdgcn_rcpf(1.0f + __builtin_amdgcn_exp2f(-2.302208198f * u)); }
__device__ __forceinline__ void up8(const v4u a, float (&x)[8]) { x[0] = pg8::bf_lo(a.x); x[1] = pg8::bf_hi(a.x); x[2] = pg8::bf_lo(a.y); x[3] = pg8::bf_hi(a.y); x[4] = pg8::bf_lo(a.z); x[5] = pg8::bf_hi(a.z); x[6] = pg8::bf_lo(a.w); x[7] = pg8::bf_hi(a.w); }
__device__ __forceinline__ void phase_conv(const Ctx& F) {
    int tid_ = F.wave_s * 64 + lane_id_v(); asm volatile("" : "+v"(tid_)); const int tid = tid_, lane = tid & 63, wave = F.wave_s, gw = F.vcu * NWAVES + wave, NGW = F.G * NWAVES; (void)lane; (void)gw; (void)NGW;
    unsigned char* const ws = KWS(); (void)ws;
    const bf16_t* U = (const bf16_t*)(ws + WS_U); bf16_t* ACT = (bf16_t*)(ws + WS_ACT);
    const float* cw = KIN(18); const float* cb = KIN(19);
    constexpr int NCG = DFF / 8, RUN = 16, NRUN = MC / RUN;
    if (tid < NCG) {
        const int ch0 = tid * 8;
        float wg[3][8], wv[3][8], bg[8], bv[8];
#pragma unroll
        for (int k = 0; k < 3; ++k) { const f32x4 a = *(const f32x4*)(cw + k * NUP + ch0), b = *(const f32x4*)(cw + k * NUP + ch0 + 4), c = *(const f32x4*)(cw + k * NUP + DFF + ch0), d = *(const f32x4*)(cw + k * NUP + DFF + ch0 + 4);
            wg[k][0] = a.x; wg[k][1] = a.y; wg[k][2] = a.z; wg[k][3] = a.w; wg[k][4] = b.x; wg[k][5] = b.y; wg[k][6] = b.z; wg[k][7] = b.w;
            wv[k][0] = c.x; wv[k][1] = c.y; wv[k][2] = c.z; wv[k][3] = c.w; wv[k][4] = d.x; wv[k][5] = d.y; wv[k][6] = d.z; wv[k][7] = d.w; }
        { const f32x4 a = *(const f32x4*)(cb + ch0), b = *(const f32x4*)(cb + ch0 + 4), c = *(const f32x4*)(cb + DFF + ch0), d = *(const f32x4*)(cb + DFF + ch0 + 4);
          bg[0] = a.x; bg[1] = a.y; bg[2] = a.z; bg[3] = a.w; bg[4] = b.x; bg[5] = b.y; bg[6] = b.z; bg[7] = b.w; bv[0] = c.x; bv[1] = c.y; bv[2] = c.z; bv[3] = c.w; bv[4] = d.x; bv[5] = d.y; bv[6] = d.z; bv[7] = d.w; }
        for (int run = F.vcu; run < NRUN; run += F.G) {
            const int t0 = run * RUN; const bool first = (t0 & (SEQ - 1)) == 0, last = ((t0 + RUN) & (SEQ - 1)) == 0;
            const bf16_t* up = U + (size_t)t0 * NUP + ch0;
            v4u rg[RUN + 2], rv[RUN + 2];
#pragma unroll
            for (int i = 0; i < RUN + 2; ++i) { const bool z = (i == 0 && first) || (i == RUN + 1 && last);
                if (z) { rg[i] = (v4u){0u, 0u, 0u, 0u}; rv[i] = rg[i]; } else { rg[i] = *(const v4u*)(up + (long)(i - 1) * NUP); rv[i] = *(const v4u*)(up + (long)(i - 1) * NUP + DFF); } }
            asm volatile("" ::: "memory");
#pragma unroll
            for (int i = 0; i < RUN; ++i) {
                float pg_[8], cg_[8], ng_[8], pv_[8], cv_[8], nv_[8], o[8];
                up8(rg[i], pg_); up8(rg[i + 1], cg_); up8(rg[i + 2], ng_); up8(rv[i], pv_); up8(rv[i + 1], cv_); up8(rv[i + 2], nv_);
#pragma unroll
                for (int k = 0; k < 8; ++k) { const float ug = pg_[k] * wg[0][k] + cg_[k] * wg[1][k] + ng_[k] * wg[2][k] + bg[k]; const float uv = pv_[k] * wv[0][k] + cv_[k] * wv[1][k] + nv_[k] * wv[2][k] + bv[k]; o[k] = gelu_tanh(ug) * uv; }
                v4u w; w.x = pk2(o[0], o[1]); w.y = pk2(o[2], o[3]); w.z = pk2(o[4], o[5]); w.w = pk2(o[6], o[7]);
                *(v4u*)(ACT + (size_t)(t0 + i) * DFF + ch0) = w;
            }
        }
    }
}

__device__ __forceinline__ void phase_final(const Ctx& F, float* out, const float* ss3, const float oscale) {
    int tid_ = F.wave_s * 64 + lane_id_v(); asm volatile("" : "+v"(tid_)); const int tid = tid_, lane = tid & 63, wave = F.wave_s, gw = F.vcu * NWAVES + wave, NGW = F.G * NWAVES; (void)lane; (void)gw; (void)NGW;
    unsigned char* const ws = KWS(); (void)ws;
    const float* g = KIN(24); const bf16_t* hs = (const bf16_t*)(ws + WS_XNB);
    f32x4 gv[4];
#pragma unroll
    for (int j = 0; j < 4; ++j) gv[j] = ((const f32x4*)g)[lane + 64 * j];
    for (int m0 = gw * 4; m0 < MC; m0 += NGW * 4) {
        v2u v[4][4]; float rs[4];
#pragma unroll
        for (int r = 0; r < 4; ++r) { const v2u* xr = (const v2u*)(hs + (size_t)(m0 + r) * DM) + lane; { const f32x4* sp = (const f32x4*)(ss3 + (size_t)(m0 + r) * 16); const f32x4 sa = (sp[0] + sp[1]) + (sp[2] + sp[3]); rs[r] = (sa[0] + sa[1]) + (sa[2] + sa[3]); }
#pragma unroll
            for (int j = 0; j < 4; ++j) v[r][j] = xr[64 * j]; }
        asm volatile("" ::: "memory");
#pragma unroll
        for (int r = 0; r < 4; ++r) { f32x4* xr = (f32x4*)(out + (size_t)(m0 + r) * DM) + lane; const float rr = __builtin_amdgcn_rsqf(rs[r] * (1.f / DM) + EPS) * oscale;
#pragma unroll
            for (int j = 0; j < 4; ++j) { const f32x4 h = (f32x4){pg8::bf_lo(v[r][j].x), pg8::bf_hi(v[r][j].x), pg8::bf_lo(v[r][j].y), pg8::bf_hi(v[r][j].y)}; xr[64 * j] = h * rr * gv[j]; } }
    }
}

struct Args { const float* in[25]; float* out; unsigned char* ws; };

#ifndef PROBE_GB
#define PROBE_GB 1
#endif
#ifndef PROBE_GF
#define PROBE_GF 1
#endif
#ifndef PROBE_GG
#define PROBE_GG 1
#endif
#ifndef PROBE_GI
#define PROBE_GI 1
#endif
#ifndef PROBE_GL
#define PROBE_GL 1
#endif
#ifndef PROBE_CONV
#define PROBE_CONV 1
#endif
#ifndef PROBE_PRO
#define PROBE_PRO 1
#endif
#ifndef PROBE_PREP
#define PROBE_PREP 1
#endif
#ifndef PROBE_TS
#define PROBE_TS 0
#endif
#ifndef PROBE_TSCALE
#define PROBE_TSCALE 2000
#endif
#if PROBE_TS
#define TS_PTR() ((volatile LAS unsigned long long*)((LAS unsigned char*)lds + MISC_OFF + 64))
#define STAMP(k) do { if (gbar.leader && blockIdx.x == 0) { volatile LAS unsigned long long* T_ = TS_PTR(); const unsigned long long t_ = __builtin_amdgcn_s_memrealtime(); if ((k) >= 0 && ((PROBE_TS >> (k)) & 1)) T_[1] += t_ - T_[0]; T_[0] = t_; } } while (0)
#define TS_PUBLISH() do { if (gbar.leader && blockIdx.x == 0) { const float us_ = (float)TS_PTR()[1] * 0.01f; const float b_ = __builtin_rintf(__builtin_log2f(us_ < 1.f ? 1.f : us_) * 2.6419f); *(volatile float*)(KWS() + WS_EPS) = b_ * (1.0f / 64.0f); } } while (0)
#else
#define STAMP(k) do {} while (0)
#define TS_PUBLISH() do {} while (0)
#endif
#ifndef PROBE_ATTNPH
#define PROBE_ATTNPH 1
#endif
#ifndef PROBE_GK
#define PROBE_GK 1
#endif
#ifndef PROBE_GH
#define PROBE_GH 1
#endif
#ifndef PROBE_BARX
#define PROBE_BARX 1
#endif
#define GBAR() do { for (int rep_ = 0; rep_ < PROBE_BARX; ++rep_) xcd_barrier(gbar); } while (0)
template <int c> __device__ __forceinline__ void run_chunk(const Ctx& F, unsigned char* lds, const XcdBarrier& gbar) {
    LAS unsigned char* L = (LAS unsigned char*)lds;
    const int bid = (int)blockIdx.x;
#define WSP(T, off) ((T*)(ws + (off)))
#define XC() ((c == 0) ? KIN(0) : KIN(1) + (size_t)(c - 1) * MC * DM)
#define OUTC() (KOUT() + (size_t)c * MC * DM)
#define SSP(k) ((float*)(ws + WS_SS) + (size_t)(k) * MC * 16)
#ifndef SKIP_GB
        for (int rep_ = 0; rep_ < PROBE_GB; ++rep_) {
            unsigned char* const ws = KWS(); pg8::Gemm g{WSP(bf16_t, WS_XN), (const bf16_t*)(ws + WS_WIN), MC, NPROJ, DM}; pg8::StaticOrder S; S.init(MC, NPROJ, F.G, bid);
            pg8::EpiProj E{WSP(bf16_t, WS_PROJ), NPROJ, C_GA / 256, C_AK / 256, QSCALE};
            pg8::gemm_phase<pg8::EpiProj, pg8::StaticOrder, PG8_ALIGN, PG8_SP2>(L, g, S, E, F.wave_s);
        }
#endif
        {
            const int extra = ((MC / 256) * (NPROJ / 256)) % F.G, gE = extra ? F.G - extra : F.G, cE = extra ? bid - extra : bid;
            if (cE >= 0) {
            unsigned char* const ws = KWS(); pg8::Gemm g{WSP(bf16_t, WS_PB), (const bf16_t*)(ws + WS_WPLE), MC, DM, PLE}; pg8::StaticOrder S; S.init(MC, DM, gE, cE);
            pg8::EpiProj E{WSP(bf16_t, WS_E), DM, 1 << 20, 0, 1.0f};
            pg8::gemm_phase<pg8::EpiProj, pg8::StaticOrder, PG8_ALIGN, PG8_SP2>(L, g, S, E, F.wave_s);
            }
        }
#ifndef SKIP_EW
        if (c > 0) { unsigned char* const ws = KWS(); phase_final(F, KOUT() + (size_t)(c - 1) * MC * DM, SSP(2), 1.0f); }
#endif
        GBAR(); STAMP(1);
#ifndef SKIP_EW
        phase_rope(F);
        if (c + 1 < NCHUNK) { for (int rep_ = 0; rep_ < PROBE_PREP; ++rep_) phase_prep(F, KIN(1) + (size_t)c * MC * DM, KIN(3) + (size_t)c * MC * PLE); }
#endif
        GBAR(); STAMP(2);
#ifndef SKIP_ATTN
        for (int rep_ = 1; rep_ < PROBE_ATTNPH; ++rep_) { phase_attn(F, (char*)lds); xcd_barrier(gbar); }
        phase_attn(F, (char*)lds);
#endif
        GBAR(); STAMP(3);
#ifndef SKIP_GF
        for (int rep_ = 0; rep_ < PROBE_GF; ++rep_) {
            unsigned char* const ws = KWS(); pg8::Gemm g{WSP(bf16_t, WS_OA1), (const bf16_t*)(ws + WS_WA), MC, DM, DM}; pg8::StaticOrder S; S.init(MC, DM, F.G, bid);
            pg8::EpiT1 E{WSP(bf16_t, WS_PROJ) + C_GA, NPROJ, WSP(bf16_t, WS_OA2), DM};
            pg8::gemm_phase<pg8::EpiT1, pg8::StaticOrder, PG8_ALIGN1, PG8_SP2>(L, g, S, E, F.wave_s);
        }
#endif
        GBAR(); STAMP(5);
#ifndef SKIP_GG
        for (int rep_ = 0; rep_ < PROBE_GG; ++rep_) {
            unsigned char* const ws = KWS(); pg8::Gemm g{WSP(bf16_t, WS_OB), (const bf16_t*)(ws + WS_WB), MC, DM, DM}; pg8::StaticOrder S; S.init(MC, DM, F.G, bid);
            pg8::EpiMerge E{WSP(bf16_t, WS_PROJ) + C_GB, NPROJ, WSP(bf16_t, WS_OA2), DM, WSP(bf16_t, WS_MG), DM};
            pg8::gemm_phase<pg8::EpiMerge, pg8::StaticOrder, PG8_ALIGN1, PG8_SP2>(L, g, S, E, F.wave_s);
        }
#endif
        GBAR(); STAMP(6);
#ifndef SKIP_GH
        for (int rep_ = 0; rep_ < PROBE_GH; ++rep_) {
            unsigned char* const ws = KWS(); pg8::Gemm g{WSP(bf16_t, WS_MG), (const bf16_t*)(ws + WS_WOUT), MC, DM, DM}; pg8::StaticOrder S; S.init(MC, DM, F.G, bid);
            pg8::EpiResidB<false> E{XC(), WSP(bf16_t, WS_HS), SSP(0), DM};
            pg8::gemm_phase<pg8::EpiResidB<false>, pg8::StaticOrder, PG8_ALIGN1, PG8_SP2>(L, g, S, E, F.wave_s);
        }
#endif
        GBAR(); STAMP(7);
#ifndef SKIP_GI
        for (int rep_ = 0; rep_ < PROBE_GI; ++rep_) {
            unsigned char* const ws = KWS(); pg8::Gemm g{WSP(bf16_t, WS_HS), (const bf16_t*)(ws + WS_WUP), MC, NUP, DM}; pg8::StaticOrder S; S.init(MC, NUP, F.G, bid);
            pg8::EpiScale<false> E{SSP(0), 1.f / DM, EPS, WSP(bf16_t, WS_U), nullptr, NUP};
            pg8::gemm_phase<pg8::EpiScale<false>, pg8::StaticOrder, PG8_ALIGN, PG8_SP2>(L, g, S, E, F.wave_s);
        }
#endif
        GBAR(); STAMP(8);
#ifndef SKIP_CONV
        for (int rep_ = 0; rep_ < PROBE_CONV; ++rep_) phase_conv(F);
#endif
        GBAR(); STAMP(9);
#ifndef SKIP_GK
        {
            unsigned char* const ws = KWS(); pg8::Gemm g{WSP(bf16_t, WS_ACT), (const bf16_t*)(ws + WS_WDN), MC, DM, DFF}; pg8::StaticOrder S; S.init(MC, DM, F.G, bid);
            pg8::EpiResidB<true> E{WSP(bf16_t, WS_HS), WSP(bf16_t, WS_HS), SSP(1), DM};
            pg8::gemm_phase<pg8::EpiResidB<true>, pg8::StaticOrder, PG8_ALIGN1, PG8_SP2>(L, g, S, E, F.wave_s);
        }
#endif
        GBAR(); STAMP(10);
#ifndef SKIP_GL
        {
            unsigned char* const ws = KWS(); pg8::Gemm g{WSP(bf16_t, WS_HS), (const bf16_t*)(ws + WS_WPG), MC, DM, DM}; pg8::StaticOrder S; S.init(MC, DM, F.G, bid);
            pg8::EpiPle E{SSP(1), 1.f / DM, EPS, WSP(bf16_t, WS_E), WSP(bf16_t, WS_HS), WSP(bf16_t, WS_XNB), SSP(2), DM};
            pg8::gemm_phase<pg8::EpiPle, pg8::StaticOrder, PG8_ALIGN1, PG8_SP2>(L, g, S, E, F.wave_s);
        }
#endif
        GBAR(); STAMP(11); if (c == NCHUNK - 1) TS_PUBLISH();
#ifndef SKIP_EW
        if (c == NCHUNK - 1) { unsigned char* const ws = KWS(); phase_final(F, OUTC(), SSP(2), (PROBE_TS && c == NCHUNK - 1) ? 1.0f + *(const float*)(ws + WS_EPS) : 1.0f); }
#endif
}

__global__ void __launch_bounds__(NWAVES * 64, 2) mk_fwd(Args args) {
    extern __shared__ __attribute__((aligned(16))) unsigned char lds[];
    cg::grid_group grid = cg::this_grid();
    Ctx F;
    F.wave_s = __builtin_amdgcn_readfirstlane((int)threadIdx.x >> 6);
    if (threadIdx.x < 32) ((volatile LAS unsigned*)((LAS unsigned char*)lds + MISC_OFF))[threadIdx.x] = 0u;
    __syncthreads();
    const XcdBarrier gbar = xcd_barrier_post((unsigned*)(KWS() + WS_BAR), (volatile LAS unsigned*)((LAS unsigned char*)lds + MISC_OFF) + 8, threadIdx.x == 0);
    F.G = gridDim.x; { const int bx = blockIdx.x; F.vcu = (F.G % 8 == 0) ? (bx % 8) * (F.G / 8) + bx / 8 : bx; }
    (void)args;
    LAS unsigned char* L = (LAS unsigned char*)lds;
#ifndef SKIP_EW
    STAMP(-1);
    for (int rep_ = 0; rep_ < PROBE_PRO; ++rep_) phase_prologue(F, L);
    for (int rep_ = 0; rep_ < PROBE_PREP; ++rep_) phase_prep(F, KIN(0), KIN(2));
#endif
    grid.sync(); STAMP(0);
    run_chunk<0>(F, lds, gbar);
#ifndef ONE_CHUNK
    run_chunk<1>(F, lds, gbar);
    run_chunk<2>(F, lds, gbar);
#endif
}

extern "C" void kernel_launch(void* const* d_in, const int* in_sizes, int n_in, void* d_out, int out_size, void* d_ws, size_t ws_size, hipStream_t stream) {
    static int grid = 0;
    if (grid == 0) {
        if (n_in != 25 || ws_size < WS_END) { fprintf(stderr, "kernel_launch: unexpected inputs (n_in %d, ws %zu)\n", n_in, ws_size); grid = -1; return; }
        int dev = 0, cus = 0, per_cu = 0;
        hipGetDevice(&dev); hipDeviceGetAttribute(&cus, hipDeviceAttributeMultiprocessorCount, dev);
        hipFuncSetAttribute((const void*)mk_fwd, hipFuncAttributeMaxDynamicSharedMemorySize, LDS_BYTES);
        hipOccupancyMaxActiveBlocksPerMultiprocessor(&per_cu, (const void*)mk_fwd, NWAVES * 64, LDS_BYTES);
        (void)hipGetLastError();
        if (per_cu < 1) per_cu = 1;
        grid = cus;
    }
    if (grid < 0) return;
    if (hipMemsetAsync((char*)d_ws + WS_BAR, 0, 16384, stream) != hipSuccess) { fprintf(stderr, "kernel_launch: memset failed\n"); return; }
    Args a{};
    for (int i = 0; i < 25; ++i) a.in[i] = (const float*)d_in[i];
    a.out = (float*)d_out; a.ws = (unsigned char*)d_ws;
    void* kargs[] = {&a};
    hipError_t e = hipLaunchCooperativeKernel((const void*)mk_fwd, dim3(grid), dim3(NWAVES * 64), kargs, LDS_BYTES, stream);
    if (e != hipSuccess) fprintf(stderr, "cooperative launch failed: %s (grid %d)\n", hipGetErrorString(e), grid);
}
```

```cpp
#include <hip/hip_runtime.h>
#include <hip/hip_cooperative_groups.h>
#include <cstdio>
#include <cstdint>
__device__ __forceinline__ int lane_id_v() { int l; asm volatile("v_mbcnt_lo_u32_b32 %0, -1, 0\n\tv_mbcnt_hi_u32_b32 %0, -1, %0" : "=v"(l)); return l; }
__device__ __forceinline__ float shx(float v, int lane, int m) { return __int_as_float(__builtin_amdgcn_ds_bpermute((lane ^ m) << 2, __float_as_int(v))); }
namespace pg8 {
#define PG8_LAS __attribute__((address_space(3)))
typedef unsigned short bf16_t;
typedef short bf16x8 __attribute__((ext_vector_type(8)));
typedef float f32x4 __attribute__((ext_vector_type(4)));
typedef unsigned u32x4 __attribute__((ext_vector_type(4)));
constexpr int BM = 256, BK = 64, HALF = 128, HTB = HALF * BK * 2  , STAGE_BYTES = 8 * HTB, NXCD = 8, WGM = 8;

__host__ __device__ __forceinline__ int lds_byte(int r, int c) { const int st = (r >> 4) * 2 + (c >> 5), rr = r & 15, cc = c & 31, ob = rr * 64 + cc * 2; return st * 1024 + (ob ^ (((ob >> 9) & 1) << 5)); }
__host__ __device__ __forceinline__ void stage_rc(int b, int& R, int& C) { const int st = b / 1024, sb = b % 1024, swz = sb ^ (((sb >> 9) & 1) << 5); R = (st >> 1) * 16 + swz / 64; C = (st & 1) * 32 + (swz % 64) / 2; }
__host__ __device__ __forceinline__ int perm32(int rho) { const int n = rho >> 4, i = rho & 15; return 8 * (i >> 2) + 4 * n + (i & 3); }

struct Unit { int pm, pn; };
struct Gemm { const bf16_t* A; const bf16_t* Bt; int M, N, K; };

struct StaticOrder {
    int nM, nN, nwg, G, c;
    __host__ __device__ void init(int M, int N, int G_, int c_) { nM = M / BM; nN = N / BM; nwg = nM * nN; G = G_; c = c_; }
    __host__ __device__ bool next(int i, Unit& u) const {
        const long L = (long)i * G + c; if (L >= nwg) return false;
        int wgid = (int)L; { const int q = nwg / NXCD, r = nwg % NXCD, xcd = wgid % NXCD, off = wgid / NXCD; wgid = (xcd < r ? xcd * (q + 1) : r * (q + 1) + (xcd - r) * q) + off; }
        const int nig = WGM * nN, gid = wgid / nig, fm = gid * WGM, gsz = (nM - fm) < WGM ? (nM - fm) : WGM;
        u.pm = fm + ((wgid % nig) % gsz); u.pn = (wgid % nig) / gsz; return true;
    }
    __device__ __forceinline__ void a_ready(const Unit&) const {}
    __device__ __forceinline__ void done(const Unit&) const {}
};

__device__ __forceinline__ unsigned cvt_pk_bf16(float lo, float hi) { unsigned r; asm volatile("v_cvt_pk_bf16_f32 %0, %1, %2" : "=v"(r) : "v"(lo), "v"(hi)); return r; }
typedef float f32x2 __attribute__((ext_vector_type(2)));
__device__ __forceinline__ f32x2 gelu_pk(f32x2 v) {
    const f32x2 av = __builtin_elementwise_abs(v), d = av * 0.2316418882f + 1.0f;
    f32x2 t; t.x = __builtin_amdgcn_rcpf(d.x); t.y = __builtin_amdgcn_rcpf(d.y);
    f32x2 q = t * 0.5307027145f + (-0.7265760135f); q = q * t + 0.7107068705f; q = q * t + (-0.142248368f); q = q * t + 0.127414796f; q = q * t;
    const f32x2 s = (v * v) * (-0.72134752044f);
    f32x2 e; e.x = __builtin_amdgcn_exp2f(s.x); e.y = __builtin_amdgcn_exp2f(s.y);
    const f32x2 m = v * (q * e), r = v - m;
    f32x2 o; o.x = v.x < 0.f ? m.x : r.x; o.y = v.y < 0.f ? m.y : r.y; return o;
}

template <int ACT  > struct EpiBf16 {
    static constexpr bool PERM = true, AFTER_DRAIN = false; static_assert(ACT == 0 || ACT == 1, "EpiBf16: ACT is 0 (none) or 1 (gelu_pk)");
    bf16_t* O; int ldc; const float* bias; int split_cols; size_t split_stride; float scale0;
    __device__ __forceinline__ void operator()(const f32x4 (&acc)[2][2][4][2], const Unit& u, int wr, int wc, int fr, int fq) const {
        const int row0 = u.pm * BM + wr * 64 + fr; int colt = u.pn * BM; bf16_t* base = O;
        float sc = 1.f; if (split_cols) { const int t = colt / split_cols; base += (size_t)t * split_stride; colt -= t * split_cols; if (t == 0) sc = scale0; }
        const int col0 = colt + wc * 32 + 8 * fq, bcol0 = u.pn * BM + wc * 32 + 8 * fq;
        f32x4 bv[2][2];
#pragma unroll
        for (int bj = 0; bj < 2; ++bj)
#pragma unroll
            for (int n = 0; n < 2; ++n) bv[bj][n] = bias ? *(const f32x4*)(bias + bcol0 + bj * HALF + 4 * n) : (f32x4){0.f, 0.f, 0.f, 0.f};
#pragma unroll
        for (int ai = 0; ai < 2; ++ai)
#pragma unroll
            for (int m = 0; m < 4; ++m) { bf16_t* rowp = base + (size_t)(row0 + ai * HALF + m * 16) * ldc + col0;
#pragma unroll
                for (int bj = 0; bj < 2; ++bj) { f32x4 v0 = acc[ai][bj][m][0] + bv[bj][0], v1 = acc[ai][bj][m][1] + bv[bj][1];
                    if (ACT == 1) { f32x2 a = gelu_pk((f32x2){v0[0], v0[1]}), b = gelu_pk((f32x2){v0[2], v0[3]}), c = gelu_pk((f32x2){v1[0], v1[1]}), d = gelu_pk((f32x2){v1[2], v1[3]});
                        v0 = (f32x4){a.x, a.y, b.x, b.y}; v1 = (f32x4){c.x, c.y, d.x, d.y}; }
                    v0 = v0 * sc; v1 = v1 * sc; u32x4 w; w.x = cvt_pk_bf16(v0[0], v0[1]); w.y = cvt_pk_bf16(v0[2], v0[3]); w.z = cvt_pk_bf16(v1[0], v1[1]); w.w = cvt_pk_bf16(v1[2], v1[3]);
                    *(u32x4*)(rowp + bj * HALF) = w; } }
    }
};

__device__ __forceinline__ float sigm(float x) { return __builtin_amdgcn_rcpf(1.0f + __builtin_amdgcn_exp2f(-1.4426950408889634f * x)); }
__device__ __forceinline__ float bf_lo(unsigned w) { return __uint_as_float(w << 16); }
__device__ __forceinline__ float bf_hi(unsigned w) { return __uint_as_float(w & 0xffff0000u); }
__device__ __forceinline__ u32x4 pack8(const f32x4 v0, const f32x4 v1) { u32x4 w; w.x = cvt_pk_bf16(v0[0], v0[1]); w.y = cvt_pk_bf16(v0[2], v0[3]); w.z = cvt_pk_bf16(v1[0], v1[1]); w.w = cvt_pk_bf16(v1[2], v1[3]); return w; }
__device__ __forceinline__ void unpack8(const u32x4 g, f32x4& a, f32x4& b) { a = (f32x4){bf_lo(g.x), bf_hi(g.x), bf_lo(g.y), bf_hi(g.y)}; b = (f32x4){bf_lo(g.z), bf_hi(g.z), bf_lo(g.w), bf_hi(g.w)}; }

struct EpiProj {
    static constexpr bool PERM = true, AFTER_DRAIN = false;
    bf16_t* O; int ldc; int sig_pn; int scale_pn; float scale;
    __device__ __forceinline__ void operator()(const f32x4 (&acc)[2][2][4][2], const Unit& u, int wr, int wc, int fr, int fq) const {
        const int row0 = u.pm * BM + wr * 64 + fr, col0 = u.pn * BM + wc * 32 + 8 * fq; const bool sg = u.pn >= sig_pn; const float sc = u.pn < scale_pn ? scale : 1.0f;
#pragma unroll
        for (int ai = 0; ai < 2; ++ai)
#pragma unroll
            for (int m = 0; m < 4; ++m) { bf16_t* rowp = O + (size_t)(row0 + ai * HALF + m * 16) * ldc + col0;
#pragma unroll
                for (int bj = 0; bj < 2; ++bj) { f32x4 v0 = acc[ai][bj][m][0] * sc, v1 = acc[ai][bj][m][1] * sc;
                    if (sg) {
#pragma unroll
                        for (int k = 0; k < 4; ++k) { v0[k] = sigm(v0[k]); v1[k] = sigm(v1[k]); } }
                    *(u32x4*)(rowp + bj * HALF) = pack8(v0, v1); } }
    }
};
struct EpiT1 {
    static constexpr bool PERM = true, AFTER_DRAIN = false;
    const bf16_t* G; int ldg; bf16_t* T; int ldt;
    __device__ __forceinline__ void operator()(const f32x4 (&acc)[2][2][4][2], const Unit& u, int wr, int wc, int fr, int fq) const {
        const int row0 = u.pm * BM + wr * 64 + fr, col0 = u.pn * BM + wc * 32 + 8 * fq;
#pragma unroll
        for (int ai = 0; ai < 2; ++ai)
#pragma unroll
            for (int m = 0; m < 4; ++m) { const size_t row = (size_t)(row0 + ai * HALF + m * 16);
#pragma unroll
                for (int bj = 0; bj < 2; ++bj) { const u32x4 g = *(const u32x4*)(G + row * ldg + col0 + bj * HALF); f32x4 g0, g1; unpack8(g, g0, g1);
                    *(u32x4*)(T + row * ldt + col0 + bj * HALF) = pack8(acc[ai][bj][m][0] * g0, acc[ai][bj][m][1] * g1); } }
    }
};
struct EpiMerge {
    static constexpr bool PERM = true, AFTER_DRAIN = false;
    const bf16_t* G; int ldg; const bf16_t* T; int ldt; bf16_t* O; int ldo;
    __device__ __forceinline__ void operator()(const f32x4 (&acc)[2][2][4][2], const Unit& u, int wr, int wc, int fr, int fq) const {
        const int row0 = u.pm * BM + wr * 64 + fr, col0 = u.pn * BM + wc * 32 + 8 * fq;
#pragma unroll
        for (int ai = 0; ai < 2; ++ai)
#pragma unroll
            for (int m = 0; m < 4; ++m) { const size_t row = (size_t)(row0 + ai * HALF + m * 16);
#pragma unroll
                for (int bj = 0; bj < 2; ++bj) { const u32x4 g = *(const u32x4*)(G + row * ldg + col0 + bj * HALF); f32x4 g0, g1; unpack8(g, g0, g1);
                    const u32x4 tv = *(const u32x4*)(T + row * ldt + col0 + bj * HALF); f32x4 t0, t1; unpack8(tv, t0, t1);
                    *(u32x4*)(O + row * ldo + col0 + bj * HALF) = pack8(t0 + acc[ai][bj][m][0] * g0, t1 + acc[ai][bj][m][1] * g1); } }
    }
};
template <bool MUL, bool XN> struct EpiResid {
    static constexpr bool PERM = true, AFTER_DRAIN = false;
    const float* base; float* out; const float* mul; bf16_t* xn; const float* gain; float* ss; int ld;
    __device__ __forceinline__ void operator()(const f32x4 (&acc)[2][2][4][2], const Unit& u, int wr, int wc, int fr, int fq) const {
        const int row0 = u.pm * BM + wr * 64 + fr, col0 = u.pn * BM + wc * 32 + 8 * fq;
        f32x4 gv[2][2];
#pragma unroll
        for (int bj = 0; bj < 2; ++bj) { if (XN) { gv[bj][0] = *(const f32x4*)(gain + col0 + bj * HALF); gv[bj][1] = *(const f32x4*)(gain + col0 + bj * HALF + 4); } else { gv[bj][0] = (f32x4){0.f, 0.f, 0.f, 0.f}; gv[bj][1] = gv[bj][0]; } }
#pragma unroll
        for (int ai = 0; ai < 2; ++ai) {
            f32x4 pre[4][2][2];
#pragma unroll
            for (int m = 0; m < 4; ++m)
#pragma unroll
                for (int bj = 0; bj < 2; ++bj) { const size_t p = (size_t)(row0 + ai * HALF + m * 16) * ld + col0 + bj * HALF; pre[m][bj][0] = *(const f32x4*)(base + p); pre[m][bj][1] = *(const f32x4*)(base + p + 4); }
            asm volatile("" ::: "memory");
#pragma unroll
            for (int m = 0; m < 4; ++m) { const size_t row = (size_t)(row0 + ai * HALF + m * 16); float s = 0.f;
#pragma unroll
                for (int bj = 0; bj < 2; ++bj) { const size_t p = row * ld + col0 + bj * HALF;
                    f32x4 v0 = acc[ai][bj][m][0], v1 = acc[ai][bj][m][1];
                    if (MUL) { v0 = v0 * *(const f32x4*)(mul + p); v1 = v1 * *(const f32x4*)(mul + p + 4); }
                    v0 = v0 + pre[m][bj][0]; v1 = v1 + pre[m][bj][1];
                    *(f32x4*)(out + p) = v0; *(f32x4*)(out + p + 4) = v1;
                    s += (v0[0] * v0[0] + v0[1] * v0[1]) + (v0[2] * v0[2] + v0[3] * v0[3]) + (v1[0] * v1[0] + v1[1] * v1[1]) + (v1[2] * v1[2] + v1[3] * v1[3]);
                    if (XN) *(u32x4*)(xn + p) = pack8(v0 * gv[bj][0], v1 * gv[bj][1]); }
                { const int ln = fr + 16 * fq; s += shx(s, ln, 16); s += shx(s, ln, 32); }
                if (fq == 0) ss[row * 16 + u.pn * 4 + wc] = s; }
            asm volatile("" ::: "memory");
        }
    }
};
template <bool BB> struct EpiResidB {
    static constexpr bool PERM = true, AFTER_DRAIN = false;
    const void* base; bf16_t* hs; float* ss; int ld;
    __device__ __forceinline__ void operator()(const f32x4 (&acc)[2][2][4][2], const Unit& u, int wr, int wc, int fr, int fq) const {
        const int row0 = u.pm * BM + wr * 64 + fr, col0 = u.pn * BM + wc * 32 + 8 * fq;
#pragma unroll
        for (int ai = 0; ai < 2; ++ai) {
            f32x4 pre[4][2][2];
#pragma unroll
            for (int m = 0; m < 4; ++m)
#pragma unroll
                for (int bj = 0; bj < 2; ++bj) { const size_t p = (size_t)(row0 + ai * HALF + m * 16) * ld + col0 + bj * HALF;
                    if (BB) { const u32x4 b = *(const u32x4*)((const bf16_t*)base + p); unpack8(b, pre[m][bj][0], pre[m][bj][1]); }
                    else { pre[m][bj][0] = *(const f32x4*)((const float*)base + p); pre[m][bj][1] = *(const f32x4*)((const float*)base + p + 4); } }
            asm volatile("" ::: "memory");
#pragma unroll
            for (int m = 0; m < 4; ++m) { const size_t row = (size_t)(row0 + ai * HALF + m * 16); float s = 0.f;
#pragma unroll
                for (int bj = 0; bj < 2; ++bj) { const size_t p = row * ld + col0 + bj * HALF;
                    const f32x4 v0 = acc[ai][bj][m][0] + pre[m][bj][0], v1 = acc[ai][bj][m][1] + pre[m][bj][1];
                    *(u32x4*)(hs + p) = pack8(v0, v1);
                    s += (v0[0] * v0[0] + v0[1] * v0[1]) + (v0[2] * v0[2] + v0[3] * v0[3]) + (v1[0] * v1[0] + v1[1] * v1[1]) + (v1[2] * v1[2] + v1[3] * v1[3]);
}
                { const int ln = fr + 16 * fq; s += shx(s, ln, 16); s += shx(s, ln, 32); }
                if (fq == 0) ss[row * 16 + u.pn * 4 + wc] = s; }
            asm volatile("" ::: "memory");
        }
    }
};
template <bool SIG> struct EpiScale {
    static constexpr bool PERM = true, AFTER_DRAIN = false;
    const float* ss; float inv_n, eps; bf16_t* O; float* F; int ldc;
    __device__ __forceinline__ void operator()(const f32x4 (&acc)[2][2][4][2], const Unit& u, int wr, int wc, int fr, int fq) const {
        const int row0 = u.pm * BM + wr * 64 + fr, col0 = u.pn * BM + wc * 32 + 8 * fq;
#pragma unroll
        for (int ai = 0; ai < 2; ++ai)
#pragma unroll
            for (int m = 0; m < 4; ++m) { const size_t row = (size_t)(row0 + ai * HALF + m * 16); const f32x4* sp = (const f32x4*)(ss + row * 16); const f32x4 sa = (sp[0] + sp[1]) + (sp[2] + sp[3]); const float r = __builtin_amdgcn_rsqf(((sa[0] + sa[1]) + (sa[2] + sa[3])) * inv_n + eps);
#pragma unroll
                for (int bj = 0; bj < 2; ++bj) { f32x4 v0 = acc[ai][bj][m][0] * r, v1 = acc[ai][bj][m][1] * r; const size_t p = row * ldc + col0 + bj * HALF;
                    if (SIG) {
#pragma unroll
                        for (int k = 0; k < 4; ++k) { v0[k] = sigm(v0[k]); v1[k] = sigm(v1[k]); }
                        *(f32x4*)(F + p) = v0; *(f32x4*)(F + p + 4) = v1;
                    } else *(u32x4*)(O + p) = pack8(v0, v1); } }
    }
};

struct EpiPle {
    static constexpr bool PERM = true, AFTER_DRAIN = false;
    const float* ss2; float inv_n, eps; const bf16_t* E; const bf16_t* hs; bf16_t* ho; float* ss3; int ld;
    __device__ __forceinline__ void operator()(const f32x4 (&acc)[2][2][4][2], const Unit& u, int wr, int wc, int fr, int fq) const {
        const int row0 = u.pm * BM + wr * 64 + fr, col0 = u.pn * BM + wc * 32 + 8 * fq;
#pragma unroll
        for (int ai = 0; ai < 2; ++ai)
#pragma unroll
          for (int mp = 0; mp < 2; ++mp) {
            f32x4 pre[2][2][2]; u32x4 ev[2][2]; f32x4 sv[2][4];
#pragma unroll
            for (int mm = 0; mm < 2; ++mm) { const size_t row = (size_t)(row0 + ai * HALF + (2 * mp + mm) * 16); const f32x4* sp = (const f32x4*)(ss2 + row * 16); sv[mm][0] = sp[0]; sv[mm][1] = sp[1]; sv[mm][2] = sp[2]; sv[mm][3] = sp[3];
#pragma unroll
                for (int bj = 0; bj < 2; ++bj) { const size_t p = row * ld + col0 + bj * HALF; { const u32x4 hb = *(const u32x4*)(hs + p); unpack8(hb, pre[mm][bj][0], pre[mm][bj][1]); } ev[mm][bj] = *(const u32x4*)(E + p); } }
            asm volatile("" ::: "memory");
#pragma unroll
            for (int mm = 0; mm < 2; ++mm) { const int m = 2 * mp + mm; const size_t row = (size_t)(row0 + ai * HALF + m * 16); float s = 0.f;
                const f32x4 sa = (sv[mm][0] + sv[mm][1]) + (sv[mm][2] + sv[mm][3]); const float r = __builtin_amdgcn_rsqf(((sa[0] + sa[1]) + (sa[2] + sa[3])) * inv_n + eps);
#pragma unroll
                for (int bj = 0; bj < 2; ++bj) { const size_t p = row * ld + col0 + bj * HALF;
                    f32x4 e0, e1; unpack8(ev[mm][bj], e0, e1);
                    f32x4 v0 = acc[ai][bj][m][0] * r, v1 = acc[ai][bj][m][1] * r;
#pragma unroll
                    for (int k = 0; k < 4; ++k) { v0[k] = sigm(v0[k]); v1[k] = sigm(v1[k]); }
                    v0 = v0 * e0 + pre[mm][bj][0]; v1 = v1 * e1 + pre[mm][bj][1];
                    *(u32x4*)(ho + p) = pack8(v0, v1);
                    s += (v0[0] * v0[0] + v0[1] * v0[1]) + (v0[2] * v0[2] + v0[3] * v0[3]) + (v1[0] * v1[0] + v1[1] * v1[1]) + (v1[2] * v1[2] + v1[3] * v1[3]); }
                { const int ln = fr + 16 * fq; s += shx(s, ln, 16); s += shx(s, ln, 32); }
                if (fq == 0) ss3[row * 16 + u.pn * 4 + wc] = s; }
            asm volatile("" ::: "memory");
          }
    }
};

template <class Epi, class Sched, bool ALIGN_EPI = false, bool SP2 = false>
__device__ __forceinline__ void gemm_phase(PG8_LAS unsigned char* lds, const Gemm g, const Sched& S, const Epi& E, int wave_s) {
    int tid_ = wave_s * 64 + lane_id_v(); asm volatile("" : "+v"(tid_));
    const int tid = tid_, wid = __builtin_amdgcn_readfirstlane(tid >> 6), lane = tid & 63, wr = wid >> 2, wc = wid & 3, fr = lane & 15, fq = lane >> 4;
    const int K = g.K, nt = K / BK;
    unsigned voffA[2], voffB[2];
#pragma unroll
    for (int i = 0; i < 2; ++i) { int R, C; stage_rc(tid * 16 + i * 8192, R, C); const int Rb = Epi::PERM ? ((R & ~31) + perm32(R & 31)) : R;
        voffA[i] = (unsigned)(R * K + C) * 2u; voffB[i] = (unsigned)(Rb * K + C) * 2u; }
    const size_t kstep = (size_t)(BK * 2);
    const size_t hstep = (size_t)HALF * K * 2;
    const size_t tstep = 2 * hstep;
    const unsigned ldsw = (unsigned)wid * 1024u;
    const int aoff = lds_byte(wr * 64 + fr, fq * 8), boff = lds_byte(wc * 32 + fr, fq * 8);
#define PG8_SA(b, h) (((b) * 2 + (h)) * HTB)
#define PG8_SB(b, h) ((4 + (b) * 2 + (h)) * HTB)
#define PG8_STAGE(bufoff, gbase, voff) do { _Pragma("unroll") for (int _i = 0; _i < 2; ++_i) \
        __builtin_amdgcn_global_load_lds((const unsigned*)((const char*)(gbase) + (voff)[_i]), (PG8_LAS unsigned*)(lds + (bufoff) + ldsw + _i * 8192), 16, 0, 0); } while (0)
#define PG8_LDA(dst, b, h) do { _Pragma("unroll") for (int m = 0; m < 4; ++m) _Pragma("unroll") for (int k = 0; k < 2; ++k) dst[m][k] = *(const PG8_LAS bf16x8*)(lds + PG8_SA(b, h) + aoff + m * 2048 + k * 1024); } while (0)
#define PG8_LDB(dst, b, h) do { _Pragma("unroll") for (int n = 0; n < 2; ++n) _Pragma("unroll") for (int k = 0; k < 2; ++k) dst[n][k] = *(const PG8_LAS bf16x8*)(lds + PG8_SB(b, h) + boff + n * 2048 + k * 1024); } while (0)
#define PG8_MMA(ai, bj, At, Bt) do { __builtin_amdgcn_s_setprio(1); _Pragma("unroll") for (int m = 0; m < 4; ++m) _Pragma("unroll") for (int n = 0; n < 2; ++n) _Pragma("unroll") for (int k = 0; k < 2; ++k) \
        acc[ai][bj][m][n] = __builtin_amdgcn_mfma_f32_16x16x32_bf16(Bt[n][k], At[m][k], acc[ai][bj][m][n], 0, 0, 0); __builtin_amdgcn_s_setprio(0); } while (0)
#define PG8_WAIT_V(n) asm volatile("s_waitcnt vmcnt(" #n ")" ::: "memory")
#define PG8_WAIT_L(n) asm volatile("s_waitcnt lgkmcnt(" #n ")" ::: "memory")
#define PG8_BAR __builtin_amdgcn_s_barrier()
#define PG8_SCHED __builtin_amdgcn_sched_barrier(0)
    Unit cur, nxt; int ui = 0;
    if (!S.next(0, cur)) return;
    f32x4 acc[2][2][4][2];
#pragma unroll
    for (int a = 0; a < 2; ++a)
#pragma unroll
        for (int b = 0; b < 2; ++b)
#pragma unroll
            for (int m = 0; m < 4; ++m)
#pragma unroll
                for (int n = 0; n < 2; ++n) acc[a][b][m][n] = (f32x4){0.f, 0.f, 0.f, 0.f};
    bf16x8 At[4][2], B0[2][2], B1[2][2];
    const char* cA = (const char*)g.A + (size_t)cur.pm * tstep; const char* cB = (const char*)g.Bt + (size_t)cur.pn * tstep;
    S.a_ready(cur);
    if constexpr (SP2) {
        PG8_STAGE(PG8_SB(0, 0), cB, voffB); PG8_STAGE(PG8_SB(0, 1), cB + hstep, voffB); PG8_STAGE(PG8_SA(0, 0), cA, voffA); PG8_STAGE(PG8_SA(0, 1), cA + hstep, voffA);
        if (wr == 1) PG8_BAR;
        PG8_WAIT_V(2); PG8_BAR;
        PG8_STAGE(PG8_SB(1, 0), cB + kstep, voffB); PG8_STAGE(PG8_SA(1, 0), cA + kstep, voffA); PG8_STAGE(PG8_SB(1, 1), cB + hstep + kstep, voffB);
        PG8_WAIT_V(6); PG8_BAR;
    } else {
        PG8_STAGE(PG8_SB(0, 0), cB, voffB); PG8_STAGE(PG8_SA(0, 0), cA, voffA); PG8_STAGE(PG8_SB(0, 1), cB + hstep, voffB); PG8_STAGE(PG8_SA(0, 1), cA + hstep, voffA);
        if (wr == 1) PG8_BAR;
        PG8_WAIT_V(4); PG8_BAR;
        PG8_STAGE(PG8_SB(1, 0), cB + kstep, voffB); PG8_STAGE(PG8_SA(1, 0), cA + kstep, voffA); PG8_STAGE(PG8_SB(1, 1), cB + hstep + kstep, voffB);
        PG8_WAIT_V(6); PG8_BAR;
    }
    for (;;) {
        const bool has_next = S.next(ui + 1, nxt);
        const char* nA = has_next ? (const char*)g.A + (size_t)nxt.pm * tstep : cA; const char* nB = has_next ? (const char*)g.Bt + (size_t)nxt.pn * tstep : cB;
        for (int t = 0; t < nt; t += 2) {
            const bool last = (t == nt - 2);
            const char* a1 = cA + (size_t)(t + 1) * kstep;
            const char* a2 = last ? nA : cA + (size_t)(t + 2) * kstep; const char* b2 = last ? nB : cB + (size_t)(t + 2) * kstep;
            const char* a3 = a2 + kstep; const char* b3 = b2 + kstep;
            if (last && has_next) S.a_ready(nxt);
            if constexpr (SP2) {
            PG8_LDB(B0, 0, 0); PG8_LDB(B1, 0, 1); PG8_SCHED; PG8_LDA(At, 0, 0); PG8_STAGE(PG8_SA(1, 1), a1 + hstep, voffA);
            PG8_WAIT_V(8); PG8_WAIT_L(0); PG8_BAR; PG8_MMA(0, 0, At, B0); PG8_MMA(0, 1, At, B1); PG8_BAR; PG8_SCHED;
            PG8_LDA(At, 0, 1); PG8_STAGE(PG8_SB(0, 0), b2, voffB); PG8_STAGE(PG8_SB(0, 1), b2 + hstep, voffB); PG8_STAGE(PG8_SA(0, 0), a2, voffA);
            PG8_WAIT_V(8); PG8_WAIT_L(0); PG8_BAR; PG8_MMA(1, 0, At, B0); PG8_MMA(1, 1, At, B1); PG8_BAR; PG8_SCHED;
            PG8_LDB(B0, 1, 0); PG8_LDB(B1, 1, 1); PG8_SCHED; PG8_LDA(At, 1, 0); PG8_STAGE(PG8_SA(0, 1), a2 + hstep, voffA);
            PG8_WAIT_V(8); PG8_WAIT_L(0); PG8_BAR; PG8_MMA(0, 0, At, B0); PG8_MMA(0, 1, At, B1); PG8_BAR; PG8_SCHED;
            PG8_LDA(At, 1, 1); PG8_STAGE(PG8_SB(1, 0), b3, voffB); PG8_STAGE(PG8_SB(1, 1), b3 + hstep, voffB); PG8_STAGE(PG8_SA(1, 0), a3, voffA);
            PG8_WAIT_V(8); PG8_WAIT_L(0); PG8_BAR; PG8_MMA(1, 0, At, B0); PG8_MMA(1, 1, At, B1); PG8_BAR; PG8_SCHED;
            } else {
            PG8_LDB(B0, 0, 0); PG8_SCHED; PG8_LDA(At, 0, 0); PG8_STAGE(PG8_SA(1, 1), a1 + hstep, voffA);
            PG8_WAIT_L(8); PG8_BAR; PG8_WAIT_L(0); PG8_MMA(0, 0, At, B0); PG8_BAR; PG8_SCHED;
            PG8_LDB(B1, 0, 1); PG8_STAGE(PG8_SB(0, 0), b2, voffB);
            PG8_BAR; PG8_WAIT_L(0); PG8_MMA(0, 1, At, B1); PG8_BAR;
            PG8_LDA(At, 0, 1); PG8_STAGE(PG8_SA(0, 0), a2, voffA);
            PG8_BAR; PG8_WAIT_L(0); PG8_MMA(1, 0, At, B0); PG8_BAR; PG8_SCHED;
            PG8_STAGE(PG8_SB(0, 1), b2 + hstep, voffB);
            PG8_WAIT_V(6); PG8_BAR; PG8_MMA(1, 1, At, B1); PG8_BAR;
            PG8_LDB(B0, 1, 0); PG8_SCHED; PG8_LDA(At, 1, 0); PG8_STAGE(PG8_SA(0, 1), a2 + hstep, voffA);
            PG8_WAIT_L(8); PG8_BAR; PG8_WAIT_L(0); PG8_MMA(0, 0, At, B0); PG8_BAR; PG8_SCHED;
            PG8_LDB(B1, 1, 1); PG8_STAGE(PG8_SB(1, 0), b3, voffB);
            PG8_BAR; PG8_WAIT_L(0); PG8_MMA(0, 1, At, B1); PG8_BAR;
            PG8_LDA(At, 1, 1); PG8_STAGE(PG8_SA(1, 0), a3, voffA);
            PG8_BAR; PG8_WAIT_L(0); PG8_MMA(1, 0, At, B0); PG8_BAR; PG8_SCHED;
            PG8_STAGE(PG8_SB(1, 1), b3 + hstep, voffB);
            PG8_WAIT_V(6); PG8_BAR; PG8_MMA(1, 1, At, B1); PG8_BAR;
            }
        }
        if constexpr (ALIGN_EPI) { if (wr == 0) PG8_BAR; }
        if constexpr (!Epi::AFTER_DRAIN) { E(acc, cur, wr, wc, fr, fq); S.done(cur); }
        if (!has_next) break;
#pragma unroll
        for (int a = 0; a < 2; ++a)
#pragma unroll
            for (int b = 0; b < 2; ++b)
#pragma unroll
                for (int m = 0; m < 4; ++m)
#pragma unroll
                    for (int n = 0; n < 2; ++n) acc[a][b][m][n] = (f32x4){0.f, 0.f, 0.f, 0.f};
        cur = nxt; cA = nA; cB = nB; ++ui;
        if constexpr (ALIGN_EPI) { if (wr == 1) PG8_BAR; }
    }
    PG8_WAIT_V(0);
    if constexpr (!ALIGN_EPI) { if (wr == 0) PG8_BAR; }
    PG8_BAR;
    if constexpr (Epi::AFTER_DRAIN) { E.fused(acc, cur, wr, wc, fr, fq, lds, wid, lane); S.done(cur); }
#undef PG8_SA
#undef PG8_SB
#undef PG8_STAGE
#undef PG8_LDA
#undef PG8_LDB
#undef PG8_MMA
#undef PG8_WAIT_V
#undef PG8_WAIT_L
#undef PG8_BAR
#undef PG8_SCHED
}
}

#ifndef PG8_SP2
#define PG8_SP2 true
#endif
#ifndef PG8_ALIGN
#define PG8_ALIGN true
#endif
#include <hip/hip_bf16.h>
#include <cmath>
#include <hip/hip_bf16.h>
#include <cmath>
namespace attn_body {
using bf16=__hip_bfloat16;
using bf16x8=__attribute__((ext_vector_type(8)))short;
using s16x4=__attribute__((ext_vector_type(4)))short;
using f32x16=__attribute__((ext_vector_type(16)))float;
using u32x4=__attribute__((ext_vector_type(4)))unsigned;
constexpr int BATCH=2,NHEAD=16,SEQ=8192,D=64,DM=NHEAD*D;
constexpr int NW=8,QBLK=32,QB=QBLK*NW,KVBLK=64,NQB=SEQ/QB;
constexpr int ATTN_PITCH=DM, ATTN_UNIT_ROWS=QB;
__device__ __forceinline__ int crow(int r,int hi){return (r&3)+8*(r>>2)+4*hi;}
#define SBAR() __builtin_amdgcn_sched_barrier(0)
__device__ __forceinline__ void cmask(f32x16&p0,f32x16&p1,int jb,int qrel,int hi){
  const float NEG=-INFINITY; int kb=64*jb+4*hi;
  #pragma unroll
  for(int r=0;r<16;++r){int kv=kb+(r&3)+8*(r>>2); if(kv>qrel)p0[r]=NEG; if(kv+32>qrel)p1[r]=NEG;}
}

constexpr int NSLOT=3, SLOTB=8192;
constexpr int LDS_K=0, LDS_V=NSLOT*SLOTB, LDS_WS=2*NSLOT*SLOTB, LDS_OST=LDS_WS+NW*64*4, LDS_BYTES=LDS_OST+NW*4096;
constexpr float C2=0.125f*1.4426950408889634f;
__device__ __forceinline__ void glds16(const void*gsrc,unsigned lds_dst){unsigned keep;
  asm volatile("s_mov_b32 %0, m0\n\ts_mov_b32 m0, %2\n\ts_nop 0\n\tglobal_load_lds_dwordx4 %1, off\n\ts_mov_b32 m0, %0":"=&s"(keep):"v"(gsrc),"s"(lds_dst):"memory");}
__device__ __forceinline__ float max3f(float a,float b,float c){float r;asm("v_max3_f32 %0, %1, %2, %3":"=v"(r):"v"(a),"v"(b),"v"(c));return r;}
__device__ __forceinline__ float max2f(float a,float b){float r;asm("v_max_f32_e32 %0, %1, %2":"=v"(r):"v"(a),"v"(b));return r;}
__device__ __forceinline__ float fadd_s(float a,float b){float r;asm("v_add_f32_e32 %0, %1, %2":"=v"(r):"v"(a),"v"(b));return r;}
__device__ __forceinline__ float fsub_s(float a,float b){float r;asm("v_sub_f32_e32 %0, %1, %2":"=v"(r):"v"(a),"v"(b));return r;}
typedef float f32x2_t __attribute__((ext_vector_type(2))); typedef __bf16 bf16x2_t __attribute__((ext_vector_type(2)));
__device__ __forceinline__ unsigned cvtpk_s(float lo,float hi){f32x2_t v={lo,hi};bf16x2_t b=__builtin_convertvector(v,bf16x2_t);return __builtin_bit_cast(unsigned,b);}
#define WAIT_BAR(N) asm volatile("s_waitcnt vmcnt(" #N ") lgkmcnt(0)\n\ts_barrier":::"memory")

__device__ __forceinline__ void qkt(f32x16&p0,f32x16&p1,const char*Kslot,const bf16x8*qr,const f32x16&negm,int r32,int hi){
  const char*kb=Kslot+hi*1024+r32*16;
  #pragma unroll
  for(int d0=0;d0<4;++d0){
    const bf16x8 b0=*reinterpret_cast<const bf16x8*>(kb+d0*2048);
    const bf16x8 b1=*reinterpret_cast<const bf16x8*>(kb+d0*2048+512);
    if(d0==0){p0=__builtin_amdgcn_mfma_f32_32x32x16_bf16(b0,qr[0],negm,0,0,0);p1=__builtin_amdgcn_mfma_f32_32x32x16_bf16(b1,qr[0],negm,0,0,0);}
    else{p0=__builtin_amdgcn_mfma_f32_32x32x16_bf16(b0,qr[d0],p0,0,0,0);p1=__builtin_amdgcn_mfma_f32_32x32x16_bf16(b1,qr[d0],p1,0,0,0);}}
}
typedef __attribute__((address_space(3))) const char* lds_cptr;
typedef short v4i16_t __attribute__((ext_vector_type(4)));
__device__ __forceinline__ void kload8(bf16x8*kf,lds_cptr kp){
  kf[0]=*(const __attribute__((address_space(3))) bf16x8*)(kp);      kf[1]=*(const __attribute__((address_space(3))) bf16x8*)(kp+512);
  kf[2]=*(const __attribute__((address_space(3))) bf16x8*)(kp+2048); kf[3]=*(const __attribute__((address_space(3))) bf16x8*)(kp+2560);
  kf[4]=*(const __attribute__((address_space(3))) bf16x8*)(kp+4096); kf[5]=*(const __attribute__((address_space(3))) bf16x8*)(kp+4608);
  kf[6]=*(const __attribute__((address_space(3))) bf16x8*)(kp+6144); kf[7]=*(const __attribute__((address_space(3))) bf16x8*)(kp+6656);
}
__device__ __forceinline__ void kload2(bf16x8*kf,lds_cptr kp,int j){ kf[2*j]=*(const __attribute__((address_space(3))) bf16x8*)(kp+j*2048); kf[2*j+1]=*(const __attribute__((address_space(3))) bf16x8*)(kp+j*2048+512); }
__device__ __forceinline__ s16x4 vtr(lds_cptr p){ return __builtin_bit_cast(s16x4,__builtin_amdgcn_ds_read_tr16_b64_v4i16((__attribute__((address_space(3))) v4i16_t*)p)); }
__device__ __forceinline__ float rowmax(const f32x16&p0,const f32x16&p1){
  float a=max3f(p0[0],p0[1],p1[0]),b=max3f(p0[2],p0[3],p1[1]);a=max3f(a,p1[2],p1[3]);
  #pragma unroll
  for(int r=4;r<16;r+=4){a=max3f(a,p0[r],p0[r+1]);b=max3f(b,p0[r+2],p0[r+3]);a=max3f(a,p1[r],p1[r+1]);b=max3f(b,p1[r+2],p1[r+3]);}
  const float m=max2f(a,b);
  auto rr=__builtin_amdgcn_permlane32_swap(__float_as_uint(m),__float_as_uint(m),false,false);
  return max2f(__uint_as_float(rr[0]),__uint_as_float(rr[1]));
}
__device__ __forceinline__ void pv(f32x16*o,int vb,bf16x8 pa0,bf16x8 pa1,bf16x8 pa2,bf16x8 pa3){
  #pragma unroll
  for(int d0=0;d0<2;++d0){s16x4 lo[4],hi[4];
    #pragma unroll
    for(int ks=0;ks<4;++ks){
      asm volatile("ds_read_b64_tr_b16 %0,%1 offset:%c2":"=&v"(lo[ks]):"v"(vb),"i"(d0*4096+ks*1024):"memory");
      asm volatile("ds_read_b64_tr_b16 %0,%1 offset:%c2":"=&v"(hi[ks]):"v"(vb),"i"(d0*4096+ks*1024+512):"memory");}
    asm volatile("s_waitcnt lgkmcnt(0)":::"memory");SBAR();
    #define PK(k) (bf16x8){lo[k][0],lo[k][1],lo[k][2],lo[k][3],hi[k][0],hi[k][1],hi[k][2],hi[k][3]}
    o[d0]=__builtin_amdgcn_mfma_f32_32x32x16_bf16(pa0,PK(0),o[d0],0,0,0);
    o[d0]=__builtin_amdgcn_mfma_f32_32x32x16_bf16(pa1,PK(1),o[d0],0,0,0);
    o[d0]=__builtin_amdgcn_mfma_f32_32x32x16_bf16(pa2,PK(2),o[d0],0,0,0);
    o[d0]=__builtin_amdgcn_mfma_f32_32x32x16_bf16(pa3,PK(3),o[d0],0,0,0);
    #undef PK
  }
}

#ifndef ATTN_STORE16
#define ATTN_STORE16(p,v) (*(u32x4*)(p)=(v))
#endif
template<int THRL> __device__ __forceinline__ void attn_unit(int qb,const bf16*Qh,const bf16*Kh,const bf16*Vh,bf16*Oh,int pq,int pk,int pv_,int po,char*shm,int wave_s){
  int tid_=wave_s*64+lane_id_v(); asm volatile("":"+v"(tid_)); const int tid=tid_,lane=tid&63,r32=lane&31,hi=lane>>5; const int wid=__builtin_amdgcn_readfirstlane(tid>>6);
  const int q0=qb*QB;
  const bf16*Qw=Qh+(long)(q0+wid*QBLK)*pq;
  const unsigned lds0=(unsigned)(uintptr_t)shm;
  float*wsf=(float*)(shm+LDS_WS)+wid*64;
  const bf16*ksrc=Kh+(long)lane*pk+wid*8;
  const bf16*vsrc=Vh+(long)(16*(wid&3)+(lane>>2))*pv_+(wid>>2)*32+(lane&3)*8;
  const unsigned kdst=lds0+LDS_K+wid*1024, vdst=lds0+LDS_V+wid*1024;
  #define DMA_K(t,slot) glds16(ksrc+(long)(t)*KVBLK*pk,(unsigned)__builtin_amdgcn_readfirstlane(kdst+(slot)))
  #define DMA_V(t,slot) glds16(vsrc+(long)(t)*KVBLK*pv_,(unsigned)__builtin_amdgcn_readfirstlane(vdst+(slot)))
  const int vb0=(int)(lds0+LDS_V)+((lane>>4)&1)*32+(lane&3)*8+(4*hi+((lane&15)>>2))*64;
  const char*Kbase=shm+LDS_K; bf16x8 kf[8];
  const lds_cptr shm3=(lds_cptr)shm; const lds_cptr kp0=shm3+LDS_K+hi*1024+r32*16; const lds_cptr vp0=shm3+LDS_V+((lane>>4)&1)*32+(lane&3)*8+(4*hi+((lane&15)>>2))*64;
  constexpr int NT=SEQ/KVBLK;
  DMA_K(0,0);DMA_V(0,0);DMA_K(1,SLOTB);
  bf16x8 qr[4];
  #pragma unroll
  for(int d0=0;d0<4;++d0)qr[d0]=*reinterpret_cast<const bf16x8*>(&Qw[(long)r32*pq+d0*16+hi*8]);
  float mhat=0.f,l_reg=0.f;f32x16 o[2];o[0]=f32x16{};o[1]=f32x16{};f32x16 negm=f32x16{};asm volatile("":"+v"(negm));

  #define CMASK(P0,P1,t) do{}while(0)
  bool resc=false;
  #define START(P0,P1) do{ const float rm=rowmax(P0,P1); resc=false; \
    { const float dl=rm; mhat=fadd_s(mhat,dl); \
      _Pragma("unroll") for(int r=0;r<16;++r){P0[r]=fsub_s(P0[r],dl);P1[r]=fsub_s(P1[r],dl);} \
      _Pragma("unroll") for(int r=0;r<16;++r)negm[r]=-mhat; asm volatile("":"+v"(negm)); } \
    _Pragma("unroll") for(int r=0;r<16;++r)P0[r]=__builtin_amdgcn_exp2f(P0[r]); }while(0)
  #define RESC() do{ if(resc){ asm volatile("s_waitcnt lgkmcnt(0)":::"memory"); \
      _Pragma("unroll") for(int d_=0;d_<2;++d_) _Pragma("unroll") for(int r=0;r<16;++r)o[d_][r]*=wsf[crow(r,hi)]; } }while(0)
  f32x16 pA0,pA1,pB0,pB1;
  int sl_prev=0,sl_cur=0,sl_next=SLOTB;
  #define ROT() do{sl_prev=sl_cur;sl_cur=sl_next;sl_next=(sl_next==(NSLOT-1)*SLOTB)?0:sl_next+SLOTB;}while(0)
  DMA_K(2,2*SLOTB);
  WAIT_BAR(3);
  qkt(pA0,pA1,Kbase,qr,negm,r32,hi);asm volatile("s_nop 15\n\ts_nop 7":"+v"(pA0),"+v"(pA1));CMASK(pA0,pA1,0);
  START(pA0,pA1);
  _Pragma("unroll") for(int r=0;r<16;++r)pA1[r]=__builtin_amdgcn_exp2f(pA1[r]);
  WAIT_BAR(0);
  DMA_K(3,0);DMA_V(1,SLOTB);
  ROT();
  kload8(kf,kp0+sl_cur);
  WAIT_BAR(2);
  s16x4 vlo[8],vhi[8]; u32x4 pw0,pw1,pw2,pw3;
  #define PKW(P,B) cvtpk_s(P[B],P[B+1])
  #define PAF(k) __builtin_bit_cast(bf16x8,pw##k)
  #define VFR(i) (bf16x8){vlo[i][0],vlo[i][1],vlo[i][2],vlo[i][3],vhi[i][0],vhi[i][1],vhi[i][2],vhi[i][3]}
  #define PIN(x) asm volatile("":"+v"(x))
  #define MX3(a,b,c) __builtin_fmaxf(__builtin_fmaxf((a),(b)),(c))
  #define GAPA(MF,A0,A1,A2,A3,W0,W1,PW) do{ MF; sacc+=A0; sacc+=A1; sacc+=A2; sacc+=A3; PIN(sacc); W0; W1; PIN(PW); SBAR(); }while(0)
  #define EX(v) __builtin_amdgcn_exp2f(v)
  #define GAPB(MF,X,B) do{ MF; X[B]=EX(X[B]); X[B+1]=EX(X[B+1]); X[B+2]=EX(X[B+2]); X[B+3]=EX(X[B+3]); PIN(X); SBAR(); }while(0)
  #define VRD(i) do{ vlo[i]=vtr(vp_+(((i)>>2)*4096+((i)&3)*1024)); vhi[i]=vtr(vp_+(((i)>>2)*4096+((i)&3)*1024+512)); }while(0)
  #define KRD(G,j) do{ if(G){ kload2(kf,kp0+sl_next,j); SBAR(); } }while(0)
  #define STEP(C0,C1,P0,P1,t,GK,GV,GL) do{ SBAR(); \
    const lds_cptr vp_=vp0+sl_prev; \
    VRD(0); SBAR(); float sacc=(P0[0]+P0[1]); \
    GAPA(C0=__builtin_amdgcn_mfma_f32_32x32x16_bf16(kf[0],qr[0],negm,0,0,0), P0[2],P0[3],P0[4],P0[5],     pw0[0]=PKW(P0,0), pw0[1]=PKW(P0,2), pw0); \
    VRD(4); SBAR(); GAPA(C1=__builtin_amdgcn_mfma_f32_32x32x16_bf16(kf[1],qr[0],negm,0,0,0), P0[6],P0[7],P0[8],P0[9],     pw0[2]=PKW(P0,4), pw0[3]=PKW(P0,6), pw0); \
    VRD(1); SBAR(); GAPA(C0=__builtin_amdgcn_mfma_f32_32x32x16_bf16(kf[2],qr[1],C0,0,0,0),   P0[10],P0[11],P0[12],P0[13], pw1[0]=PKW(P0,8), pw1[1]=PKW(P0,10), pw1); \
    VRD(5); SBAR(); GAPA(C1=__builtin_amdgcn_mfma_f32_32x32x16_bf16(kf[3],qr[1],C1,0,0,0),   P0[14],P0[15],P1[0],P1[1],   pw1[2]=PKW(P0,12),pw1[3]=PKW(P0,14), pw1); \
    VRD(2); SBAR(); GAPA(C0=__builtin_amdgcn_mfma_f32_32x32x16_bf16(kf[4],qr[2],C0,0,0,0),   P1[2],P1[3],P1[4],P1[5],     pw2[0]=PKW(P1,0), pw2[1]=PKW(P1,2), pw2); \
    VRD(6); SBAR(); GAPA(C1=__builtin_amdgcn_mfma_f32_32x32x16_bf16(kf[5],qr[2],C1,0,0,0),   P1[6],P1[7],P1[8],P1[9],     pw2[2]=PKW(P1,4), pw2[3]=PKW(P1,6), pw2); \
    VRD(3); SBAR(); GAPA(C0=__builtin_amdgcn_mfma_f32_32x32x16_bf16(kf[6],qr[3],C0,0,0,0),   P1[10],P1[11],P1[12],P1[13], pw3[0]=PKW(P1,8), pw3[1]=PKW(P1,10), pw3); \
    VRD(7); SBAR(); GAPA(C1=__builtin_amdgcn_mfma_f32_32x32x16_bf16(kf[7],qr[3],C1,0,0,0),   P1[14],P1[15],0.f,0.f,       pw3[2]=PKW(P1,12),pw3[3]=PKW(P1,14), pw3); \
    l_reg+=sacc; \
    if(GK){DMA_K((t)+3,sl_cur);} if(GV){DMA_V((t)+1,sl_next);} \
    CMASK(C0,C1,t); \
    { float a=MX3(C0[0],C0[1],C1[0]),b=MX3(C0[2],C0[3],C1[1]); a=MX3(a,C1[2],C1[3]); \
      _Pragma("unroll") for(int r=4;r<16;r+=4){a=MX3(a,C0[r],C0[r+1]);b=MX3(b,C0[r+2],C0[r+3]);a=MX3(a,C1[r],C1[r+1]);b=MX3(b,C1[r+2],C1[r+3]);} \
      float rm=__builtin_fmaxf(a,b); { auto rr=__builtin_amdgcn_permlane32_swap(__float_as_uint(rm),__float_as_uint(rm),false,false); rm=__builtin_fmaxf(__uint_as_float(rr[0]),__uint_as_float(rr[1])); } \
      resc=false; \
      if(__builtin_expect(__any(rm>(float)THRL),0)){ const float dl=__builtin_fmaxf(rm,0.f); mhat+=dl; \
        _Pragma("unroll") for(int r=0;r<16;++r){C0[r]-=dl;C1[r]-=dl;} \
        _Pragma("unroll") for(int r=0;r<16;++r)negm[r]=-mhat; asm volatile("":"+v"(negm)); \
        const float f=__builtin_amdgcn_exp2f(-dl); l_reg*=f; if(hi==0)wsf[r32]=f; resc=true; } } \
    SBAR(); \
    GAPB(o[0]=__builtin_amdgcn_mfma_f32_32x32x16_bf16(PAF(0),VFR(0),o[0],0,0,0), C0,0); \
    GAPB(o[1]=__builtin_amdgcn_mfma_f32_32x32x16_bf16(PAF(0),VFR(4),o[1],0,0,0), C0,4); \
    KRD(GL,0); GAPB(o[0]=__builtin_amdgcn_mfma_f32_32x32x16_bf16(PAF(1),VFR(1),o[0],0,0,0), C0,8); \
    KRD(GL,1); GAPB(o[1]=__builtin_amdgcn_mfma_f32_32x32x16_bf16(PAF(1),VFR(5),o[1],0,0,0), C0,12); \
    KRD(GL,2); GAPB(o[0]=__builtin_amdgcn_mfma_f32_32x32x16_bf16(PAF(2),VFR(2),o[0],0,0,0), C1,0); \
    KRD(GL,3); GAPB(o[1]=__builtin_amdgcn_mfma_f32_32x32x16_bf16(PAF(2),VFR(6),o[1],0,0,0), C1,4); \
    GAPB(o[0]=__builtin_amdgcn_mfma_f32_32x32x16_bf16(PAF(3),VFR(3),o[0],0,0,0), C1,8); \
    GAPB(o[1]=__builtin_amdgcn_mfma_f32_32x32x16_bf16(PAF(3),VFR(7),o[1],0,0,0), C1,12); \
    }while(0)
  int t=1;
  #undef CMASK
  #define CMASK(P0,P1,t) do{}while(0)
  for(;t+5<NT;t+=2){
    STEP(pB0,pB1,pA0,pA1,t,true,true,true);     WAIT_BAR(2); RESC(); ROT();
    STEP(pA0,pA1,pB0,pB1,t+1,true,true,true);   WAIT_BAR(2); RESC(); ROT();
  }
  #undef CMASK
  #define CMASK(P0,P1,t) do{}while(0)
  #define ENDW(tt) do{ if((tt)+3<NT){WAIT_BAR(2);} else if((tt)+2<NT){WAIT_BAR(1);} else {WAIT_BAR(0);} }while(0)
  for(;t+1<NT;t+=2){
    STEP(pB0,pB1,pA0,pA1,t,(t+3<NT),(t+1<NT),(t+1<NT));       ENDW(t);   RESC(); ROT();
    STEP(pA0,pA1,pB0,pB1,t+1,(t+4<NT),(t+2<NT),(t+2<NT));     ENDW(t+1); RESC(); ROT();
  }
  STEP(pB0,pB1,pA0,pA1,NT-1,false,false,false); RESC();
  { float sacc=pB0[0]+pB0[1]; _Pragma("unroll") for(int r=2;r<16;++r)sacc+=pB0[r]; _Pragma("unroll") for(int r=0;r<16;++r)sacc+=pB1[r]; l_reg+=sacc;
    pw0=(u32x4){PKW(pB0,0),PKW(pB0,2),PKW(pB0,4),PKW(pB0,6)};pw1=(u32x4){PKW(pB0,8),PKW(pB0,10),PKW(pB0,12),PKW(pB0,14)};pw2=(u32x4){PKW(pB1,0),PKW(pB1,2),PKW(pB1,4),PKW(pB1,6)};pw3=(u32x4){PKW(pB1,8),PKW(pB1,10),PKW(pB1,12),PKW(pB1,14)};
    SBAR(); pv(o,vb0+sl_cur,PAF(0),PAF(1),PAF(2),PAF(3)); }
  #undef PKW
  #undef PAF
  #undef VFR
  #undef PIN
  #undef MX3
  #undef GAPA
  #undef GAPB
  #undef EX
  #undef VRD
  #undef KRD
  #undef STEP
  #undef ENDW
  {auto rr=__builtin_amdgcn_permlane32_swap(__float_as_uint(l_reg),__float_as_uint(l_reg),false,false);l_reg=__uint_as_float(rr[0])+__uint_as_float(rr[1]);}
  if(hi==0)wsf[32+r32]=l_reg;asm volatile("s_waitcnt lgkmcnt(0)":::"memory");
  float rli[16];
  #pragma unroll
  for(int r=0;r<16;++r)rli[r]=__builtin_amdgcn_rcpf(wsf[32+crow(r,hi)]);
  bf16*Ow=Oh+(long)(q0+wid*QBLK)*po;
  { bf16*stg=(bf16*)(shm+LDS_OST)+wid*2048;
    #pragma unroll
    for(int r=0;r<16;++r){const int orow=crow(r,hi);
      #pragma unroll
      for(int d0=0;d0<2;++d0)stg[orow*64+d0*32+r32]=__float2bfloat16(o[d0][r]*rli[r]);}
    asm volatile("s_waitcnt lgkmcnt(0)":::"memory");
    #pragma unroll
    for(int i=0;i<4;++i){const int row=i*8+(lane>>3),ch=lane&7; const u32x4 v=*(const u32x4*)(stg+row*64+ch*8); ATTN_STORE16(Ow+(long)row*po+ch*8,v);} }
  asm volatile("s_waitcnt lgkmcnt(0)\n\ts_barrier":::"memory");
  #undef DMA_K
  #undef DMA_V
  #undef CMASK
  #undef START
  #undef RESC
  #undef ROT
}
#undef SBAR
#undef WAIT_BAR
}
namespace attn128 {
using bf16 = __hip_bfloat16;
using bf16x8 = __attribute__((ext_vector_type(8))) short;
using s16x4  = __attribute__((ext_vector_type(4))) short;
using f32x16 = __attribute__((ext_vector_type(16))) float;
using u32x4  = __attribute__((ext_vector_type(4))) unsigned;
constexpr int NW = 8, QBLK = 32, KVBLK = 64, SEQ = 8192;
constexpr float THR = 8.f;
constexpr size_t SHM_V = KVBLK * 128 * 2, SHM_K = KVBLK * 64 * 2, SHM_ATTN = 2 * SHM_V + 2 * SHM_K + NW * 64 * 4;
#define KSWZ64(row, colB) ((row) * 128 + ((colB) ^ ((((row) >> 1) & 7) << 4)))
#define SBAR() __builtin_amdgcn_sched_barrier(0)
#define WGBAR() asm volatile("s_waitcnt lgkmcnt(0)\n\ts_barrier" ::: "memory")
__device__ __forceinline__ int crow(int r, int hi) { return (r & 3) + 8 * (r >> 2) + 4 * hi; }
__device__ __forceinline__ unsigned cvtpk(float lo, float hi) { unsigned r; asm volatile("v_cvt_pk_bf16_f32 %0, %1, %2" : "=v"(r) : "v"(lo), "v"(hi)); return r; }
__device__ __forceinline__ void partialSM_nocheck(f32x16& p0, float& alpha) {
  alpha = 1.f;
#pragma unroll
  for (int r = 0; r < 16; ++r) p0[r] = __builtin_amdgcn_exp2f(p0[r]);
}
template <bool FIRST> __device__ __forceinline__ void partialSM(f32x16& p0, f32x16& p1, float& m_reg, f32x16& negm, float& alpha) {
  float pmax = p0[0];
#pragma unroll
  for (int r = 1; r < 16; ++r) pmax = fmaxf(pmax, p0[r]);
#pragma unroll
  for (int r = 0; r < 16; ++r) pmax = fmaxf(pmax, p1[r]);
  { auto rr = __builtin_amdgcn_permlane32_swap(__float_as_uint(pmax), __float_as_uint(pmax), false, false);
    pmax = fmaxf(__uint_as_float(rr[0]), __uint_as_float(rr[1])); }
  if (!FIRST && __builtin_expect(__all(pmax <= THR), 1)) { alpha = 1.f; }
  else { const float d = FIRST ? pmax : fmaxf(pmax, 0.f); alpha = FIRST ? 1.f : __builtin_amdgcn_exp2f(-d); m_reg += d;
#pragma unroll
    for (int r = 0; r < 16; ++r) { p0[r] -= d; p1[r] -= d; }
#pragma unroll
    for (int r = 0; r < 16; ++r) negm[r] = -m_reg;
    asm volatile("" : "+v"(negm)); }
#pragma unroll
  for (int r = 0; r < 16; ++r) p0[r] = __builtin_amdgcn_exp2f(p0[r]);
}
__device__ __forceinline__ void finishSM(f32x16& p0, f32x16& p1, float alpha, float& l_reg, bf16x8& pa0, bf16x8& pa1, bf16x8& pa2, bf16x8& pa3) {
#pragma unroll
  for (int r = 0; r < 16; ++r) p1[r] = __builtin_amdgcn_exp2f(p1[r]);
  float ps = 0;
#pragma unroll
  for (int r = 0; r < 16; ++r) ps += p0[r];
#pragma unroll
  for (int r = 0; r < 16; ++r) ps += p1[r];
  { auto rr = __builtin_amdgcn_permlane32_swap(__float_as_uint(ps), __float_as_uint(ps), false, false);
    ps = __uint_as_float(rr[0]) + __uint_as_float(rr[1]); }
  l_reg = l_reg * alpha + ps;
#define PK4(P, BASE, OUT) do { unsigned a0 = cvtpk(P[BASE + 0], P[BASE + 1]), a1 = cvtpk(P[BASE + 2], P[BASE + 3]);   \
    unsigned b0 = cvtpk(P[BASE + 4], P[BASE + 5]), b1 = cvtpk(P[BASE + 6], P[BASE + 7]);                              \
    auto r0 = __builtin_amdgcn_permlane32_swap(a0, b0, false, false); auto r1 = __builtin_amdgcn_permlane32_swap(a1, b1, false, false); \
    u32x4 w = {r0[0], r1[0], r0[1], r1[1]}; OUT = *reinterpret_cast<bf16x8*>(&w); } while (0)
  PK4(p0, 0, pa0); PK4(p0, 8, pa1); PK4(p1, 0, pa2); PK4(p1, 8, pa3);
#undef PK4
}
__device__ __forceinline__ void qkt(f32x16& p0, f32x16& p1, const char* Ks, const bf16x8* qr, const f32x16& negm, int r32, int hi) {
  p0 = negm; p1 = negm;
#pragma unroll
  for (int d0 = 0; d0 < 4; ++d0) { const int cb = (d0 * 16 + hi * 8) * 2;
    bf16x8 b0 = *reinterpret_cast<const bf16x8*>(Ks + KSWZ64(r32, cb));
    bf16x8 b1 = *reinterpret_cast<const bf16x8*>(Ks + KSWZ64(32 + r32, cb));
    p0 = __builtin_amdgcn_mfma_f32_32x32x16_bf16(b0, qr[d0], p0, 0, 0, 0);
    p1 = __builtin_amdgcn_mfma_f32_32x32x16_bf16(b1, qr[d0], p1, 0, 0, 0); }
}
__device__ __forceinline__ int v_st(int k, int c) { const int kk = (k & ~0xC) | ((k & 4) << 1) | ((k & 8) >> 1); return ((kk >> 3) * 4 + (c >> 5)) * 512 + ((kk & 7) * 32 + (c & 31)) * 2; }
__device__ __forceinline__ int v_rd_base(int lane) { return ((lane & 3) << 3) | (((lane >> 2) & 3) << 6) | (((lane >> 4) & 1) << 5) | (((lane >> 5) & 1) << 8); }
constexpr int v_rd_off(int d0, int ks, int half) { return d0 * 512 + ks * 4096 + half * 2048; }
template <int OFF> __device__ __forceinline__ s16x4 tr_read(int vb) { s16x4 r; asm volatile("ds_read_b64_tr_b16 %0, %1 offset:%2" : "=&v"(r) : "v"(vb), "i"(OFF) : "memory"); return r; }
template <int D0> __device__ __forceinline__ void pv_one(f32x16& od, int vb, bf16x8 pa0, bf16x8 pa1, bf16x8 pa2, bf16x8 pa3) {
  const s16x4 l0 = tr_read<v_rd_off(D0, 0, 0)>(vb), h0 = tr_read<v_rd_off(D0, 0, 1)>(vb), l1 = tr_read<v_rd_off(D0, 1, 0)>(vb), h1 = tr_read<v_rd_off(D0, 1, 1)>(vb);
  const s16x4 l2 = tr_read<v_rd_off(D0, 2, 0)>(vb), h2 = tr_read<v_rd_off(D0, 2, 1)>(vb), l3 = tr_read<v_rd_off(D0, 3, 0)>(vb), h3 = tr_read<v_rd_off(D0, 3, 1)>(vb);
  asm volatile("s_waitcnt lgkmcnt(0)" ::: "memory"); SBAR();
#define PK(L, H) (bf16x8){L[0], L[1], L[2], L[3], H[0], H[1], H[2], H[3]}
  od = __builtin_amdgcn_mfma_f32_32x32x16_bf16(pa0, PK(l0, h0), od, 0, 0, 0);
  od = __builtin_amdgcn_mfma_f32_32x32x16_bf16(pa1, PK(l1, h1), od, 0, 0, 0);
  od = __builtin_amdgcn_mfma_f32_32x32x16_bf16(pa2, PK(l2, h2), od, 0, 0, 0);
  od = __builtin_amdgcn_mfma_f32_32x32x16_bf16(pa3, PK(l3, h3), od, 0, 0, 0);
#undef PK
}
#define PV_RD(F, D0) do { F[0] = tr_read<v_rd_off(D0, 0, 0)>(vb); F[1] = tr_read<v_rd_off(D0, 0, 1)>(vb); F[2] = tr_read<v_rd_off(D0, 1, 0)>(vb); F[3] = tr_read<v_rd_off(D0, 1, 1)>(vb); \
    F[4] = tr_read<v_rd_off(D0, 2, 0)>(vb); F[5] = tr_read<v_rd_off(D0, 2, 1)>(vb); F[6] = tr_read<v_rd_off(D0, 3, 0)>(vb); F[7] = tr_read<v_rd_off(D0, 3, 1)>(vb); } while (0)
#define PV_PK(L, H) (bf16x8){L[0], L[1], L[2], L[3], H[0], H[1], H[2], H[3]}
#define PV_MF(OD, F) do { OD = __builtin_amdgcn_mfma_f32_32x32x16_bf16(pa0, PV_PK(F[0], F[1]), OD, 0, 0, 0); OD = __builtin_amdgcn_mfma_f32_32x32x16_bf16(pa1, PV_PK(F[2], F[3]), OD, 0, 0, 0); \
    OD = __builtin_amdgcn_mfma_f32_32x32x16_bf16(pa2, PV_PK(F[4], F[5]), OD, 0, 0, 0); OD = __builtin_amdgcn_mfma_f32_32x32x16_bf16(pa3, PV_PK(F[6], F[7]), OD, 0, 0, 0); } while (0)
__device__ __forceinline__ void pv_d0(f32x16* o, int vb, bf16x8 pa0, bf16x8 pa1, bf16x8 pa2, bf16x8 pa3) {
  s16x4 fa[8], fb[8];
  PV_RD(fa, 0); PV_RD(fb, 1);
  asm volatile("s_waitcnt lgkmcnt(8)" ::: "memory"); SBAR();
  PV_MF(o[0], fa); SBAR();
  PV_RD(fa, 2);
  asm volatile("s_waitcnt lgkmcnt(8)" ::: "memory"); SBAR();
  PV_MF(o[1], fb); SBAR();
  PV_RD(fb, 3);
  asm volatile("s_waitcnt lgkmcnt(8)" ::: "memory"); SBAR();
  PV_MF(o[2], fa); SBAR();
  asm volatile("s_waitcnt lgkmcnt(0)" ::: "memory"); SBAR();
  PV_MF(o[3], fb);
}
#undef PV_RD
#undef PV_PK
#undef PV_MF
__device__ __forceinline__ void attn128_unit(int qb, const bf16* __restrict__ Qh0, const bf16* __restrict__ Kh0, const bf16* __restrict__ Vh, bf16* __restrict__ Oh,
                                             int pq, int pk, int pv_, int po, char* lds, int wave_s, float lam, const float* __restrict__ gdiff) {
#pragma nounroll
 for (int jmap = 0; jmap < 2; ++jmap) {
  const bf16* __restrict__ Qh = Qh0 + jmap * 64; const bf16* __restrict__ Kh = Kh0 + jmap * 64;
  int tid_ = wave_s * 64 + lane_id_v(); asm volatile("" : "+v"(tid_));
  const int tid = tid_, wid = wave_s, lane = tid & 63, r32 = lane & 31, hi = lane >> 5;
  char* V_lds = lds; char* K_lds = lds + 2 * SHM_V;
  float* ws = (float*)(lds + 2 * SHM_V + 2 * SHM_K) + wid * 64; float* li_l = ws; float* al_l = ws + 32;
  float m_reg = 0.f, l_reg = 0; bf16x8 qr[4];
  float z_ = 0.f; asm volatile("" : "+v"(z_));
  f32x16 negm, o[4];
#pragma unroll
  for (int r = 0; r < 16; ++r) { negm[r] = z_; o[0][r] = z_; o[1][r] = z_; o[2][r] = z_; o[3][r] = z_; }
  asm volatile("" : "+v"(negm));
  const bf16* Qw = Qh + (long)(qb * 256 + wid * QBLK + r32) * pq + hi * 8;
#pragma unroll
  for (int d0 = 0; d0 < 4; ++d0) qr[d0] = *reinterpret_cast<const bf16x8*>(Qw + d0 * 16);
  const int sr = tid >> 4, sc = (tid & 15) * 8, vst0 = v_st(sr, sc), vst1 = v_st(32 + sr, sc);
  const int kr = tid >> 3, kc = (tid & 7) * 8, kst = KSWZ64(kr, kc * 2);
  const int vb0 = (int)(uintptr_t)V_lds + v_rd_base(lane);
  struct { bf16x8 vs0, vs1, ks0; } sr_[2];
#define SLOAD(i, k0) do { sr_[i].vs0 = *reinterpret_cast<const bf16x8*>(&Vh[(long)((k0) + sr) * pv_ + sc]); sr_[i].vs1 = *reinterpret_cast<const bf16x8*>(&Vh[(long)((k0) + 32 + sr) * pv_ + sc]); \
    sr_[i].ks0 = *reinterpret_cast<const bf16x8*>(&Kh[(long)((k0) + kr) * pk + kc]); } while (0)
#define SWRITE(b, i) do { *(bf16x8*)(V_lds + (b) * SHM_V + vst0) = sr_[i].vs0; *(bf16x8*)(V_lds + (b) * SHM_V + vst1) = sr_[i].vs1; \
    *(bf16x8*)(K_lds + (b) * SHM_K + kst) = sr_[i].ks0; } while (0)
#define SWAIT() asm volatile("s_waitcnt vmcnt(3)" ::: "memory")
#define RESC(a) do { if (__any((a) < 1.f)) { if (hi == 0) al_l[r32] = (a); asm volatile("s_waitcnt lgkmcnt(0)" ::: "memory"); \
    _Pragma("unroll") for (int d = 0; d < 4; ++d) _Pragma("unroll") for (int r = 0; r < 16; ++r) o[d][r] *= al_l[crow(r, hi)]; } } while (0)
  f32x16 pA0, pA1, pB0, pB1; float alA, alB; bf16x8 pa0, pa1, pa2, pa3; constexpr int NT = SEQ / KVBLK;
  constexpr int SE = 0, SO = 1;
  SLOAD(SE, 0); asm volatile("s_waitcnt vmcnt(0)" ::: "memory"); SWRITE(0, SE); WGBAR();
  qkt(pA0, pA1, K_lds, qr, negm, r32, hi); partialSM<true>(pA0, pA1, m_reg, negm, alA);
  SLOAD(SO, KVBLK); SLOAD(SE, 2 * KVBLK);
  SWAIT(); SWRITE(1, SO); WGBAR();
  for (int j = 1; j + 1 < NT; j += 2) {
    SBAR(); qkt(pB0, pB1, K_lds + SHM_K, qr, negm, r32, hi);
    finishSM(pA0, pA1, alA, l_reg, pa0, pa1, pa2, pa3); SBAR();
    SLOAD(SO, (j + 2) * KVBLK); SBAR();
    pv_d0(o, vb0, pa0, pa1, pa2, pa3); partialSM<false>(pB0, pB1, m_reg, negm, alB);
    WGBAR(); SWAIT(); SWRITE(0, SE);
    RESC(alB); WGBAR();
    SBAR(); qkt(pA0, pA1, K_lds, qr, negm, r32, hi);
    finishSM(pB0, pB1, alB, l_reg, pa0, pa1, pa2, pa3); SBAR();
    if (j + 3 < NT) SLOAD(SE, (j + 3) * KVBLK); SBAR();
    pv_d0(o, vb0 + (int)SHM_V, pa0, pa1, pa2, pa3); partialSM_nocheck(pA0, alA);
    WGBAR(); SWAIT(); SWRITE(1, SO);
    RESC(alA); WGBAR();
  }
  SBAR(); qkt(pB0, pB1, K_lds + SHM_K, qr, negm, r32, hi);
  finishSM(pA0, pA1, alA, l_reg, pa0, pa1, pa2, pa3); SBAR();
  pv_d0(o, vb0, pa0, pa1, pa2, pa3); partialSM<false>(pB0, pB1, m_reg, negm, alB);
  WGBAR(); RESC(alB);
  finishSM(pB0, pB1, alB, l_reg, pa0, pa1, pa2, pa3); SBAR();
  pv_d0(o, vb0 + (int)SHM_V, pa0, pa1, pa2, pa3);
  if (hi == 0) li_l[r32] = l_reg; asm volatile("s_waitcnt lgkmcnt(0)" ::: "memory");
  float rli[16];
#pragma unroll
  for (int r = 0; r < 16; ++r) rli[r] = __builtin_amdgcn_rcpf(li_l[crow(r, hi)]);
  unsigned short* stash = (unsigned short*)(lds + SHM_ATTN) + wid * 4096;
  if (jmap == 0) {
#pragma unroll
    for (int r = 0; r < 16; ++r) { const int orow = crow(r, hi);
#pragma unroll
      for (int d0 = 0; d0 < 4; ++d0) { const bf16 v = __float2bfloat16(o[d0][r] * rli[r]); stash[orow * 128 + d0 * 32 + r32] = __builtin_bit_cast(unsigned short, v); } }
  } else {
    float ssq[16];
#pragma unroll
    for (int r = 0; r < 16; ++r) { const int orow = crow(r, hi); float q = 0.f;
#pragma unroll
      for (int d0 = 0; d0 < 4; ++d0) { const float o1 = __uint_as_float((unsigned)stash[orow * 128 + d0 * 32 + r32] << 16); const float v = o1 - lam * (o[d0][r] * rli[r]); o[d0][r] = v; q += v * v; }
      ssq[r] = q; }
#pragma unroll
    for (int msk = 1; msk < 32; msk <<= 1)
#pragma unroll
      for (int r = 0; r < 16; ++r) ssq[r] += shx(ssq[r], lane, msk);
    float gd[4];
#pragma unroll
    for (int d0 = 0; d0 < 4; ++d0) gd[d0] = gdiff[d0 * 32 + r32] * 0.8f;
    bf16* Ow = Oh + (long)(qb * 256 + wid * QBLK) * po;
#pragma unroll
    for (int r = 0; r < 16; ++r) { const int orow = crow(r, hi); const float rs = __builtin_amdgcn_rsqf(ssq[r] * (1.f / 128.f) + 1e-6f);
#pragma unroll
      for (int d0 = 0; d0 < 4; ++d0) Ow[(long)orow * po + d0 * 32 + r32] = __float2bfloat16(o[d0][r] * rs * gd[d0]); }
  }
  WGBAR();
 }
#undef SLOAD
#undef SWRITE
#undef SWAIT
#undef RESC
}
#undef KSWZ64
#undef SBAR
#undef WGBAR
}
#define LAS __attribute__((address_space(3)))
#define XB_TMO      128
#define XB_XCNT(j)  (256  + 64 * (j))
#define XB_XSUB(j)  (1280 + 64 * (j))
#define XB_XGEN(j)  (2304 + 64 * (j))
#define XB_TOP      3328
#define XB_TOPGEN   3392
#define XCD_BAR_WORDS 3456
#define XB_SPIN_CAP (1u << 18)

__device__ __forceinline__ unsigned xb_ld(unsigned* p)              { return __hip_atomic_load(p, __ATOMIC_RELAXED, __HIP_MEMORY_SCOPE_AGENT); }
__device__ __forceinline__ unsigned xb_add(unsigned* p, unsigned v) { return __hip_atomic_fetch_add(p, v, __ATOMIC_RELAXED, __HIP_MEMORY_SCOPE_AGENT); }
__device__ __forceinline__ unsigned xb_xcc_id() { return (unsigned)__builtin_amdgcn_s_getreg((3 << 11) | 20) & 0xFu; }
#define XB_SPIN(cond, bar) do { unsigned _sp = 0; while (cond) { __builtin_amdgcn_s_sleep(1); \
    if ((++_sp & 255u) == 0u) { if (xb_ld(&(bar)[XB_TMO])) break; if (_sp > XB_SPIN_CAP) { atomicAdd(&(bar)[XB_TMO], 1u); break; } } } } while (0)

struct XcdBarrier {
    unsigned* bar; unsigned x;
    volatile LAS unsigned* st; bool leader;
};

__device__ __forceinline__ XcdBarrier xcd_barrier_post(unsigned* bar, volatile LAS unsigned* st, bool leader) {
    XcdBarrier b; b.bar = bar; b.x = xb_xcc_id(); b.st = st; b.leader = leader;
    if (leader) (void)xb_add(&bar[XB_XCNT(b.x)], 1u);
    return b;
}
__device__ __forceinline__ void xcd_barrier_complete(unsigned* bar, unsigned x, unsigned& nloc, unsigned& nx) {
    const unsigned G = gridDim.x * gridDim.y * gridDim.z;
    unsigned sum, cnt, mine, sp = 0u;
    for (;;) {
        sum = 0u; cnt = 0u; mine = 0u;
#pragma unroll
        for (unsigned j = 0; j < 16; ++j) { const unsigned c = xb_ld(&bar[XB_XCNT(j)]); sum += c; cnt += (c > 0u) ? 1u : 0u; mine = (j == x) ? c : mine; }
        if (sum == G) break;
        __builtin_amdgcn_s_sleep(1);
        if ((++sp & 255u) == 0u) { if (xb_ld(&bar[XB_TMO])) break; if (sp > XB_SPIN_CAP) { atomicAdd(&bar[XB_TMO], 1u); break; } }
    }
    nloc = mine > 0u ? mine : 1u; nx = cnt > 0u ? cnt : 1u;
}

__device__ __forceinline__ void xcd_barrier(const XcdBarrier& b) {
    asm volatile("s_waitcnt vmcnt(0)" ::: "memory");
    __syncthreads();
    if (b.leader) {
        unsigned* bar = b.bar;
        __builtin_amdgcn_s_waitcnt(0);
        unsigned nloc = b.st[0], nx = b.st[1];
        if (nloc == 0u) { xcd_barrier_complete(bar, b.x, nloc, nx); b.st[0] = nloc; b.st[1] = nx; }
        const unsigned old = xb_add(&bar[XB_XSUB(b.x)], 1u);
        const unsigned gen = old / nloc;
        if (old + 1u == (gen + 1u) * nloc) {
            __builtin_amdgcn_fence(__ATOMIC_RELEASE, "agent");
            asm volatile("s_waitcnt vmcnt(0)" ::: "memory");
            const unsigned og = xb_add(&bar[XB_TOP], 1u);
            const unsigned tg = og / nx;
            if (og + 1u == (tg + 1u) * nx) xb_add(&bar[XB_TOPGEN], 1u);
            else XB_SPIN(xb_ld(&bar[XB_TOPGEN]) == tg, bar);
            __builtin_amdgcn_fence(__ATOMIC_ACQUIRE, "agent");
            xb_add(&bar[XB_XGEN(b.x)], 1u);
            asm volatile("s_waitcnt vmcnt(0)" ::: "memory");
        } else {
            XB_SPIN(xb_ld(&bar[XB_XGEN(b.x)]) == gen, bar);
            __builtin_amdgcn_fence(__ATOMIC_ACQUIRE, "agent");
            asm volatile("s_waitcnt vmcnt(0)" ::: "memory");
        }
    }
    __syncthreads();
}
#undef LAS
namespace cg = cooperative_groups;
#ifndef PG8_ALIGN1
#define PG8_ALIGN1 PG8_ALIGN
#endif
#ifndef PROBE_REP64
#define PROBE_REP64 1
#endif
#ifndef PROBE_REP128
#define PROBE_REP128 1
#endif
#ifndef NCHUNK_DEF
#define NCHUNK_DEF 3
#endif
constexpr int NWAVES = 8;
constexpr int SEQ = 8192, DM = 1024, MC = 16384  , NCHUNK = NCHUNK_DEF, NPROJ = 6656, DFF = 2816, NUP = 2 * DFF, PLE = 256;
constexpr int C_AQ = 0, C_AK = 1024, C_AV = 2048, C_BQ = 3072, C_BK = 4096, C_BV = 4352, C_GA = 4608, C_GB = 5632;
constexpr float EPS = 1e-6f;
constexpr float QSCALE = 0.125f * 1.4426950408889634f;
constexpr size_t MiB = 1u << 20;
constexpr size_t WS_SS = 420 * MiB;
constexpr size_t WS_TABA = 1 * MiB;
constexpr size_t WS_TABX = 1 * MiB + 512 * 1024;
constexpr size_t WS_WIN = 2 * MiB, WS_WA = 15 * MiB, WS_WB = 17 * MiB, WS_WOUT = 19 * MiB, WS_WUP = 21 * MiB, WS_WDN = 32 * MiB, WS_WPLE = 38 * MiB, WS_WPG = 39 * MiB;
constexpr size_t WS_XN = 42 * MiB;
constexpr size_t WS_PB = 74 * MiB;
constexpr size_t WS_PROJ = 82 * MiB;
constexpr size_t WS_U = WS_PROJ;
constexpr size_t WS_SG = WS_PROJ;
constexpr size_t WS_OA1 = 290 * MiB, WS_OA2 = 322 * MiB, WS_OB = 354 * MiB, WS_MG = WS_OA1  , WS_HS = 386 * MiB  ;
constexpr size_t WS_ACT = WS_OA1;
constexpr size_t WS_E = 424 * MiB;
constexpr size_t WS_XNB = 456 * MiB;
constexpr size_t WS_END = 488 * MiB;
constexpr int LDS_BYTES = 147456, MISC_OFF = 131072 + 320;
constexpr size_t WS_EPS = 1 * MiB + 800 * 1024;
constexpr size_t WS_BAR = 1 * MiB + 768 * 1024;

#define GAS __attribute__((address_space(1)))
#define LAS __attribute__((address_space(3)))
typedef unsigned short bf16_t;
typedef unsigned v4u __attribute__((ext_vector_type(4)));
typedef unsigned v2u __attribute__((ext_vector_type(2)));
typedef float f32x4 __attribute__((ext_vector_type(4)));
#define LDS_WAIT() asm volatile("s_waitcnt lgkmcnt(0)" ::: "memory")
__device__ __forceinline__ unsigned f2bf(float f) { unsigned u = __builtin_bit_cast(unsigned, f); return (u + 0x7fffu + ((u >> 16) & 1u)) >> 16; }
__device__ __forceinline__ unsigned pk2(float lo, float hi) { return f2bf(lo) | (f2bf(hi) << 16); }
__device__ __forceinline__ float wave_sum(float v, int lane) {
#pragma unroll
    for (int o = 1; o < 64; o <<= 1) v += shx(v, lane, o);
    return v;
}
__device__ __forceinline__ void unpack16(const v4u a, const v4u b, float (&x)[16]) {
    x[0] = pg8::bf_lo(a.x); x[1] = pg8::bf_hi(a.x); x[2] = pg8::bf_lo(a.y); x[3] = pg8::bf_hi(a.y); x[4] = pg8::bf_lo(a.z); x[5] = pg8::bf_hi(a.z); x[6] = pg8::bf_lo(a.w); x[7] = pg8::bf_hi(a.w);
    x[8] = pg8::bf_lo(b.x); x[9] = pg8::bf_hi(b.x); x[10] = pg8::bf_lo(b.y); x[11] = pg8::bf_hi(b.y); x[12] = pg8::bf_lo(b.z); x[13] = pg8::bf_hi(b.z); x[14] = pg8::bf_lo(b.w); x[15] = pg8::bf_hi(b.w);
}
__device__ __forceinline__ void pack16(const float (&x)[16], v4u& a, v4u& b) {
    a.x = pk2(x[0], x[1]); a.y = pk2(x[2], x[3]); a.z = pk2(x[4], x[5]); a.w = pk2(x[6], x[7]);
    b.x = pk2(x[8], x[9]); b.y = pk2(x[10], x[11]); b.z = pk2(x[12], x[13]); b.w = pk2(x[14], x[15]);
}

__device__ __forceinline__ void p0_transpose_item(const float* W, int K, int N, bf16_t* WT, LAS float* scr, int item, int lane, const float* kg = nullptr) {
    const int nblk = N / 32, kb = item / nblk, nb = item % nblk, k0 = 64 * kb, n0 = 32 * nb;
#pragma unroll 8
    for (int i = 0; i < 32; ++i) { const int kk = 2 * i + (lane >> 5); scr[kk * 33 + (lane & 31)] = W[(size_t)(k0 + kk) * N + n0 + (lane & 31)] * (kg ? kg[k0 + kk] : 1.0f); }
    LDS_WAIT(); asm volatile("" ::: "memory");
    const int c = lane & 7;
#pragma unroll
    for (int j = 0; j < 4; ++j) { const int n = (lane >> 3) + 8 * j; const LAS float* s = scr + (8 * c) * 33 + n;
        v4u o; o.x = pk2(s[0 * 33], s[1 * 33]); o.y = pk2(s[2 * 33], s[3 * 33]); o.z = pk2(s[4 * 33], s[5 * 33]); o.w = pk2(s[6 * 33], s[7 * 33]);
        *(GAS v4u*)(WT + (size_t)(n0 + n) * K + k0 + 8 * c) = o; }
    LDS_WAIT(); asm volatile("" ::: "memory");
}

struct Ctx {
    int vcu, G, wave_s;
};
__device__ __forceinline__ unsigned long long karg(int i) { const __attribute__((address_space(4))) unsigned long long* ka = (const __attribute__((address_space(4))) unsigned long long*)__builtin_amdgcn_kernarg_segment_ptr(); asm volatile("" : "+s"(ka)); return ka[i]; }
#define KIN(i) ((const float*)karg(i))
#define KOUT() ((float*)karg(25))
#define KWS() ((unsigned char*)karg(26))

__device__ __forceinline__ void phase_prologue(const Ctx& F, LAS unsigned char* lds) {
    int tid_ = F.wave_s * 64 + lane_id_v(); asm volatile("" : "+v"(tid_)); const int tid = tid_, lane = tid & 63, wave = F.wave_s, gw = F.vcu * NWAVES + wave, NGW = F.G * NWAVES; (void)lane; (void)gw; (void)NGW;
    unsigned char* const ws = KWS(); (void)ws;
    const int gt = F.vcu * (NWAVES * 64) + tid, NGT = F.G * NWAVES * 64;
    {
        float* tab = (float*)(ws + WS_TABA);
        for (int i = gt; i < SEQ * 8; i += NGT) { const int pos = i >> 3, k = i & 7;
            const float inv = k == 0 ? 1.0f : k == 1 ? 0.19392274474868576f : k == 2 ? 0.03760603093086393f : k == 3 ? 0.007292664737217109f : k == 4 ? 0.001414213562373095f : k == 5 ? 0.0002742481756762073f : k == 6 ? 5.318295896944988e-05f : 1.031338537721246e-05f;
            const float ang = (float)pos * inv; double rev = (double)ang * 0.15915494309189535; rev -= __builtin_floor(rev); const float r = (float)rev;
            tab[pos * 16 + k] = __builtin_amdgcn_cosf(r); tab[pos * 16 + 8 + k] = __builtin_amdgcn_sinf(r); }
    }
    {
        float* tab = (float*)(ws + WS_TABX);
        for (int i = gt; i < 128 * 16; i += NGT) { const int pos = i >> 4, k = i & 15;
            const float inv = __builtin_amdgcn_exp2f(-(float)k * (13.287712379549449f / 16.0f));
            const float ang = (float)pos * inv; double rev = (double)ang * 0.15915494309189535; rev -= __builtin_floor(rev); const float r = (float)rev;
            tab[pos * 32 + k] = __builtin_amdgcn_cosf(r); tab[pos * 32 + 16 + k] = __builtin_amdgcn_sinf(r); }
    }
    LAS float* scr = (LAS float*)(lds + wave * 16384);
    constexpr int I_IN = (DM / 64) * (NPROJ / 32), I_SQ = (DM / 64) * (DM / 32), I_UP = (DM / 64) * (NUP / 32), I_DN = (DFF / 64) * (DM / 32), I_PLE = (PLE / 64) * (DM / 32);
    constexpr int NITEMS = I_IN + 4 * I_SQ + I_UP + I_DN + I_PLE;
    for (int it = gw; it < NITEMS; it += NGW) {
        int r = it;
        if (r < I_IN) { p0_transpose_item(KIN(5), DM, NPROJ, (bf16_t*)(ws + WS_WIN), scr, r, lane); continue; } r -= I_IN;
        if (r < I_SQ) { p0_transpose_item(KIN(11), DM, DM, (bf16_t*)(ws + WS_WA), scr, r, lane); continue; } r -= I_SQ;
        if (r < I_SQ) { p0_transpose_item(KIN(14), DM, DM, (bf16_t*)(ws + WS_WB), scr, r, lane); continue; } r -= I_SQ;
        if (r < I_SQ) { p0_transpose_item(KIN(15), DM, DM, (bf16_t*)(ws + WS_WOUT), scr, r, lane); continue; } r -= I_SQ;
        if (r < I_SQ) { p0_transpose_item(KIN(23), DM, DM, (bf16_t*)(ws + WS_WPG), scr, r, lane, KIN(22)); continue; } r -= I_SQ;
        if (r < I_UP) { p0_transpose_item(KIN(17), DM, NUP, (bf16_t*)(ws + WS_WUP), scr, r, lane, KIN(16)); continue; } r -= I_UP;
        if (r < I_DN) { p0_transpose_item(KIN(20), DFF, DM, (bf16_t*)(ws + WS_WDN), scr, r, lane); continue; } r -= I_DN;
        p0_transpose_item(KIN(21), PLE, DM, (bf16_t*)(ws + WS_WPLE), scr, r, lane);
    }
}

__device__ __forceinline__ void phase_prep(const Ctx& F, const float* x, const float* p) {
    int tid_ = F.wave_s * 64 + lane_id_v(); asm volatile("" : "+v"(tid_)); const int tid = tid_, lane = tid & 63, wave = F.wave_s, gw = F.vcu * NWAVES + wave, NGW = F.G * NWAVES; (void)lane; (void)gw; (void)NGW;
    unsigned char* const ws = KWS(); (void)ws;
    const float* g = KIN(4);
    bf16_t* XN = (bf16_t*)(ws + WS_XN); bf16_t* PB = (bf16_t*)(ws + WS_PB);
    f32x4 gv[4];
#pragma unroll
    for (int j = 0; j < 4; ++j) gv[j] = ((const f32x4*)g)[lane + 64 * j];
    for (int m0 = gw * 4; m0 < MC; m0 += NGW * 4) {
        f32x4 v[4][4], pv[4];
#pragma unroll
        for (int r = 0; r < 4; ++r) { const f32x4* xr = (const f32x4*)(x + (size_t)(m0 + r) * DM) + lane;
#pragma unroll
            for (int j = 0; j < 4; ++j) v[r][j] = xr[64 * j];
            pv[r] = ((const f32x4*)(p + (size_t)(m0 + r) * PLE))[lane]; }
#pragma unroll
        for (int r = 0; r < 4; ++r) { float s = 0.f;
#pragma unroll
            for (int j = 0; j < 4; ++j) s += (v[r][j].x * v[r][j].x + v[r][j].y * v[r][j].y) + (v[r][j].z * v[r][j].z + v[r][j].w * v[r][j].w);
            const float rstd = __builtin_amdgcn_rsqf(wave_sum(s, lane) * (1.f / DM) + EPS);
            v2u* o8 = (v2u*)(XN + (size_t)(m0 + r) * DM) + lane;
#pragma unroll
            for (int j = 0; j < 4; ++j) { const f32x4 y = v[r][j] * rstd * gv[j]; v2u w; w.x = pk2(y.x, y.y); w.y = pk2(y.z, y.w); o8[64 * j] = w; }
            { v2u w; w.x = pk2(pv[r].x, pv[r].y); w.y = pk2(pv[r].z, pv[r].w); ((v2u*)(PB + (size_t)(m0 + r) * PLE))[lane] = w; } }
    }
}

__device__ __forceinline__ void phase_rope(const Ctx& F) {
    int tid_ = F.wave_s * 64 + lane_id_v(); asm volatile("" : "+v"(tid_)); const int tid = tid_, lane = tid & 63, wave = F.wave_s, gw = F.vcu * NWAVES + wave, NGW = F.G * NWAVES; (void)lane; (void)gw; (void)NGW;
    unsigned char* const ws = KWS(); (void)ws;
    bf16_t* PROJ = (bf16_t*)(ws + WS_PROJ);
    const float* tabA = (const float*)(ws + WS_TABA); const float* tabX = (const float*)(ws + WS_TABX);
    const int q4 = lane & 3;
    float gq[16], gk[16];
#pragma unroll
    for (int k = 0; k < 16; ++k) { gq[k] = KIN(12)[q4 * 16 + k]; gk[k] = KIN(13)[q4 * 16 + k]; }
    const float sgn = (q4 & 1) ? 1.f : -1.f;
    for (int m = gw; m < MC; m += NGW) {
        const int t = m & (SEQ - 1);
        bf16_t* row = PROJ + (size_t)m * NPROJ;
        v4u* paq = (v4u*)(row + C_AQ + (lane & ~3) * 16); v4u* pak = (v4u*)(row + C_AK + (lane & ~3) * 16); v4u* pbq = (v4u*)(row + C_BQ + lane * 16); v4u* pbk = (v4u*)(row + C_BK + (lane & 15) * 16);
        v4u aq0 = paq[0], aq1 = paq[1], ak0 = pak[0], ak1 = pak[1], bq0 = pbq[0], bq1 = pbq[1], bk0 = pbk[0], bk1 = pbk[1];
        float c8[8], s8[8], cx[16], sx[16];
        { const f32x4* tp = (const f32x4*)(tabA + t * 16); const f32x4 a = tp[0], b = tp[1], c = tp[2], d = tp[3];
          c8[0] = a.x; c8[1] = a.y; c8[2] = a.z; c8[3] = a.w; c8[4] = b.x; c8[5] = b.y; c8[6] = b.z; c8[7] = b.w;
          s8[0] = c.x; s8[1] = c.y; s8[2] = c.z; s8[3] = c.w; s8[4] = d.x; s8[5] = d.y; s8[6] = d.z; s8[7] = d.w; }
        { const int pos = (q4 < 2) ? (t >> 6) : (t & 63); const f32x4* tp = (const f32x4*)(tabX + pos * 32);
#pragma unroll
          for (int j = 0; j < 4; ++j) { const f32x4 a = tp[j], b = tp[4 + j]; cx[4 * j] = a.x; cx[4 * j + 1] = a.y; cx[4 * j + 2] = a.z; cx[4 * j + 3] = a.w; sx[4 * j] = b.x; sx[4 * j + 1] = b.y; sx[4 * j + 2] = b.z; sx[4 * j + 3] = b.w; } }
        asm volatile("" ::: "memory");
        if (q4 == 0) {
            float x[16]; unpack16(aq0, aq1, x);
#pragma unroll
            for (int i = 0; i < 8; ++i) { const float x1 = x[i], x2 = x[8 + i]; x[i] = x1 * c8[i] - x2 * s8[i]; x[8 + i] = x2 * c8[i] + x1 * s8[i]; }
            pack16(x, aq0, aq1); paq[0] = aq0; paq[1] = aq1;
        }
        {
            float x[16]; unpack16(ak0, ak1, x);
#pragma unroll
            for (int i = 0; i < 8; ++i) { const float x1 = x[i], x2 = x[8 + i]; x[i] = x1 * c8[i] - x2 * s8[i]; x[8 + i] = x2 * c8[i] + x1 * s8[i]; }
            if (q4 == 0) { pack16(x, ak0, ak1); pak[0] = ak0; pak[1] = ak1; }
        }
        {
            float x[16]; unpack16(bq0, bq1, x);
            float sq = 0.f;
#pragma unroll
            for (int i = 0; i < 16; ++i) sq += x[i] * x[i];
            sq += shx(sq, lane, 1); sq += shx(sq, lane, 2);
            const float r = __builtin_amdgcn_rsqf(sq * (1.f / 64.f) + EPS);
#pragma unroll
            for (int i = 0; i < 16; ++i) x[i] = x[i] * r * gq[i];
#pragma unroll
            for (int i = 0; i < 16; ++i) { const float o = shx(x[i], lane, 1); x[i] = (x[i] * cx[i] + sgn * o * sx[i]) * QSCALE; }
            pack16(x, bq0, bq1); pbq[0] = bq0; pbq[1] = bq1;
        }
        {
            float x[16]; unpack16(bk0, bk1, x);
            float sq = 0.f;
#pragma unroll
            for (int i = 0; i < 16; ++i) sq += x[i] * x[i];
            sq += shx(sq, lane, 1); sq += shx(sq, lane, 2);
            const float r = __builtin_amdgcn_rsqf(sq * (1.f / 64.f) + EPS);
#pragma unroll
            for (int i = 0; i < 16; ++i) x[i] = x[i] * r * gk[i];
#pragma unroll
            for (int i = 0; i < 16; ++i) { const float o = shx(x[i], lane, 1); x[i] = x[i] * cx[i] + sgn * o * sx[i]; }
            if (lane < 16) { pack16(x, bk0, bk1); pbk[0] = bk0; pbk[1] = bk1; }
        }
    }
}

__device__ __forceinline__ void phase_attn(const Ctx& F, char* lds) {
    using abf = attn_body::bf16;
    unsigned char* const ws = KWS();
    abf* PROJ = (abf*)(ws + WS_PROJ); abf* OA1 = (abf*)(ws + WS_OA1); abf* OB = (abf*)(ws + WS_OB);
    float lam;
    { const int lane = lane_id_v(); const float s1 = wave_sum(KIN(6)[lane] * KIN(7)[lane], lane), s2 = wave_sum(KIN(8)[lane] * KIN(9)[lane], lane); lam = __expf(s1) - __expf(s2) + 0.2f; }
    const float* gdiff = KIN(10);
    if (F.wave_s >= 4) __builtin_amdgcn_s_setprio(1);
    for (int i = 0;; ++i) {
        const int L = i * F.G + F.vcu; if (L >= 1536) break;
        if (L < 1024) { for (int rep = 0; rep < PROBE_REP64; ++rep) { const int i4 = (L >> 8) & 3, v = L & 255, g = v >> 3, s = v & 7, qb = i4 * 8 + s;
            const int qd = g >> 2, mem = g & 3, b = qd >> 2, kvh = qd & 3, qh = kvh * 4 + mem; const size_t r0 = (size_t)b * SEQ;
            attn_body::attn_unit<8>(qb, PROJ + r0 * NPROJ + C_BQ + qh * 64, PROJ + r0 * NPROJ + C_BK + kvh * 64, PROJ + r0 * NPROJ + C_BV + kvh * 64, OB + r0 * DM + qh * 64, NPROJ, NPROJ, NPROJ, DM, lds, F.wave_s); }
        } else { for (int rep = 0; rep < PROBE_REP128; ++rep) { const int idx = L - 1024, i4 = idx >> 8, v = idx & 255, g = v >> 3, s = v & 7;
            const int bh = g >> 1, qb = (g & 1) * 16 + i4 * 8 + s, b = bh >> 3, h = bh & 7; const size_t r0 = (size_t)b * SEQ;
            attn128::attn128_unit(qb, PROJ + r0 * NPROJ + C_AQ + h * 128, PROJ + r0 * NPROJ + C_AK + h * 128, PROJ + r0 * NPROJ + C_AV + h * 128, OA1 + r0 * DM + h * 128, NPROJ, NPROJ, NPROJ, DM, lds, F.wave_s, lam, gdiff); } }
    }
    __builtin_amdgcn_s_setprio(0);
}

__device__ __forceinline__ void phase_diffnorm(const Ctx& F) {
    int tid_ = F.wave_s * 64 + lane_id_v(); asm volatile("" : "+v"(tid_)); const int tid = tid_, lane = tid & 63, wave = F.wave_s, gw = F.vcu * NWAVES + wave, NGW = F.G * NWAVES; (void)lane; (void)gw; (void)NGW;
    unsigned char* const ws = KWS(); (void)ws;
    bf16_t* OA1 = (bf16_t*)(ws + WS_OA1); const bf16_t* OA2 = (const bf16_t*)(ws + WS_OA2);
    const float s1 = wave_sum(KIN(6)[lane] * KIN(7)[lane], lane), s2 = wave_sum(KIN(8)[lane] * KIN(9)[lane], lane);
    const float lam = __expf(s1) - __expf(s2) + 0.2f;
    float gd[16];
#pragma unroll
    for (int k = 0; k < 16; ++k) gd[k] = KIN(10)[(lane & 7) * 16 + k] * 0.8f;
    for (int m0 = gw * 4; m0 < MC; m0 += NGW * 4) {
        v4u a[4], b[4], c[4], d[4];
#pragma unroll
        for (int r = 0; r < 4; ++r) { const v4u* pp = (const v4u*)(OA1 + (size_t)(m0 + r) * DM + lane * 16); const v4u* p2 = (const v4u*)(OA2 + (size_t)(m0 + r) * DM + lane * 16); a[r] = pp[0]; b[r] = pp[1]; c[r] = p2[0]; d[r] = p2[1]; }
        asm volatile("" ::: "memory");
#pragma unroll
        for (int r = 0; r < 4; ++r) {
            float x[16], y[16]; unpack16(a[r], b[r], x); unpack16(c[r], d[r], y);
            float s = 0.f;
#pragma unroll
            for (int i = 0; i < 16; ++i) { x[i] = x[i] - lam * y[i]; s += x[i] * x[i]; }
            s += shx(s, lane, 1); s += shx(s, lane, 2); s += shx(s, lane, 4);
            const float rr = __builtin_amdgcn_rsqf(s * (1.f / 128.f) + EPS);
#pragma unroll
            for (int i = 0; i < 16; ++i) x[i] = x[i] * rr * gd[i];
            v4u oa, ob; pack16(x, oa, ob); v4u* pp = (v4u*)(OA1 + (size_t)(m0 + r) * DM + lane * 16); pp[0] = oa; pp[1] = ob;
        }
    }
}

__device__ __forceinline__ float gelu_tanh(float x) { const float u = x + 0.044715f * x * x * x; return x * __builtin_amdgcn_rcpf(1.0f + __builtin_amdgcn_exp2f(-2.302208198f * u)); }
__device__ __forceinline__ void up8(const v4u a, float (&x)[8]) { x[0] = pg8::bf_lo(a.x); x[1] = pg8::bf_hi(a.x); x[2] = pg8::bf_lo(a.y); x[3] = pg8::bf_hi(a.y); x[4] = pg8::bf_lo(a.z); x[5] = pg8::bf_hi(a.z); x[6] = pg8::bf_lo(a.w); x[7] = pg8::bf_hi(a.w); }
__device__ __forceinline__ void phase_conv(const Ctx& F) {
    int tid_ = F.wave_s * 64 + lane_id_v(); asm volatile("" : "+v"(tid_)); const int tid = tid_, lane = tid & 63, wave = F.wave_s, gw = F.vcu * NWAVES + wave, NGW = F.G * NWAVES; (void)lane; (void)gw; (void)NGW;
    unsigned char* const ws = KWS(); (void)ws;
    const bf16_t* U = (const bf16_t*)(ws + WS_U); bf16_t* ACT = (bf16_t*)(ws + WS_ACT);
    const float* cw = KIN(18); const float* cb = KIN(19);
    constexpr int NCG = DFF / 8, RUN = 8, NRUN = MC / RUN;
    if (tid < NCG) {
        const int ch0 = tid * 8;
        float wg[3][8], wv[3][8], bg[8], bv[8];
#pragma unroll
        for (int k = 0; k < 3; ++k) { const f32x4 a = *(const f32x4*)(cw + k * NUP + ch0), b = *(const f32x4*)(cw + k * NUP + ch0 + 4), c = *(const f32x4*)(cw + k * NUP + DFF + ch0), d = *(const f32x4*)(cw + k * NUP + DFF + ch0 + 4);
            wg[k][0] = a.x; wg[k][1] = a.y; wg[k][2] = a.z; wg[k][3] = a.w; wg[k][4] = b.x; wg[k][5] = b.y; wg[k][6] = b.z; wg[k][7] = b.w;
            wv[k][0] = c.x; wv[k][1] = c.y; wv[k][2] = c.z; wv[k][3] = c.w; wv[k][4] = d.x; wv[k][5] = d.y; wv[k][6] = d.z; wv[k][7] = d.w; }
        { const f32x4 a = *(const f32x4*)(cb + ch0), b = *(const f32x4*)(cb + ch0 + 4), c = *(const f32x4*)(cb + DFF + ch0), d = *(const f32x4*)(cb + DFF + ch0 + 4);
          bg[0] = a.x; bg[1] = a.y; bg[2] = a.z; bg[3] = a.w; bg[4] = b.x; bg[5] = b.y; bg[6] = b.z; bg[7] = b.w; bv[0] = c.x; bv[1] = c.y; bv[2] = c.z; bv[3] = c.w; bv[4] = d.x; bv[5] = d.y; bv[6] = d.z; bv[7] = d.w; }
        for (int run = F.vcu; run < NRUN; run += F.G) {
            const int t0 = run * RUN; const bool first = (t0 & (SEQ - 1)) == 0, last = ((t0 + RUN) & (SEQ - 1)) == 0;
            const bf16_t* up = U + (size_t)t0 * NUP + ch0;
            v4u rg[RUN + 2], rv[RUN + 2];
#pragma unroll
            for (int i = 0; i < RUN + 2; ++i) { const bool z = (i == 0 && first) || (i == RUN + 1 && last);
                if (z) { rg[i] = (v4u){0u, 0u, 0u, 0u}; rv[i] = rg[i]; } else { rg[i] = *(const v4u*)(up + (long)(i - 1) * NUP); rv[i] = *(const v4u*)(up + (long)(i - 1) * NUP + DFF); } }
            asm volatile("" ::: "memory");
#pragma unroll
            for (int i = 0; i < RUN; ++i) {
                float pg_[8], cg_[8], ng_[8], pv_[8], cv_[8], nv_[8], o[8];
                up8(rg[i], pg_); up8(rg[i + 1], cg_); up8(rg[i + 2], ng_); up8(rv[i], pv_); up8(rv[i + 1], cv_); up8(rv[i + 2], nv_);
#pragma unroll
                for (int k = 0; k < 8; ++k) { const float ug = pg_[k] * wg[0][k] + cg_[k] * wg[1][k] + ng_[k] * wg[2][k] + bg[k]; const float uv = pv_[k] * wv[0][k] + cv_[k] * wv[1][k] + nv_[k] * wv[2][k] + bv[k]; o[k] = gelu_tanh(ug) * uv; }
                v4u w; w.x = pk2(o[0], o[1]); w.y = pk2(o[2], o[3]); w.z = pk2(o[4], o[5]); w.w = pk2(o[6], o[7]);
                *(v4u*)(ACT + (size_t)(t0 + i) * DFF + ch0) = w;
            }
        }
    }
}

__device__ __forceinline__ void phase_final(const Ctx& F, float* out, const float* ss3, const float oscale) {
    int tid_ = F.wave_s * 64 + lane_id_v(); asm volatile("" : "+v"(tid_)); const int tid = tid_, lane = tid & 63, wave = F.wave_s, gw = F.vcu * NWAVES + wave, NGW = F.G * NWAVES; (void)lane; (void)gw; (void)NGW;
    unsigned char* const ws = KWS(); (void)ws;
    const float* g = KIN(24); const bf16_t* hs = (const bf16_t*)(ws + WS_XNB);
    f32x4 gv[4];
#pragma unroll
    for (int j = 0; j < 4; ++j) gv[j] = ((const f32x4*)g)[lane + 64 * j];
    for (int m0 = gw * 4; m0 < MC; m0 += NGW * 4) {
        v2u v[4][4]; float rs[4];
#pragma unroll
        for (int r = 0; r < 4; ++r) { const v2u* xr = (const v2u*)(hs + (size_t)(m0 + r) * DM) + lane; { const f32x4* sp = (const f32x4*)(ss3 + (size_t)(m0 + r) * 16); const f32x4 sa = (sp[0] + sp[1]) + (sp[2] + sp[3]); rs[r] = (sa[0] + sa[1]) + (sa[2] + sa[3]); }
#pragma unroll
            for (int j = 0; j < 4; ++j) v[r][j] = xr[64 * j]; }
        asm volatile("" ::: "memory");
#pragma unroll
        for (int r = 0; r < 4; ++r) { f32x4* xr = (f32x4*)(out + (size_t)(m0 + r) * DM) + lane; const float rr = __builtin_amdgcn_rsqf(rs[r] * (1.f / DM) + EPS) * oscale;
#pragma unroll
            for (int j = 0; j < 4; ++j) { const f32x4 h = (f32x4){pg8::bf_lo(v[r][j].x), pg8::bf_hi(v[r][j].x), pg8::bf_lo(v[r][j].y), pg8::bf_hi(v[r][j].y)}; xr[64 * j] = h * rr * gv[j]; } }
    }
}

struct Args { const float* in[25]; float* out; unsigned char* ws; };

#ifndef PROBE_GB
#define PROBE_GB 1
#endif
#ifndef PROBE_GF
#define PROBE_GF 1
#endif
#ifndef PROBE_GG
#define PROBE_GG 1
#endif
#ifndef PROBE_GI
#define PROBE_GI 1
#endif
#ifndef PROBE_GL
#define PROBE_GL 1
#endif
#ifndef PROBE_CONV
#define PROBE_CONV 1
#endif
#ifndef PROBE_PRO
#define PROBE_PRO 1
#endif
#ifndef PROBE_PREP
#define PROBE_PREP 1
#endif
#ifndef PROBE_TS
#define PROBE_TS 0
#endif
#ifndef PROBE_TSCALE
#define PROBE_TSCALE 2000
#endif
#if PROBE_TS
#define TS_PTR() ((volatile LAS unsigned long long*)((LAS unsigned char*)lds + MISC_OFF + 64))
#define STAMP(k) do { if (gbar.leader && blockIdx.x == 0) { volatile LAS unsigned long long* T_ = TS_PTR(); const unsigned long long t_ = __builtin_amdgcn_s_memrealtime(); if ((k) >= 0 && ((PROBE_TS >> (k)) & 1)) T_[1] += t_ - T_[0]; T_[0] = t_; } } while (0)
#define TS_PUBLISH() do { if (gbar.leader && blockIdx.x == 0) { const float us_ = (float)TS_PTR()[1] * 0.01f; const float b_ = __builtin_rintf(__builtin_log2f(us_ < 1.f ? 1.f : us_) * 2.6419f); *(volatile float*)(KWS() + WS_EPS) = b_ * (1.0f / 64.0f); } } while (0)
#else
#define STAMP(k) do {} while (0)
#define TS_PUBLISH() do {} while (0)
#endif
#ifndef PROBE_ATTNPH
#define PROBE_ATTNPH 1
#endif
#ifndef PROBE_GK
#define PROBE_GK 1
#endif
#ifndef PROBE_GH
#define PROBE_GH 1
#endif
#ifndef PROBE_BARX
#define PROBE_BARX 1
#endif
#define GBAR() do { for (int rep_ = 0; rep_ < PROBE_BARX; ++rep_) xcd_barrier(gbar); } while (0)
template <int c> __device__ __forceinline__ void run_chunk(const Ctx& F, unsigned char* lds, const XcdBarrier& gbar) {
    LAS unsigned char* L = (LAS unsigned char*)lds;
    const int bid = (int)blockIdx.x;
#define WSP(T, off) ((T*)(ws + (off)))
#define XC() ((c == 0) ? KIN(0) : KIN(1) + (size_t)(c - 1) * MC * DM)
#define OUTC() (KOUT() + (size_t)c * MC * DM)
#define SSP(k) ((float*)(ws + WS_SS) + (size_t)(k) * MC * 16)
#ifndef SKIP_GB
        for (int rep_ = 0; rep_ < PROBE_GB; ++rep_) {
            unsigned char* const ws = KWS(); pg8::Gemm g{WSP(bf16_t, WS_XN), (const bf16_t*)(ws + WS_WIN), MC, NPROJ, DM}; pg8::StaticOrder S; S.init(MC, NPROJ, F.G, bid);
            pg8::EpiProj E{WSP(bf16_t, WS_PROJ), NPROJ, C_GA / 256, C_AK / 256, QSCALE};
            pg8::gemm_phase<pg8::EpiProj, pg8::StaticOrder, PG8_ALIGN, PG8_SP2>(L, g, S, E, F.wave_s);
        }
#endif
        {
            const int extra = ((MC / 256) * (NPROJ / 256)) % F.G, gE = extra ? F.G - extra : F.G, cE = extra ? bid - extra : bid;
            if (cE >= 0) {
            unsigned char* const ws = KWS(); pg8::Gemm g{WSP(bf16_t, WS_PB), (const bf16_t*)(ws + WS_WPLE), MC, DM, PLE}; pg8::StaticOrder S; S.init(MC, DM, gE, cE);
            pg8::EpiProj E{WSP(bf16_t, WS_E), DM, 1 << 20, 0, 1.0f};
            pg8::gemm_phase<pg8::EpiProj, pg8::StaticOrder, PG8_ALIGN, PG8_SP2>(L, g, S, E, F.wave_s);
            }
        }
#ifndef SKIP_EW
        if (c > 0) { unsigned char* const ws = KWS(); phase_final(F, KOUT() + (size_t)(c - 1) * MC * DM, SSP(2), 1.0f); }
#endif
        GBAR(); STAMP(1);
#ifndef SKIP_EW
        phase_rope(F);
        if (c + 1 < NCHUNK) { for (int rep_ = 0; rep_ < PROBE_PREP; ++rep_) phase_prep(F, KIN(1) + (size_t)c * MC * DM, KIN(3) + (size_t)c * MC * PLE); }
#endif
        GBAR(); STAMP(2);
#ifndef SKIP_ATTN
        for (int rep_ = 1; rep_ < PROBE_ATTNPH; ++rep_) { phase_attn(F, (char*)lds); xcd_barrier(gbar); }
        phase_attn(F, (char*)lds);
#endif
        GBAR(); STAMP(3);
#ifndef SKIP_GF
        for (int rep_ = 0; rep_ < PROBE_GF; ++rep_) {
            unsigned char* const ws = KWS(); pg8::Gemm g{WSP(bf16_t, WS_OA1), (const bf16_t*)(ws + WS_WA), MC, DM, DM}; pg8::StaticOrder S; S.init(MC, DM, F.G, bid);
            pg8::EpiT1 E{WSP(bf16_t, WS_PROJ) + C_GA, NPROJ, WSP(bf16_t, WS_OA2), DM};
            pg8::gemm_phase<pg8::EpiT1, pg8::StaticOrder, PG8_ALIGN1, PG8_SP2>(L, g, S, E, F.wave_s);
        }
#endif
        GBAR(); STAMP(5);
#ifndef SKIP_GG
        for (int rep_ = 0; rep_ < PROBE_GG; ++rep_) {
            unsigned char* const ws = KWS(); pg8::Gemm g{WSP(bf16_t, WS_OB), (const bf16_t*)(ws + WS_WB), MC, DM, DM}; pg8::StaticOrder S; S.init(MC, DM, F.G, bid);
            pg8::EpiMerge E{WSP(bf16_t, WS_PROJ) + C_GB, NPROJ, WSP(bf16_t, WS_OA2), DM, WSP(bf16_t, WS_MG), DM};
            pg8::gemm_phase<pg8::EpiMerge, pg8::StaticOrder, PG8_ALIGN1, PG8_SP2>(L, g, S, E, F.wave_s);
        }
#endif
        GBAR(); STAMP(6);
#ifndef SKIP_GH
        for (int rep_ = 0; rep_ < PROBE_GH; ++rep_) {
            unsigned char* const ws = KWS(); pg8::Gemm g{WSP(bf16_t, WS_MG), (const bf16_t*)(ws + WS_WOUT), MC, DM, DM}; pg8::StaticOrder S; S.init(MC, DM, F.G, bid);
            pg8::EpiResidB<false> E{XC(), WSP(bf16_t, WS_HS), SSP(0), DM};
            pg8::gemm_phase<pg8::EpiResidB<false>, pg8::StaticOrder, PG8_ALIGN1, PG8_SP2>(L, g, S, E, F.wave_s);
        }
#endif
        GBAR(); STAMP(7);
#ifndef SKIP_GI
        for (int rep_ = 0; rep_ < PROBE_GI; ++rep_) {
            unsigned char* const ws = KWS(); pg8::Gemm g{WSP(bf16_t, WS_HS), (const bf16_t*)(ws + WS_WUP), MC, NUP, DM}; pg8::StaticOrder S; S.init(MC, NUP, F.G, bid);
            pg8::EpiScale<false> E{SSP(0), 1.f / DM, EPS, WSP(bf16_t, WS_U), nullptr, NUP};
            pg8::gemm_phase<pg8::EpiScale<false>, pg8::StaticOrder, PG8_ALIGN, PG8_SP2>(L, g, S, E, F.wave_s);
        }
#endif
        GBAR(); STAMP(8);
#ifndef SKIP_CONV
        for (int rep_ = 0; rep_ < PROBE_CONV; ++rep_) phase_conv(F);
#endif
        GBAR(); STAMP(9);
#ifndef SKIP_GK
        {
            unsigned char* const ws = KWS(); pg8::Gemm g{WSP(bf16_t, WS_ACT), (const bf16_t*)(ws + WS_WDN), MC, DM, DFF}; pg8::StaticOrder S; S.init(MC, DM, F.G, bid);
            pg8::EpiResidB<true> E{WSP(bf16_t, WS_HS), WSP(bf16_t, WS_HS), SSP(1), DM};
            pg8::gemm_phase<pg8::EpiResidB<true>, pg8::StaticOrder, PG8_ALIGN1, PG8_SP2>(L, g, S, E, F.wave_s);
        }
#endif
        GBAR(); STAMP(10);
#ifndef SKIP_GL
        {
            unsigned char* const ws = KWS(); pg8::Gemm g{WSP(bf16_t, WS_HS), (const bf16_t*)(ws + WS_WPG), MC, DM, DM}; pg8::StaticOrder S; S.init(MC, DM, F.G, bid);
            pg8::EpiPle E{SSP(1), 1.f / DM, EPS, WSP(bf16_t, WS_E), WSP(bf16_t, WS_HS), WSP(bf16_t, WS_XNB), SSP(2), DM};
            pg8::gemm_phase<pg8::EpiPle, pg8::StaticOrder, PG8_ALIGN1, PG8_SP2>(L, g, S, E, F.wave_s);
        }
#endif
        GBAR(); STAMP(11); if (c == NCHUNK - 1) TS_PUBLISH();
#ifndef SKIP_EW
        if (c == NCHUNK - 1) { unsigned char* const ws = KWS(); phase_final(F, OUTC(), SSP(2), (PROBE_TS && c == NCHUNK - 1) ? 1.0f + *(const float*)(ws + WS_EPS) : 1.0f); }
#endif
}

__global__ void __launch_bounds__(NWAVES * 64, 2) mk_fwd(Args args) {
    extern __shared__ __attribute__((aligned(16))) unsigned char lds[];
    cg::grid_group grid = cg::this_grid();
    Ctx F;
    F.wave_s = __builtin_amdgcn_readfirstlane((int)threadIdx.x >> 6);
    if (threadIdx.x < 32) ((volatile LAS unsigned*)((LAS unsigned char*)lds + MISC_OFF))[threadIdx.x] = 0u;
    __syncthreads();
    const XcdBarrier gbar = xcd_barrier_post((unsigned*)(KWS() + WS_BAR), (volatile LAS unsigned*)((LAS unsigned char*)lds + MISC_OFF) + 8, threadIdx.x == 0);
    F.G = gridDim.x; { const int bx = blockIdx.x; F.vcu = (F.G % 8 == 0) ? (bx % 8) * (F.G / 8) + bx / 8 : bx; }
    (void)args;
    LAS unsigned char* L = (LAS unsigned char*)lds;
#ifndef SKIP_EW
    STAMP(-1);
    for (int rep_ = 0; rep_ < PROBE_PRO; ++rep_) phase_prologue(F, L);
    for (int rep_ = 0; rep_ < PROBE_PREP; ++rep_) phase_prep(F, KIN(0), KIN(2));
#endif
    grid.sync(); STAMP(0);
    run_chunk<0>(F, lds, gbar);
#ifndef ONE_CHUNK
    run_chunk<1>(F, lds, gbar);
    run_chunk<2>(F, lds, gbar);
#endif
}

extern "C" void kernel_launch(void* const* d_in, const int* in_sizes, int n_in, void* d_out, int out_size, void* d_ws, size_t ws_size, hipStream_t stream) {
    static int grid = 0;
    if (grid == 0) {
        if (n_in != 25 || ws_size < WS_END) { fprintf(stderr, "kernel_launch: unexpected inputs (n_in %d, ws %zu)\n", n_in, ws_size); grid = -1; return; }
        int dev = 0, cus = 0, per_cu = 0;
        hipGetDevice(&dev); hipDeviceGetAttribute(&cus, hipDeviceAttributeMultiprocessorCount, dev);
        hipFuncSetAttribute((const void*)mk_fwd, hipFuncAttributeMaxDynamicSharedMemorySize, LDS_BYTES);
        hipOccupancyMaxActiveBlocksPerMultiprocessor(&per_cu, (const void*)mk_fwd, NWAVES * 64, LDS_BYTES);
        (void)hipGetLastError();
        if (per_cu < 1) per_cu = 1;
        grid = cus;
    }
    if (grid < 0) return;
    if (hipMemsetAsync((char*)d_ws + WS_BAR, 0, 16384, stream) != hipSuccess) { fprintf(stderr, "kernel_launch: memset failed\n"); return; }
    Args a{};
    for (int i = 0; i < 25; ++i) a.in[i] = (const float*)d_in[i];
    a.out = (float*)d_out; a.ws = (unsigned char*)d_ws;
    void* kargs[] = {&a};
    hipError_t e = hipLaunchCooperativeKernel((const void*)mk_fwd, dim3(grid), dim3(NWAVES * 64), kargs, LDS_BYTES, stream);
    if (e != hipSuccess) fprintf(stderr, "cooperative launch failed: %s (grid %d)\n", hipGetErrorString(e), grid);
}
```

```cpp
#include <hip/hip_runtime.h>
#include <hip/hip_cooperative_groups.h>
#include <cstdio>
#include <cstdint>
__device__ __forceinline__ int lane_id_v() { int l; asm volatile("v_mbcnt_lo_u32_b32 %0, -1, 0\n\tv_mbcnt_hi_u32_b32 %0, -1, %0" : "=v"(l)); return l; }
__device__ __forceinline__ float shx(float v, int lane, int m) { return __int_as_float(__builtin_amdgcn_ds_bpermute((lane ^ m) << 2, __float_as_int(v))); }
namespace pg8 {
#define PG8_LAS __attribute__((address_space(3)))
typedef unsigned short bf16_t;
typedef short bf16x8 __attribute__((ext_vector_type(8)));
typedef float f32x4 __attribute__((ext_vector_type(4)));
typedef unsigned u32x4 __attribute__((ext_vector_type(4)));
constexpr int BM = 256, BK = 64, HALF = 128, HTB = HALF * BK * 2  , STAGE_BYTES = 8 * HTB, NXCD = 8, WGM = 8;

__host__ __device__ __forceinline__ int lds_byte(int r, int c) { const int st = (r >> 4) * 2 + (c >> 5), rr = r & 15, cc = c & 31, ob = rr * 64 + cc * 2; return st * 1024 + (ob ^ (((ob >> 9) & 1) << 5)); }
__host__ __device__ __forceinline__ void stage_rc(int b, int& R, int& C) { const int st = b / 1024, sb = b % 1024, swz = sb ^ (((sb >> 9) & 1) << 5); R = (st >> 1) * 16 + swz / 64; C = (st & 1) * 32 + (swz % 64) / 2; }
__host__ __device__ __forceinline__ int perm32(int rho) { const int n = rho >> 4, i = rho & 15; return 8 * (i >> 2) + 4 * n + (i & 3); }

struct Unit { int pm, pn; };
struct Gemm { const bf16_t* A; const bf16_t* Bt; int M, N, K; };

struct StaticOrder {
    int nM, nN, nwg, G, c;
    __host__ __device__ void init(int M, int N, int G_, int c_) { nM = M / BM; nN = N / BM; nwg = nM * nN; G = G_; c = c_; }
    __host__ __device__ bool next(int i, Unit& u) const {
        const long L = (long)i * G + c; if (L >= nwg) return false;
        int wgid = (int)L; { const int q = nwg / NXCD, r = nwg % NXCD, xcd = wgid % NXCD, off = wgid / NXCD; wgid = (xcd < r ? xcd * (q + 1) : r * (q + 1) + (xcd - r) * q) + off; }
        const int nig = WGM * nN, gid = wgid / nig, fm = gid * WGM, gsz = (nM - fm) < WGM ? (nM - fm) : WGM;
        u.pm = fm + ((wgid % nig) % gsz); u.pn = (wgid % nig) / gsz; return true;
    }
    __device__ __forceinline__ void a_ready(const Unit&) const {}
    __device__ __forceinline__ void done(const Unit&) const {}
};

__device__ __forceinline__ unsigned cvt_pk_bf16(float lo, float hi) { unsigned r; asm volatile("v_cvt_pk_bf16_f32 %0, %1, %2" : "=v"(r) : "v"(lo), "v"(hi)); return r; }
typedef float f32x2 __attribute__((ext_vector_type(2)));
__device__ __forceinline__ f32x2 gelu_pk(f32x2 v) {
    const f32x2 av = __builtin_elementwise_abs(v), d = av * 0.2316418882f + 1.0f;
    f32x2 t; t.x = __builtin_amdgcn_rcpf(d.x); t.y = __builtin_amdgcn_rcpf(d.y);
    f32x2 q = t * 0.5307027145f + (-0.7265760135f); q = q * t + 0.7107068705f; q = q * t + (-0.142248368f); q = q * t + 0.127414796f; q = q * t;
    const f32x2 s = (v * v) * (-0.72134752044f);
    f32x2 e; e.x = __builtin_amdgcn_exp2f(s.x); e.y = __builtin_amdgcn_exp2f(s.y);
    const f32x2 m = v * (q * e), r = v - m;
    f32x2 o; o.x = v.x < 0.f ? m.x : r.x; o.y = v.y < 0.f ? m.y : r.y; return o;
}

template <int ACT  > struct EpiBf16 {
    static constexpr bool PERM = true, AFTER_DRAIN = false; static_assert(ACT == 0 || ACT == 1, "EpiBf16: ACT is 0 (none) or 1 (gelu_pk)");
    bf16_t* O; int ldc; const float* bias; int split_cols; size_t split_stride; float scale0;
    __device__ __forceinline__ void operator()(const f32x4 (&acc)[2][2][4][2], const Unit& u, int wr, int wc, int fr, int fq) const {
        const int row0 = u.pm * BM + wr * 64 + fr; int colt = u.pn * BM; bf16_t* base = O;
        float sc = 1.f; if (split_cols) { const int t = colt / split_cols; base += (size_t)t * split_stride; colt -= t * split_cols; if (t == 0) sc = scale0; }
        const int col0 = colt + wc * 32 + 8 * fq, bcol0 = u.pn * BM + wc * 32 + 8 * fq;
        f32x4 bv[2][2];
#pragma unroll
        for (int bj = 0; bj < 2; ++bj)
#pragma unroll
            for (int n = 0; n < 2; ++n) bv[bj][n] = bias ? *(const f32x4*)(bias + bcol0 + bj * HALF + 4 * n) : (f32x4){0.f, 0.f, 0.f, 0.f};
#pragma unroll
        for (int ai = 0; ai < 2; ++ai)
#pragma unroll
            for (int m = 0; m < 4; ++m) { bf16_t* rowp = base + (size_t)(row0 + ai * HALF + m * 16) * ldc + col0;
#pragma unroll
                for (int bj = 0; bj < 2; ++bj) { f32x4 v0 = acc[ai][bj][m][0] + bv[bj][0], v1 = acc[ai][bj][m][1] + bv[bj][1];
                    if (ACT == 1) { f32x2 a = gelu_pk((f32x2){v0[0], v0[1]}), b = gelu_pk((f32x2){v0[2], v0[3]}), c = gelu_pk((f32x2){v1[0], v1[1]}), d = gelu_pk((f32x2){v1[2], v1[3]});
                        v0 = (f32x4){a.x, a.y, b.x, b.y}; v1 = (f32x4){c.x, c.y, d.x, d.y}; }
                    v0 = v0 * sc; v1 = v1 * sc; u32x4 w; w.x = cvt_pk_bf16(v0[0], v0[1]); w.y = cvt_pk_bf16(v0[2], v0[3]); w.z = cvt_pk_bf16(v1[0], v1[1]); w.w = cvt_pk_bf16(v1[2], v1[3]);
                    *(u32x4*)(rowp + bj * HALF) = w; } }
    }
};

__device__ __forceinline__ float sigm(float x) { return __builtin_amdgcn_rcpf(1.0f + __builtin_amdgcn_exp2f(-1.4426950408889634f * x)); }
__device__ __forceinline__ float bf_lo(unsigned w) { return __uint_as_float(w << 16); }
__device__ __forceinline__ float bf_hi(unsigned w) { return __uint_as_float(w & 0xffff0000u); }
__device__ __forceinline__ u32x4 pack8(const f32x4 v0, const f32x4 v1) { u32x4 w; w.x = cvt_pk_bf16(v0[0], v0[1]); w.y = cvt_pk_bf16(v0[2], v0[3]); w.z = cvt_pk_bf16(v1[0], v1[1]); w.w = cvt_pk_bf16(v1[2], v1[3]); return w; }
__device__ __forceinline__ void unpack8(const u32x4 g, f32x4& a, f32x4& b) { a = (f32x4){bf_lo(g.x), bf_hi(g.x), bf_lo(g.y), bf_hi(g.y)}; b = (f32x4){bf_lo(g.z), bf_hi(g.z), bf_lo(g.w), bf_hi(g.w)}; }

struct EpiProj {
    static constexpr bool PERM = true, AFTER_DRAIN = false;
    bf16_t* O; int ldc; int sig_pn; int scale_pn; float scale;
    __device__ __forceinline__ void operator()(const f32x4 (&acc)[2][2][4][2], const Unit& u, int wr, int wc, int fr, int fq) const {
        const int row0 = u.pm * BM + wr * 64 + fr, col0 = u.pn * BM + wc * 32 + 8 * fq; const bool sg = u.pn >= sig_pn; const float sc = u.pn < scale_pn ? scale : 1.0f;
#pragma unroll
        for (int ai = 0; ai < 2; ++ai)
#pragma unroll
            for (int m = 0; m < 4; ++m) { bf16_t* rowp = O + (size_t)(row0 + ai * HALF + m * 16) * ldc + col0;
#pragma unroll
                for (int bj = 0; bj < 2; ++bj) { f32x4 v0 = acc[ai][bj][m][0] * sc, v1 = acc[ai][bj][m][1] * sc;
                    if (sg) {
#pragma unroll
                        for (int k = 0; k < 4; ++k) { v0[k] = sigm(v0[k]); v1[k] = sigm(v1[k]); } }
                    *(u32x4*)(rowp + bj * HALF) = pack8(v0, v1); } }
    }
};
struct EpiT1 {
    static constexpr bool PERM = true, AFTER_DRAIN = false;
    const bf16_t* G; int ldg; bf16_t* T; int ldt;
    __device__ __forceinline__ void operator()(const f32x4 (&acc)[2][2][4][2], const Unit& u, int wr, int wc, int fr, int fq) const {
        const int row0 = u.pm * BM + wr * 64 + fr, col0 = u.pn * BM + wc * 32 + 8 * fq;
#pragma unroll
        for (int ai = 0; ai < 2; ++ai)
#pragma unroll
            for (int m = 0; m < 4; ++m) { const size_t row = (size_t)(row0 + ai * HALF + m * 16);
#pragma unroll
                for (int bj = 0; bj < 2; ++bj) { const u32x4 g = *(const u32x4*)(G + row * ldg + col0 + bj * HALF); f32x4 g0, g1; unpack8(g, g0, g1);
                    *(u32x4*)(T + row * ldt + col0 + bj * HALF) = pack8(acc[ai][bj][m][0] * g0, acc[ai][bj][m][1] * g1); } }
    }
};
struct EpiMerge {
    static constexpr bool PERM = true, AFTER_DRAIN = false;
    const bf16_t* G; int ldg; const bf16_t* T; int ldt; bf16_t* O; int ldo;
    __device__ __forceinline__ void operator()(const f32x4 (&acc)[2][2][4][2], const Unit& u, int wr, int wc, int fr, int fq) const {
        const int row0 = u.pm * BM + wr * 64 + fr, col0 = u.pn * BM + wc * 32 + 8 * fq;
#pragma unroll
        for (int ai = 0; ai < 2; ++ai)
#pragma unroll
            for (int m = 0; m < 4; ++m) { const size_t row = (size_t)(row0 + ai * HALF + m * 16);
#pragma unroll
                for (int bj = 0; bj < 2; ++bj) { const u32x4 g = *(const u32x4*)(G + row * ldg + col0 + bj * HALF); f32x4 g0, g1; unpack8(g, g0, g1);
                    const u32x4 tv = *(const u32x4*)(T + row * ldt + col0 + bj * HALF); f32x4 t0, t1; unpack8(tv, t0, t1);
                    *(u32x4*)(O + row * ldo + col0 + bj * HALF) = pack8(t0 + acc[ai][bj][m][0] * g0, t1 + acc[ai][bj][m][1] * g1); } }
    }
};
template <bool MUL, bool XN> struct EpiResid {
    static constexpr bool PERM = true, AFTER_DRAIN = false;
    const float* base; float* out; const float* mul; bf16_t* xn; const float* gain; float* ss; int ld;
    __device__ __forceinline__ void operator()(const f32x4 (&acc)[2][2][4][2], const Unit& u, int wr, int wc, int fr, int fq) const {
        const int row0 = u.pm * BM + wr * 64 + fr, col0 = u.pn * BM + wc * 32 + 8 * fq;
        f32x4 gv[2][2];
#pragma unroll
        for (int bj = 0; bj < 2; ++bj) { if (XN) { gv[bj][0] = *(const f32x4*)(gain + col0 + bj * HALF); gv[bj][1] = *(const f32x4*)(gain + col0 + bj * HALF + 4); } else { gv[bj][0] = (f32x4){0.f, 0.f, 0.f, 0.f}; gv[bj][1] = gv[bj][0]; } }
#pragma unroll
        for (int ai = 0; ai < 2; ++ai) {
            f32x4 pre[4][2][2];
#pragma unroll
            for (int m = 0; m < 4; ++m)
#pragma unroll
                for (int bj = 0; bj < 2; ++bj) { const size_t p = (size_t)(row0 + ai * HALF + m * 16) * ld + col0 + bj * HALF; pre[m][bj][0] = *(const f32x4*)(base + p); pre[m][bj][1] = *(const f32x4*)(base + p + 4); }
            asm volatile("" ::: "memory");
#pragma unroll
            for (int m = 0; m < 4; ++m) { const size_t row = (size_t)(row0 + ai * HALF + m * 16); float s = 0.f;
#pragma unroll
                for (int bj = 0; bj < 2; ++bj) { const size_t p = row * ld + col0 + bj * HALF;
                    f32x4 v0 = acc[ai][bj][m][0], v1 = acc[ai][bj][m][1];
                    if (MUL) { v0 = v0 * *(const f32x4*)(mul + p); v1 = v1 * *(const f32x4*)(mul + p + 4); }
                    v0 = v0 + pre[m][bj][0]; v1 = v1 + pre[m][bj][1];
                    *(f32x4*)(out + p) = v0; *(f32x4*)(out + p + 4) = v1;
                    s += (v0[0] * v0[0] + v0[1] * v0[1]) + (v0[2] * v0[2] + v0[3] * v0[3]) + (v1[0] * v1[0] + v1[1] * v1[1]) + (v1[2] * v1[2] + v1[3] * v1[3]);
                    if (XN) *(u32x4*)(xn + p) = pack8(v0 * gv[bj][0], v1 * gv[bj][1]); }
                { const int ln = fr + 16 * fq; s += shx(s, ln, 16); s += shx(s, ln, 32); }
                if (fq == 0) ss[row * 16 + u.pn * 4 + wc] = s; }
            asm volatile("" ::: "memory");
        }
    }
};
template <bool BB> struct EpiResidB {
    static constexpr bool PERM = true, AFTER_DRAIN = false;
    const void* base; bf16_t* hs; float* ss; int ld;
    __device__ __forceinline__ void operator()(const f32x4 (&acc)[2][2][4][2], const Unit& u, int wr, int wc, int fr, int fq) const {
        const int row0 = u.pm * BM + wr * 64 + fr, col0 = u.pn * BM + wc * 32 + 8 * fq;
#pragma unroll
        for (int ai = 0; ai < 2; ++ai) {
            f32x4 pre[4][2][2];
#pragma unroll
            for (int m = 0; m < 4; ++m)
#pragma unroll
                for (int bj = 0; bj < 2; ++bj) { const size_t p = (size_t)(row0 + ai * HALF + m * 16) * ld + col0 + bj * HALF;
                    if (BB) { const u32x4 b = *(const u32x4*)((const bf16_t*)base + p); unpack8(b, pre[m][bj][0], pre[m][bj][1]); }
                    else { pre[m][bj][0] = *(const f32x4*)((const float*)base + p); pre[m][bj][1] = *(const f32x4*)((const float*)base + p + 4); } }
            asm volatile("" ::: "memory");
#pragma unroll
            for (int m = 0; m < 4; ++m) { const size_t row = (size_t)(row0 + ai * HALF + m * 16); float s = 0.f;
#pragma unroll
                for (int bj = 0; bj < 2; ++bj) { const size_t p = row * ld + col0 + bj * HALF;
                    const f32x4 v0 = acc[ai][bj][m][0] + pre[m][bj][0], v1 = acc[ai][bj][m][1] + pre[m][bj][1];
                    *(u32x4*)(hs + p) = pack8(v0, v1);
                    s += (v0[0] * v0[0] + v0[1] * v0[1]) + (v0[2] * v0[2] + v0[3] * v0[3]) + (v1[0] * v1[0] + v1[1] * v1[1]) + (v1[2] * v1[2] + v1[3] * v1[3]);
}
                { const int ln = fr + 16 * fq; s += shx(s, ln, 16); s += shx(s, ln, 32); }
                if (fq == 0) ss[row * 16 + u.pn * 4 + wc] = s; }
            asm volatile("" ::: "memory");
        }
    }
};
template <bool SIG> struct EpiScale {
    static constexpr bool PERM = true, AFTER_DRAIN = false;
    const float* ss; float inv_n, eps; bf16_t* O; float* F; int ldc;
    __device__ __forceinline__ void operator()(const f32x4 (&acc)[2][2][4][2], const Unit& u, int wr, int wc, int fr, int fq) const {
        const int row0 = u.pm * BM + wr * 64 + fr, col0 = u.pn * BM + wc * 32 + 8 * fq;
#pragma unroll
        for (int ai = 0; ai < 2; ++ai)
#pragma unroll
            for (int m = 0; m < 4; ++m) { const size_t row = (size_t)(row0 + ai * HALF + m * 16); const f32x4* sp = (const f32x4*)(ss + row * 16); const f32x4 sa = (sp[0] + sp[1]) + (sp[2] + sp[3]); const float r = __builtin_amdgcn_rsqf(((sa[0] + sa[1]) + (sa[2] + sa[3])) * inv_n + eps);
#pragma unroll
                for (int bj = 0; bj < 2; ++bj) { f32x4 v0 = acc[ai][bj][m][0] * r, v1 = acc[ai][bj][m][1] * r; const size_t p = row * ldc + col0 + bj * HALF;
                    if (SIG) {
#pragma unroll
                        for (int k = 0; k < 4; ++k) { v0[k] = sigm(v0[k]); v1[k] = sigm(v1[k]); }
                        *(f32x4*)(F + p) = v0; *(f32x4*)(F + p + 4) = v1;
                    } else *(u32x4*)(O + p) = pack8(v0, v1); } }
    }
};

struct EpiPle {
    static constexpr bool PERM = true, AFTER_DRAIN = false;
    const float* ss2; float inv_n, eps; const bf16_t* E; const bf16_t* hs; bf16_t* ho; float* ss3; int ld;
    __device__ __forceinline__ void operator()(const f32x4 (&acc)[2][2][4][2], const Unit& u, int wr, int wc, int fr, int fq) const {
        const int row0 = u.pm * BM + wr * 64 + fr, col0 = u.pn * BM + wc * 32 + 8 * fq;
#pragma unroll
        for (int ai = 0; ai < 2; ++ai)
#pragma unroll
          for (int mp = 0; mp < 2; ++mp) {
            f32x4 pre[2][2][2]; u32x4 ev[2][2]; f32x4 sv[2][4];
#pragma unroll
            for (int mm = 0; mm < 2; ++mm) { const size_t row = (size_t)(row0 + ai * HALF + (2 * mp + mm) * 16); const f32x4* sp = (const f32x4*)(ss2 + row * 16); sv[mm][0] = sp[0]; sv[mm][1] = sp[1]; sv[mm][2] = sp[2]; sv[mm][3] = sp[3];
#pragma unroll
                for (int bj = 0; bj < 2; ++bj) { const size_t p = row * ld + col0 + bj * HALF; { const u32x4 hb = *(const u32x4*)(hs + p); unpack8(hb, pre[mm][bj][0], pre[mm][bj][1]); } ev[mm][bj] = *(const u32x4*)(E + p); } }
            asm volatile("" ::: "memory");
#pragma unroll
            for (int mm = 0; mm < 2; ++mm) { const int m = 2 * mp + mm; const size_t row = (size_t)(row0 + ai * HALF + m * 16); float s = 0.f;
                const f32x4 sa = (sv[mm][0] + sv[mm][1]) + (sv[mm][2] + sv[mm][3]); const float r = __builtin_amdgcn_rsqf(((sa[0] + sa[1]) + (sa[2] + sa[3])) * inv_n + eps);
#pragma unroll
                for (int bj = 0; bj < 2; ++bj) { const size_t p = row * ld + col0 + bj * HALF;
                    f32x4 e0, e1; unpack8(ev[mm][bj], e0, e1);
                    f32x4 v0 = acc[ai][bj][m][0] * r, v1 = acc[ai][bj][m][1] * r;
#pragma unroll
                    for (int k = 0; k < 4; ++k) { v0[k] = sigm(v0[k]); v1[k] = sigm(v1[k]); }
                    v0 = v0 * e0 + pre[mm][bj][0]; v1 = v1 * e1 + pre[mm][bj][1];
                    *(u32x4*)(ho + p) = pack8(v0, v1);
                    s += (v0[0] * v0[0] + v0[1] * v0[1]) + (v0[2] * v0[2] + v0[3] * v0[3]) + (v1[0] * v1[0] + v1[1] * v1[1]) + (v1[2] * v1[2] + v1[3] * v1[3]); }
                { const int ln = fr + 16 * fq; s += shx(s, ln, 16); s += shx(s, ln, 32); }
                if (fq == 0) ss3[row * 16 + u.pn * 4 + wc] = s; }
            asm volatile("" ::: "memory");
          }
    }
};

template <class Epi, class Sched, bool ALIGN_EPI = false, bool SP2 = false>
__device__ __forceinline__ void gemm_phase(PG8_LAS unsigned char* lds, const Gemm g, const Sched& S, const Epi& E, int wave_s) {
    int tid_ = wave_s * 64 + lane_id_v(); asm volatile("" : "+v"(tid_));
    const int tid = tid_, wid = __builtin_amdgcn_readfirstlane(tid >> 6), lane = tid & 63, wr = wid >> 2, wc = wid & 3, fr = lane & 15, fq = lane >> 4;
    const int K = g.K, nt = K / BK;
    unsigned voffA[2], voffB[2];
#pragma unroll
    for (int i = 0; i < 2; ++i) { int R, C; stage_rc(tid * 16 + i * 8192, R, C); const int Rb = Epi::PERM ? ((R & ~31) + perm32(R & 31)) : R;
        voffA[i] = (unsigned)(R * K + C) * 2u; voffB[i] = (unsigned)(Rb * K + C) * 2u; }
    const size_t kstep = (size_t)(BK * 2);
    const size_t hstep = (size_t)HALF * K * 2;
    const size_t tstep = 2 * hstep;
    const unsigned ldsw = (unsigned)wid * 1024u;
    const int aoff = lds_byte(wr * 64 + fr, fq * 8), boff = lds_byte(wc * 32 + fr, fq * 8);
#define PG8_SA(b, h) (((b) * 2 + (h)) * HTB)
#define PG8_SB(b, h) ((4 + (b) * 2 + (h)) * HTB)
#define PG8_STAGE(bufoff, gbase, voff) do { _Pragma("unroll") for (int _i = 0; _i < 2; ++_i) \
        __builtin_amdgcn_global_load_lds((const unsigned*)((const char*)(gbase) + (voff)[_i]), (PG8_LAS unsigned*)(lds + (bufoff) + ldsw + _i * 8192), 16, 0, 0); } while (0)
#define PG8_LDA(dst, b, h) do { _Pragma("unroll") for (int m = 0; m < 4; ++m) _Pragma("unroll") for (int k = 0; k < 2; ++k) dst[m][k] = *(const PG8_LAS bf16x8*)(lds + PG8_SA(b, h) + aoff + m * 2048 + k * 1024); } while (0)
#define PG8_LDB(dst, b, h) do { _Pragma("unroll") for (int n = 0; n < 2; ++n) _Pragma("unroll") for (int k = 0; k < 2; ++k) dst[n][k] = *(const PG8_LAS bf16x8*)(lds + PG8_SB(b, h) + boff + n * 2048 + k * 1024); } while (0)
#define PG8_MMA(ai, bj, At, Bt) do { __builtin_amdgcn_s_setprio(1); _Pragma("unroll") for (int m = 0; m < 4; ++m) _Pragma("unroll") for (int n = 0; n < 2; ++n) _Pragma("unroll") for (int k = 0; k < 2; ++k) \
        acc[ai][bj][m][n] = __builtin_amdgcn_mfma_f32_16x16x32_bf16(Bt[n][k], At[m][k], acc[ai][bj][m][n], 0, 0, 0); __builtin_amdgcn_s_setprio(0); } while (0)
#define PG8_WAIT_V(n) asm volatile("s_waitcnt vmcnt(" #n ")" ::: "memory")
#define PG8_WAIT_L(n) asm volatile("s_waitcnt lgkmcnt(" #n ")" ::: "memory")
#define PG8_BAR __builtin_amdgcn_s_barrier()
#define PG8_SCHED __builtin_amdgcn_sched_barrier(0)
    Unit cur, nxt; int ui = 0;
    if (!S.next(0, cur)) return;
    f32x4 acc[2][2][4][2];
#pragma unroll
    for (int a = 0; a < 2; ++a)
#pragma unroll
        for (int b = 0; b < 2; ++b)
#pragma unroll
            for (int m = 0; m < 4; ++m)
#pragma unroll
                for (int n = 0; n < 2; ++n) acc[a][b][m][n] = (f32x4){0.f, 0.f, 0.f, 0.f};
    bf16x8 At[4][2], B0[2][2], B1[2][2];
    const char* cA = (const char*)g.A + (size_t)cur.pm * tstep; const char* cB = (const char*)g.Bt + (size_t)cur.pn * tstep;
    S.a_ready(cur);
    if constexpr (SP2) {
        PG8_STAGE(PG8_SB(0, 0), cB, voffB); PG8_STAGE(PG8_SB(0, 1), cB + hstep, voffB); PG8_STAGE(PG8_SA(0, 0), cA, voffA); PG8_STAGE(PG8_SA(0, 1), cA + hstep, voffA);
        if (wr == 1) PG8_BAR;
        PG8_WAIT_V(2); PG8_BAR;
        PG8_STAGE(PG8_SB(1, 0), cB + kstep, voffB); PG8_STAGE(PG8_SA(1, 0), cA + kstep, voffA); PG8_STAGE(PG8_SB(1, 1), cB + hstep + kstep, voffB);
        PG8_WAIT_V(6); PG8_BAR;
    } else {
        PG8_STAGE(PG8_SB(0, 0), cB, voffB); PG8_STAGE(PG8_SA(0, 0), cA, voffA); PG8_STAGE(PG8_SB(0, 1), cB + hstep, voffB); PG8_STAGE(PG8_SA(0, 1), cA + hstep, voffA);
        if (wr == 1) PG8_BAR;
        PG8_WAIT_V(4); PG8_BAR;
        PG8_STAGE(PG8_SB(1, 0), cB + kstep, voffB); PG8_STAGE(PG8_SA(1, 0), cA + kstep, voffA); PG8_STAGE(PG8_SB(1, 1), cB + hstep + kstep, voffB);
        PG8_WAIT_V(6); PG8_BAR;
    }
    for (;;) {
        const bool has_next = S.next(ui + 1, nxt);
        const char* nA = has_next ? (const char*)g.A + (size_t)nxt.pm * tstep : cA; const char* nB = has_next ? (const char*)g.Bt + (size_t)nxt.pn * tstep : cB;
        for (int t = 0; t < nt; t += 2) {
            const bool last = (t == nt - 2);
            const char* a1 = cA + (size_t)(t + 1) * kstep;
            const char* a2 = last ? nA : cA + (size_t)(t + 2) * kstep; const char* b2 = last ? nB : cB + (size_t)(t + 2) * kstep;
            const char* a3 = a2 + kstep; const char* b3 = b2 + kstep;
            if (last && has_next) S.a_ready(nxt);
            if constexpr (SP2) {
            PG8_LDB(B0, 0, 0); PG8_LDB(B1, 0, 1); PG8_SCHED; PG8_LDA(At, 0, 0); PG8_STAGE(PG8_SA(1, 1), a1 + hstep, voffA);
            PG8_WAIT_V(8); PG8_WAIT_L(0); PG8_BAR; PG8_MMA(0, 0, At, B0); PG8_MMA(0, 1, At, B1); PG8_BAR; PG8_SCHED;
            PG8_LDA(At, 0, 1); PG8_STAGE(PG8_SB(0, 0), b2, voffB); PG8_STAGE(PG8_SB(0, 1), b2 + hstep, voffB); PG8_STAGE(PG8_SA(0, 0), a2, voffA);
            PG8_WAIT_V(8); PG8_WAIT_L(0); PG8_BAR; PG8_MMA(1, 0, At, B0); PG8_MMA(1, 1, At, B1); PG8_BAR; PG8_SCHED;
            PG8_LDB(B0, 1, 0); PG8_LDB(B1, 1, 1); PG8_SCHED; PG8_LDA(At, 1, 0); PG8_STAGE(PG8_SA(0, 1), a2 + hstep, voffA);
            PG8_WAIT_V(8); PG8_WAIT_L(0); PG8_BAR; PG8_MMA(0, 0, At, B0); PG8_MMA(0, 1, At, B1); PG8_BAR; PG8_SCHED;
            PG8_LDA(At, 1, 1); PG8_STAGE(PG8_SB(1, 0), b3, voffB); PG8_STAGE(PG8_SB(1, 1), b3 + hstep, voffB); PG8_STAGE(PG8_SA(1, 0), a3, voffA);
            PG8_WAIT_V(8); PG8_WAIT_L(0); PG8_BAR; PG8_MMA(1, 0, At, B0); PG8_MMA(1, 1, At, B1); PG8_BAR; PG8_SCHED;
            } else {
            PG8_LDB(B0, 0, 0); PG8_SCHED; PG8_LDA(At, 0, 0); PG8_STAGE(PG8_SA(1, 1), a1 + hstep, voffA);
            PG8_WAIT_L(8); PG8_BAR; PG8_WAIT_L(0); PG8_MMA(0, 0, At, B0); PG8_BAR; PG8_SCHED;
            PG8_LDB(B1, 0, 1); PG8_STAGE(PG8_SB(0, 0), b2, voffB);
            PG8_BAR; PG8_WAIT_L(0); PG8_MMA(0, 1, At, B1); PG8_BAR;
            PG8_LDA(At, 0, 1); PG8_STAGE(PG8_SA(0, 0), a2, voffA);
            PG8_BAR; PG8_WAIT_L(0); PG8_MMA(1, 0, At, B0); PG8_BAR; PG8_SCHED;
            PG8_STAGE(PG8_SB(0, 1), b2 + hstep, voffB);
            PG8_WAIT_V(6); PG8_BAR; PG8_MMA(1, 1, At, B1); PG8_BAR;
            PG8_LDB(B0, 1, 0); PG8_SCHED; PG8_LDA(At, 1, 0); PG8_STAGE(PG8_SA(0, 1), a2 + hstep, voffA);
            PG8_WAIT_L(8); PG8_BAR; PG8_WAIT_L(0); PG8_MMA(0, 0, At, B0); PG8_BAR; PG8_SCHED;
            PG8_LDB(B1, 1, 1); PG8_STAGE(PG8_SB(1, 0), b3, voffB);
            PG8_BAR; PG8_WAIT_L(0); PG8_MMA(0, 1, At, B1); PG8_BAR;
            PG8_LDA(At, 1, 1); PG8_STAGE(PG8_SA(1, 0), a3, voffA);
            PG8_BAR; PG8_WAIT_L(0); PG8_MMA(1, 0, At, B0); PG8_BAR; PG8_SCHED;
            PG8_STAGE(PG8_SB(1, 1), b3 + hstep, voffB);
            PG8_WAIT_V(6); PG8_BAR; PG8_MMA(1, 1, At, B1); PG8_BAR;
            }
        }
        if constexpr (ALIGN_EPI) { if (wr == 0) PG8_BAR; }
        if constexpr (!Epi::AFTER_DRAIN) { E(acc, cur, wr, wc, fr, fq); S.done(cur); }
        if (!has_next) break;
#pragma unroll
        for (int a = 0; a < 2; ++a)
#pragma unroll
            for (int b = 0; b < 2; ++b)
#pragma unroll
                for (int m = 0; m < 4; ++m)
#pragma unroll
                    for (int n = 0; n < 2; ++n) acc[a][b][m][n] = (f32x4){0.f, 0.f, 0.f, 0.f};
        cur = nxt; cA = nA; cB = nB; ++ui;
        if constexpr (ALIGN_EPI) { if (wr == 1) PG8_BAR; }
    }
    PG8_WAIT_V(0);
    if constexpr (!ALIGN_EPI) { if (wr == 0) PG8_BAR; }
    PG8_BAR;
    if constexpr (Epi::AFTER_DRAIN) { E.fused(acc, cur, wr, wc, fr, fq, lds, wid, lane); S.done(cur); }
#undef PG8_SA
#undef PG8_SB
#undef PG8_STAGE
#undef PG8_LDA
#undef PG8_LDB
#undef PG8_MMA
#undef PG8_WAIT_V
#undef PG8_WAIT_L
#undef PG8_BAR
#undef PG8_SCHED
}
}

#ifndef PG8_SP2
#define PG8_SP2 true
#endif
#ifndef PG8_ALIGN
#define PG8_ALIGN true
#endif
#include <hip/hip_bf16.h>
#include <cmath>
#include <hip/hip_bf16.h>
#include <cmath>
namespace attn_body {
using bf16=__hip_bfloat16;
using bf16x8=__attribute__((ext_vector_type(8)))short;
using s16x4=__attribute__((ext_vector_type(4)))short;
using f32x16=__attribute__((ext_vector_type(16)))float;
using u32x4=__attribute__((ext_vector_type(4)))unsigned;
constexpr int BATCH=2,NHEAD=16,SEQ=8192,D=64,DM=NHEAD*D;
constexpr int NW=8,QBLK=32,QB=QBLK*NW,KVBLK=64,NQB=SEQ/QB;
constexpr int ATTN_PITCH=DM, ATTN_UNIT_ROWS=QB;
__device__ __forceinline__ int crow(int r,int hi){return (r&3)+8*(r>>2)+4*hi;}
#define SBAR() __builtin_amdgcn_sched_barrier(0)
__device__ __forceinline__ void cmask(f32x16&p0,f32x16&p1,int jb,int qrel,int hi){
  const float NEG=-INFINITY; int kb=64*jb+4*hi;
  #pragma unroll
  for(int r=0;r<16;++r){int kv=kb+(r&3)+8*(r>>2); if(kv>qrel)p0[r]=NEG; if(kv+32>qrel)p1[r]=NEG;}
}

constexpr int NSLOT=3, SLOTB=8192;
constexpr int LDS_K=0, LDS_V=NSLOT*SLOTB, LDS_WS=2*NSLOT*SLOTB, LDS_OST=LDS_WS+NW*64*4, LDS_BYTES=LDS_OST+NW*4096;
constexpr float C2=0.125f*1.4426950408889634f;
__device__ __forceinline__ void glds16(const void*gsrc,unsigned lds_dst){unsigned keep;
  asm volatile("s_mov_b32 %0, m0\n\ts_mov_b32 m0, %2\n\ts_nop 0\n\tglobal_load_lds_dwordx4 %1, off\n\ts_mov_b32 m0, %0":"=&s"(keep):"v"(gsrc),"s"(lds_dst):"memory");}
__device__ __forceinline__ float max3f(float a,float b,float c){float r;asm("v_max3_f32 %0, %1, %2, %3":"=v"(r):"v"(a),"v"(b),"v"(c));return r;}
__device__ __forceinline__ float max2f(float a,float b){float r;asm("v_max_f32_e32 %0, %1, %2":"=v"(r):"v"(a),"v"(b));return r;}
__device__ __forceinline__ float fadd_s(float a,float b){float r;asm("v_add_f32_e32 %0, %1, %2":"=v"(r):"v"(a),"v"(b));return r;}
__device__ __forceinline__ float fsub_s(float a,float b){float r;asm("v_sub_f32_e32 %0, %1, %2":"=v"(r):"v"(a),"v"(b));return r;}
typedef float f32x2_t __attribute__((ext_vector_type(2))); typedef __bf16 bf16x2_t __attribute__((ext_vector_type(2)));
__device__ __forceinline__ unsigned cvtpk_s(float lo,float hi){f32x2_t v={lo,hi};bf16x2_t b=__builtin_convertvector(v,bf16x2_t);return __builtin_bit_cast(unsigned,b);}
#define WAIT_BAR(N) asm volatile("s_waitcnt vmcnt(" #N ") lgkmcnt(0)\n\ts_barrier":::"memory")

__device__ __forceinline__ void qkt(f32x16&p0,f32x16&p1,const char*Kslot,const bf16x8*qr,const f32x16&negm,int r32,int hi){
  const char*kb=Kslot+hi*1024+r32*16;
  #pragma unroll
  for(int d0=0;d0<4;++d0){
    const bf16x8 b0=*reinterpret_cast<const bf16x8*>(kb+d0*2048);
    const bf16x8 b1=*reinterpret_cast<const bf16x8*>(kb+d0*2048+512);
    if(d0==0){p0=__builtin_amdgcn_mfma_f32_32x32x16_bf16(b0,qr[0],negm,0,0,0);p1=__builtin_amdgcn_mfma_f32_32x32x16_bf16(b1,qr[0],negm,0,0,0);}
    else{p0=__builtin_amdgcn_mfma_f32_32x32x16_bf16(b0,qr[d0],p0,0,0,0);p1=__builtin_amdgcn_mfma_f32_32x32x16_bf16(b1,qr[d0],p1,0,0,0);}}
}
typedef __attribute__((address_space(3))) const char* lds_cptr;
typedef short v4i16_t __attribute__((ext_vector_type(4)));
__device__ __forceinline__ void kload8(bf16x8*kf,lds_cptr kp){
  kf[0]=*(const __attribute__((address_space(3))) bf16x8*)(kp);      kf[1]=*(const __attribute__((address_space(3))) bf16x8*)(kp+512);
  kf[2]=*(const __attribute__((address_space(3))) bf16x8*)(kp+2048); kf[3]=*(const __attribute__((address_space(3))) bf16x8*)(kp+2560);
  kf[4]=*(const __attribute__((address_space(3))) bf16x8*)(kp+4096); kf[5]=*(const __attribute__((address_space(3))) bf16x8*)(kp+4608);
  kf[6]=*(const __attribute__((address_space(3))) bf16x8*)(kp+6144); kf[7]=*(const __attribute__((address_space(3))) bf16x8*)(kp+6656);
}
__device__ __forceinline__ void kload2(bf16x8*kf,lds_cptr kp,int j){ kf[2*j]=*(const __attribute__((address_space(3))) bf16x8*)(kp+j*2048); kf[2*j+1]=*(const __attribute__((address_space(3))) bf16x8*)(kp+j*2048+512); }
__device__ __forceinline__ s16x4 vtr(lds_cptr p){ return __builtin_bit_cast(s16x4,__builtin_amdgcn_ds_read_tr16_b64_v4i16((__attribute__((address_space(3))) v4i16_t*)p)); }
__device__ __forceinline__ float rowmax(const f32x16&p0,const f32x16&p1){
  float a=max3f(p0[0],p0[1],p1[0]),b=max3f(p0[2],p0[3],p1[1]);a=max3f(a,p1[2],p1[3]);
  #pragma unroll
  for(int r=4;r<16;r+=4){a=max3f(a,p0[r],p0[r+1]);b=max3f(b,p0[r+2],p0[r+3]);a=max3f(a,p1[r],p1[r+1]);b=max3f(b,p1[r+2],p1[r+3]);}
  const float m=max2f(a,b);
  auto rr=__builtin_amdgcn_permlane32_swap(__float_as_uint(m),__float_as_uint(m),false,false);
  return max2f(__uint_as_float(rr[0]),__uint_as_float(rr[1]));
}
__device__ __forceinline__ void pv(f32x16*o,int vb,bf16x8 pa0,bf16x8 pa1,bf16x8 pa2,bf16x8 pa3){
  #pragma unroll
  for(int d0=0;d0<2;++d0){s16x4 lo[4],hi[4];
    #pragma unroll
    for(int ks=0;ks<4;++ks){
      asm volatile("ds_read_b64_tr_b16 %0,%1 offset:%c2":"=&v"(lo[ks]):"v"(vb),"i"(d0*4096+ks*1024):"memory");
      asm volatile("ds_read_b64_tr_b16 %0,%1 offset:%c2":"=&v"(hi[ks]):"v"(vb),"i"(d0*4096+ks*1024+512):"memory");}
    asm volatile("s_waitcnt lgkmcnt(0)":::"memory");SBAR();
    #define PK(k) (bf16x8){lo[k][0],lo[k][1],lo[k][2],lo[k][3],hi[k][0],hi[k][1],hi[k][2],hi[k][3]}
    o[d0]=__builtin_amdgcn_mfma_f32_32x32x16_bf16(pa0,PK(0),o[d0],0,0,0);
    o[d0]=__builtin_amdgcn_mfma_f32_32x32x16_bf16(pa1,PK(1),o[d0],0,0,0);
    o[d0]=__builtin_amdgcn_mfma_f32_32x32x16_bf16(pa2,PK(2),o[d0],0,0,0);
    o[d0]=__builtin_amdgcn_mfma_f32_32x32x16_bf16(pa3,PK(3),o[d0],0,0,0);
    #undef PK
  }
}

#ifndef ATTN_STORE16
#define ATTN_STORE16(p,v) (*(u32x4*)(p)=(v))
#endif
template<int THRL> __device__ __forceinline__ void attn_unit(int qb,const bf16*Qh,const bf16*Kh,const bf16*Vh,bf16*Oh,int pq,int pk,int pv_,int po,char*shm,int wave_s){
  int tid_=wave_s*64+lane_id_v(); asm volatile("":"+v"(tid_)); const int tid=tid_,lane=tid&63,r32=lane&31,hi=lane>>5; const int wid=__builtin_amdgcn_readfirstlane(tid>>6);
  const int q0=qb*QB;
  const bf16*Qw=Qh+(long)(q0+wid*QBLK)*pq;
  const unsigned lds0=(unsigned)(uintptr_t)shm;
  float*wsf=(float*)(shm+LDS_WS)+wid*64;
  const bf16*ksrc=Kh+(long)lane*pk+wid*8;
  const bf16*vsrc=Vh+(long)(16*(wid&3)+(lane>>2))*pv_+(wid>>2)*32+(lane&3)*8;
  const unsigned kdst=lds0+LDS_K+wid*1024, vdst=lds0+LDS_V+wid*1024;
  #define DMA_K(t,slot) glds16(ksrc+(long)(t)*KVBLK*pk,(unsigned)__builtin_amdgcn_readfirstlane(kdst+(slot)))
  #define DMA_V(t,slot) glds16(vsrc+(long)(t)*KVBLK*pv_,(unsigned)__builtin_amdgcn_readfirstlane(vdst+(slot)))
  const int vb0=(int)(lds0+LDS_V)+((lane>>4)&1)*32+(lane&3)*8+(4*hi+((lane&15)>>2))*64;
  const char*Kbase=shm+LDS_K; bf16x8 kf[8];
  const lds_cptr shm3=(lds_cptr)shm; const lds_cptr kp0=shm3+LDS_K+hi*1024+r32*16; const lds_cptr vp0=shm3+LDS_V+((lane>>4)&1)*32+(lane&3)*8+(4*hi+((lane&15)>>2))*64;
  constexpr int NT=SEQ/KVBLK;
  DMA_K(0,0);DMA_V(0,0);DMA_K(1,SLOTB);
  bf16x8 qr[4];
  #pragma unroll
  for(int d0=0;d0<4;++d0)qr[d0]=*reinterpret_cast<const bf16x8*>(&Qw[(long)r32*pq+d0*16+hi*8]);
  float mhat=0.f,l_reg=0.f;f32x16 o[2];o[0]=f32x16{};o[1]=f32x16{};f32x16 negm=f32x16{};asm volatile("":"+v"(negm));

  #define CMASK(P0,P1,t) do{}while(0)
  bool resc=false;
  #define START(P0,P1) do{ const float rm=rowmax(P0,P1); resc=false; \
    { const float dl=rm; mhat=fadd_s(mhat,dl); \
      _Pragma("unroll") for(int r=0;r<16;++r){P0[r]=fsub_s(P0[r],dl);P1[r]=fsub_s(P1[r],dl);} \
      _Pragma("unroll") for(int r=0;r<16;++r)negm[r]=-mhat; asm volatile("":"+v"(negm)); } \
    _Pragma("unroll") for(int r=0;r<16;++r)P0[r]=__builtin_amdgcn_exp2f(P0[r]); }while(0)
  #define RESC() do{ if(resc){ asm volatile("s_waitcnt lgkmcnt(0)":::"memory"); \
      _Pragma("unroll") for(int d_=0;d_<2;++d_) _Pragma("unroll") for(int r=0;r<16;++r)o[d_][r]*=wsf[crow(r,hi)]; } }while(0)
  f32x16 pA0,pA1,pB0,pB1;
  int sl_prev=0,sl_cur=0,sl_next=SLOTB;
  #define ROT() do{sl_prev=sl_cur;sl_cur=sl_next;sl_next=(sl_next==(NSLOT-1)*SLOTB)?0:sl_next+SLOTB;}while(0)
  DMA_K(2,2*SLOTB);
  WAIT_BAR(3);
  qkt(pA0,pA1,Kbase,qr,negm,r32,hi);asm volatile("s_nop 15\n\ts_nop 7":"+v"(pA0),"+v"(pA1));CMASK(pA0,pA1,0);
  START(pA0,pA1);
  _Pragma("unroll") for(int r=0;r<16;++r)pA1[r]=__builtin_amdgcn_exp2f(pA1[r]);
  WAIT_BAR(0);
  DMA_K(3,0);DMA_V(1,SLOTB);
  ROT();
  kload8(kf,kp0+sl_cur);
  WAIT_BAR(2);
  s16x4 vlo[8],vhi[8]; u32x4 pw0,pw1,pw2,pw3;
  #define PKW(P,B) cvtpk_s(P[B],P[B+1])
  #define PAF(k) __builtin_bit_cast(bf16x8,pw##k)
  #define VFR(i) (bf16x8){vlo[i][0],vlo[i][1],vlo[i][2],vlo[i][3],vhi[i][0],vhi[i][1],vhi[i][2],vhi[i][3]}
  #define PIN(x) asm volatile("":"+v"(x))
  #define MX3(a,b,c) __builtin_fmaxf(__builtin_fmaxf((a),(b)),(c))
  #define GAPA(MF,A0,A1,A2,A3,W0,W1,PW) do{ MF; sacc+=A0; sacc+=A1; sacc+=A2; sacc+=A3; PIN(sacc); W0; W1; PIN(PW); SBAR(); }while(0)
  #define EX(v) __builtin_amdgcn_exp2f(v)
  #define GAPB(MF,X,B) do{ MF; X[B]=EX(X[B]); X[B+1]=EX(X[B+1]); X[B+2]=EX(X[B+2]); X[B+3]=EX(X[B+3]); PIN(X); SBAR(); }while(0)
  #define VRD(i) do{ vlo[i]=vtr(vp_+(((i)>>2)*4096+((i)&3)*1024)); vhi[i]=vtr(vp_+(((i)>>2)*4096+((i)&3)*1024+512)); }while(0)
  #define KRD(G,j) do{ if(G){ kload2(kf,kp0+sl_next,j); SBAR(); } }while(0)
  #define STEP(C0,C1,P0,P1,t,GK,GV,GL,GM) do{ SBAR(); \
    const lds_cptr vp_=vp0+sl_prev; \
    VRD(0); SBAR(); float sacc=(P0[0]+P0[1]); \
    GAPA(C0=__builtin_amdgcn_mfma_f32_32x32x16_bf16(kf[0],qr[0],negm,0,0,0), P0[2],P0[3],P0[4],P0[5],     pw0[0]=PKW(P0,0), pw0[1]=PKW(P0,2), pw0); \
    VRD(4); SBAR(); GAPA(C1=__builtin_amdgcn_mfma_f32_32x32x16_bf16(kf[1],qr[0],negm,0,0,0), P0[6],P0[7],P0[8],P0[9],     pw0[2]=PKW(P0,4), pw0[3]=PKW(P0,6), pw0); \
    VRD(1); SBAR(); GAPA(C0=__builtin_amdgcn_mfma_f32_32x32x16_bf16(kf[2],qr[1],C0,0,0,0),   P0[10],P0[11],P0[12],P0[13], pw1[0]=PKW(P0,8), pw1[1]=PKW(P0,10), pw1); \
    VRD(5); SBAR(); GAPA(C1=__builtin_amdgcn_mfma_f32_32x32x16_bf16(kf[3],qr[1],C1,0,0,0),   P0[14],P0[15],P1[0],P1[1],   pw1[2]=PKW(P0,12),pw1[3]=PKW(P0,14), pw1); \
    VRD(2); SBAR(); GAPA(C0=__builtin_amdgcn_mfma_f32_32x32x16_bf16(kf[4],qr[2],C0,0,0,0),   P1[2],P1[3],P1[4],P1[5],     pw2[0]=PKW(P1,0), pw2[1]=PKW(P1,2), pw2); \
    VRD(6); SBAR(); GAPA(C1=__builtin_amdgcn_mfma_f32_32x32x16_bf16(kf[5],qr[2],C1,0,0,0),   P1[6],P1[7],P1[8],P1[9],     pw2[2]=PKW(P1,4), pw2[3]=PKW(P1,6), pw2); \
    VRD(3); SBAR(); GAPA(C0=__builtin_amdgcn_mfma_f32_32x32x16_bf16(kf[6],qr[3],C0,0,0,0),   P1[10],P1[11],P1[12],P1[13], pw3[0]=PKW(P1,8), pw3[1]=PKW(P1,10), pw3); \
    VRD(7); SBAR(); GAPA(C1=__builtin_amdgcn_mfma_f32_32x32x16_bf16(kf[7],qr[3],C1,0,0,0),   P1[14],P1[15],0.f,0.f,       pw3[2]=PKW(P1,12),pw3[3]=PKW(P1,14), pw3); \
    l_reg+=sacc; \
    if(GK){DMA_K((t)+3,sl_cur);} if(GV){DMA_V((t)+1,sl_next);} \
    CMASK(C0,C1,t); \
    if(GM){ float a=MX3(C0[0],C0[1],C1[0]),b=MX3(C0[2],C0[3],C1[1]); a=MX3(a,C1[2],C1[3]); \
      _Pragma("unroll") for(int r=4;r<16;r+=4){a=MX3(a,C0[r],C0[r+1]);b=MX3(b,C0[r+2],C0[r+3]);a=MX3(a,C1[r],C1[r+1]);b=MX3(b,C1[r+2],C1[r+3]);} \
      float rm=__builtin_fmaxf(a,b); { auto rr=__builtin_amdgcn_permlane32_swap(__float_as_uint(rm),__float_as_uint(rm),false,false); rm=__builtin_fmaxf(__uint_as_float(rr[0]),__uint_as_float(rr[1])); } \
      resc=false; \
      if(__builtin_expect(__any(rm>(float)THRL),0)){ const float dl=__builtin_fmaxf(rm,0.f); mhat+=dl; \
        _Pragma("unroll") for(int r=0;r<16;++r){C0[r]-=dl;C1[r]-=dl;} \
        _Pragma("unroll") for(int r=0;r<16;++r)negm[r]=-mhat; asm volatile("":"+v"(negm)); \
        const float f=__builtin_amdgcn_exp2f(-dl); l_reg*=f; if(hi==0)wsf[r32]=f; resc=true; } } else { resc=false; } \
    SBAR(); \
    GAPB(o[0]=__builtin_amdgcn_mfma_f32_32x32x16_bf16(PAF(0),VFR(0),o[0],0,0,0), C0,0); \
    GAPB(o[1]=__builtin_amdgcn_mfma_f32_32x32x16_bf16(PAF(0),VFR(4),o[1],0,0,0), C0,4); \
    KRD(GL,0); GAPB(o[0]=__builtin_amdgcn_mfma_f32_32x32x16_bf16(PAF(1),VFR(1),o[0],0,0,0), C0,8); \
    KRD(GL,1); GAPB(o[1]=__builtin_amdgcn_mfma_f32_32x32x16_bf16(PAF(1),VFR(5),o[1],0,0,0), C0,12); \
    KRD(GL,2); GAPB(o[0]=__builtin_amdgcn_mfma_f32_32x32x16_bf16(PAF(2),VFR(2),o[0],0,0,0), C1,0); \
    KRD(GL,3); GAPB(o[1]=__builtin_amdgcn_mfma_f32_32x32x16_bf16(PAF(2),VFR(6),o[1],0,0,0), C1,4); \
    GAPB(o[0]=__builtin_amdgcn_mfma_f32_32x32x16_bf16(PAF(3),VFR(3),o[0],0,0,0), C1,8); \
    GAPB(o[1]=__builtin_amdgcn_mfma_f32_32x32x16_bf16(PAF(3),VFR(7),o[1],0,0,0), C1,12); \
    }while(0)
  int t=1;
  #undef CMASK
  #define CMASK(P0,P1,t) do{}while(0)
  for(;t+5<NT;t+=2){
    STEP(pB0,pB1,pA0,pA1,t,true,true,true,true);     WAIT_BAR(2); RESC(); ROT();
    STEP(pA0,pA1,pB0,pB1,t+1,true,true,true,false);   WAIT_BAR(2); ROT();
  }
  #undef CMASK
  #define CMASK(P0,P1,t) do{}while(0)
  #define ENDW(tt) do{ if((tt)+3<NT){WAIT_BAR(2);} else if((tt)+2<NT){WAIT_BAR(1);} else {WAIT_BAR(0);} }while(0)
  for(;t+1<NT;t+=2){
    STEP(pB0,pB1,pA0,pA1,t,(t+3<NT),(t+1<NT),(t+1<NT),true);       ENDW(t);   RESC(); ROT();
    STEP(pA0,pA1,pB0,pB1,t+1,(t+4<NT),(t+2<NT),(t+2<NT),true);     ENDW(t+1); RESC(); ROT();
  }
  STEP(pB0,pB1,pA0,pA1,NT-1,false,false,false,true); RESC();
  { float sacc=pB0[0]+pB0[1]; _Pragma("unroll") for(int r=2;r<16;++r)sacc+=pB0[r]; _Pragma("unroll") for(int r=0;r<16;++r)sacc+=pB1[r]; l_reg+=sacc;
    pw0=(u32x4){PKW(pB0,0),PKW(pB0,2),PKW(pB0,4),PKW(pB0,6)};pw1=(u32x4){PKW(pB0,8),PKW(pB0,10),PKW(pB0,12),PKW(pB0,14)};pw2=(u32x4){PKW(pB1,0),PKW(pB1,2),PKW(pB1,4),PKW(pB1,6)};pw3=(u32x4){PKW(pB1,8),PKW(pB1,10),PKW(pB1,12),PKW(pB1,14)};
    SBAR(); pv(o,vb0+sl_cur,PAF(0),PAF(1),PAF(2),PAF(3)); }
  #undef PKW
  #undef PAF
  #undef VFR
  #undef PIN
  #undef MX3
  #undef GAPA
  #undef GAPB
  #undef EX
  #undef VRD
  #undef KRD
  #undef STEP
  #undef ENDW
  {auto rr=__builtin_amdgcn_permlane32_swap(__float_as_uint(l_reg),__float_as_uint(l_reg),false,false);l_reg=__uint_as_float(rr[0])+__uint_as_float(rr[1]);}
  if(hi==0)wsf[32+r32]=l_reg;asm volatile("s_waitcnt lgkmcnt(0)":::"memory");
  float rli[16];
  #pragma unroll
  for(int r=0;r<16;++r)rli[r]=__builtin_amdgcn_rcpf(wsf[32+crow(r,hi)]);
  bf16*Ow=Oh+(long)(q0+wid*QBLK)*po;
  { bf16*stg=(bf16*)(shm+LDS_OST)+wid*2048;
    #pragma unroll
    for(int r=0;r<16;++r){const int orow=crow(r,hi);
      #pragma unroll
      for(int d0=0;d0<2;++d0)stg[orow*64+d0*32+r32]=__float2bfloat16(o[d0][r]*rli[r]);}
    asm volatile("s_waitcnt lgkmcnt(0)":::"memory");
    #pragma unroll
    for(int i=0;i<4;++i){const int row=i*8+(lane>>3),ch=lane&7; const u32x4 v=*(const u32x4*)(stg+row*64+ch*8); ATTN_STORE16(Ow+(long)row*po+ch*8,v);} }
  asm volatile("s_waitcnt lgkmcnt(0)\n\ts_barrier":::"memory");
  #undef DMA_K
  #undef DMA_V
  #undef CMASK
  #undef START
  #undef RESC
  #undef ROT
}
#undef SBAR
#undef WAIT_BAR
}
namespace attn128 {
using bf16 = __hip_bfloat16;
using bf16x8 = __attribute__((ext_vector_type(8))) short;
using s16x4  = __attribute__((ext_vector_type(4))) short;
using f32x16 = __attribute__((ext_vector_type(16))) float;
using u32x4  = __attribute__((ext_vector_type(4))) unsigned;
constexpr int NW = 8, QBLK = 32, KVBLK = 64, SEQ = 8192;
constexpr float THR = 8.f;
constexpr size_t SHM_V = KVBLK * 128 * 2, SHM_K = KVBLK * 64 * 2, SHM_ATTN = 2 * SHM_V + 2 * SHM_K + NW * 64 * 4;
#define KSWZ64(row, colB) ((row) * 128 + ((colB) ^ ((((row) >> 1) & 7) << 4)))
#define SBAR() __builtin_amdgcn_sched_barrier(0)
#define WGBAR() asm volatile("s_waitcnt lgkmcnt(0)\n\ts_barrier" ::: "memory")
__device__ __forceinline__ int crow(int r, int hi) { return (r & 3) + 8 * (r >> 2) + 4 * hi; }
__device__ __forceinline__ unsigned cvtpk(float lo, float hi) { unsigned r; asm volatile("v_cvt_pk_bf16_f32 %0, %1, %2" : "=v"(r) : "v"(lo), "v"(hi)); return r; }
__device__ __forceinline__ void partialSM_nocheck(f32x16& p0, float& alpha) {
  alpha = 1.f;
#pragma unroll
  for (int r = 0; r < 16; ++r) p0[r] = __builtin_amdgcn_exp2f(p0[r]);
}
template <bool FIRST> __device__ __forceinline__ void partialSM(f32x16& p0, f32x16& p1, float& m_reg, f32x16& negm, float& alpha) {
  float pmax = p0[0];
#pragma unroll
  for (int r = 1; r < 16; ++r) pmax = fmaxf(pmax, p0[r]);
#pragma unroll
  for (int r = 0; r < 16; ++r) pmax = fmaxf(pmax, p1[r]);
  { auto rr = __builtin_amdgcn_permlane32_swap(__float_as_uint(pmax), __float_as_uint(pmax), false, false);
    pmax = fmaxf(__uint_as_float(rr[0]), __uint_as_float(rr[1])); }
  if (!FIRST && __builtin_expect(__all(pmax <= THR), 1)) { alpha = 1.f; }
  else { const float d = FIRST ? pmax : fmaxf(pmax, 0.f); alpha = FIRST ? 1.f : __builtin_amdgcn_exp2f(-d); m_reg += d;
#pragma unroll
    for (int r = 0; r < 16; ++r) { p0[r] -= d; p1[r] -= d; }
#pragma unroll
    for (int r = 0; r < 16; ++r) negm[r] = -m_reg;
    asm volatile("" : "+v"(negm)); }
#pragma unroll
  for (int r = 0; r < 16; ++r) p0[r] = __builtin_amdgcn_exp2f(p0[r]);
}
__device__ __forceinline__ void finishSM(f32x16& p0, f32x16& p1, float alpha, float& l_reg, bf16x8& pa0, bf16x8& pa1, bf16x8& pa2, bf16x8& pa3) {
#pragma unroll
  for (int r = 0; r < 16; ++r) p1[r] = __builtin_amdgcn_exp2f(p1[r]);
  float ps = 0;
#pragma unroll
  for (int r = 0; r < 16; ++r) ps += p0[r];
#pragma unroll
  for (int r = 0; r < 16; ++r) ps += p1[r];
  { auto rr = __builtin_amdgcn_permlane32_swap(__float_as_uint(ps), __float_as_uint(ps), false, false);
    ps = __uint_as_float(rr[0]) + __uint_as_float(rr[1]); }
  l_reg = l_reg * alpha + ps;
#define PK4(P, BASE, OUT) do { unsigned a0 = cvtpk(P[BASE + 0], P[BASE + 1]), a1 = cvtpk(P[BASE + 2], P[BASE + 3]);   \
    unsigned b0 = cvtpk(P[BASE + 4], P[BASE + 5]), b1 = cvtpk(P[BASE + 6], P[BASE + 7]);                              \
    auto r0 = __builtin_amdgcn_permlane32_swap(a0, b0, false, false); auto r1 = __builtin_amdgcn_permlane32_swap(a1, b1, false, false); \
    u32x4 w = {r0[0], r1[0], r0[1], r1[1]}; OUT = *reinterpret_cast<bf16x8*>(&w); } while (0)
  PK4(p0, 0, pa0); PK4(p0, 8, pa1); PK4(p1, 0, pa2); PK4(p1, 8, pa3);
#undef PK4
}
__device__ __forceinline__ void qkt(f32x16& p0, f32x16& p1, const char* Ks, const bf16x8* qr, const f32x16& negm, int r32, int hi) {
  p0 = negm; p1 = negm;
#pragma unroll
  for (int d0 = 0; d0 < 4; ++d0) { const int cb = (d0 * 16 + hi * 8) * 2;
    bf16x8 b0 = *reinterpret_cast<const bf16x8*>(Ks + KSWZ64(r32, cb));
    bf16x8 b1 = *reinterpret_cast<const bf16x8*>(Ks + KSWZ64(32 + r32, cb));
    p0 = __builtin_amdgcn_mfma_f32_32x32x16_bf16(b0, qr[d0], p0, 0, 0, 0);
    p1 = __builtin_amdgcn_mfma_f32_32x32x16_bf16(b1, qr[d0], p1, 0, 0, 0); }
}
__device__ __forceinline__ int v_st(int k, int c) { const int kk = (k & ~0xC) | ((k & 4) << 1) | ((k & 8) >> 1); return ((kk >> 3) * 4 + (c >> 5)) * 512 + ((kk & 7) * 32 + (c & 31)) * 2; }
__device__ __forceinline__ int v_rd_base(int lane) { return ((lane & 3) << 3) | (((lane >> 2) & 3) << 6) | (((lane >> 4) & 1) << 5) | (((lane >> 5) & 1) << 8); }
constexpr int v_rd_off(int d0, int ks, int half) { return d0 * 512 + ks * 4096 + half * 2048; }
template <int OFF> __device__ __forceinline__ s16x4 tr_read(int vb) { s16x4 r; asm volatile("ds_read_b64_tr_b16 %0, %1 offset:%2" : "=&v"(r) : "v"(vb), "i"(OFF) : "memory"); return r; }
template <int D0> __device__ __forceinline__ void pv_one(f32x16& od, int vb, bf16x8 pa0, bf16x8 pa1, bf16x8 pa2, bf16x8 pa3) {
  const s16x4 l0 = tr_read<v_rd_off(D0, 0, 0)>(vb), h0 = tr_read<v_rd_off(D0, 0, 1)>(vb), l1 = tr_read<v_rd_off(D0, 1, 0)>(vb), h1 = tr_read<v_rd_off(D0, 1, 1)>(vb);
  const s16x4 l2 = tr_read<v_rd_off(D0, 2, 0)>(vb), h2 = tr_read<v_rd_off(D0, 2, 1)>(vb), l3 = tr_read<v_rd_off(D0, 3, 0)>(vb), h3 = tr_read<v_rd_off(D0, 3, 1)>(vb);
  asm volatile("s_waitcnt lgkmcnt(0)" ::: "memory"); SBAR();
#define PK(L, H) (bf16x8){L[0], L[1], L[2], L[3], H[0], H[1], H[2], H[3]}
  od = __builtin_amdgcn_mfma_f32_32x32x16_bf16(pa0, PK(l0, h0), od, 0, 0, 0);
  od = __builtin_amdgcn_mfma_f32_32x32x16_bf16(pa1, PK(l1, h1), od, 0, 0, 0);
  od = __builtin_amdgcn_mfma_f32_32x32x16_bf16(pa2, PK(l2, h2), od, 0, 0, 0);
  od = __builtin_amdgcn_mfma_f32_32x32x16_bf16(pa3, PK(l3, h3), od, 0, 0, 0);
#undef PK
}
#define PV_RD(F, D0) do { F[0] = tr_read<v_rd_off(D0, 0, 0)>(vb); F[1] = tr_read<v_rd_off(D0, 0, 1)>(vb); F[2] = tr_read<v_rd_off(D0, 1, 0)>(vb); F[3] = tr_read<v_rd_off(D0, 1, 1)>(vb); \
    F[4] = tr_read<v_rd_off(D0, 2, 0)>(vb); F[5] = tr_read<v_rd_off(D0, 2, 1)>(vb); F[6] = tr_read<v_rd_off(D0, 3, 0)>(vb); F[7] = tr_read<v_rd_off(D0, 3, 1)>(vb); } while (0)
#define PV_PK(L, H) (bf16x8){L[0], L[1], L[2], L[3], H[0], H[1], H[2], H[3]}
#define PV_MF(OD, F) do { OD = __builtin_amdgcn_mfma_f32_32x32x16_bf16(pa0, PV_PK(F[0], F[1]), OD, 0, 0, 0); OD = __builtin_amdgcn_mfma_f32_32x32x16_bf16(pa1, PV_PK(F[2], F[3]), OD, 0, 0, 0); \
    OD = __builtin_amdgcn_mfma_f32_32x32x16_bf16(pa2, PV_PK(F[4], F[5]), OD, 0, 0, 0); OD = __builtin_amdgcn_mfma_f32_32x32x16_bf16(pa3, PV_PK(F[6], F[7]), OD, 0, 0, 0); } while (0)
__device__ __forceinline__ void pv_d0(f32x16* o, int vb, bf16x8 pa0, bf16x8 pa1, bf16x8 pa2, bf16x8 pa3) {
  s16x4 fa[8], fb[8];
  PV_RD(fa, 0); PV_RD(fb, 1);
  asm volatile("s_waitcnt lgkmcnt(8)" ::: "memory"); SBAR();
  PV_MF(o[0], fa); SBAR();
  PV_RD(fa, 2);
  asm volatile("s_waitcnt lgkmcnt(8)" ::: "memory"); SBAR();
  PV_MF(o[1], fb); SBAR();
  PV_RD(fb, 3);
  asm volatile("s_waitcnt lgkmcnt(8)" ::: "memory"); SBAR();
  PV_MF(o[2], fa); SBAR();
  asm volatile("s_waitcnt lgkmcnt(0)" ::: "memory"); SBAR();
  PV_MF(o[3], fb);
}
#undef PV_RD
#undef PV_PK
#undef PV_MF
__device__ __forceinline__ void attn128_unit(int qb, const bf16* __restrict__ Qh0, const bf16* __restrict__ Kh0, const bf16* __restrict__ Vh, bf16* __restrict__ Oh,
                                             int pq, int pk, int pv_, int po, char* lds, int wave_s, float lam, const float* __restrict__ gdiff) {
#pragma nounroll
 for (int jmap = 0; jmap < 2; ++jmap) {
  const bf16* __restrict__ Qh = Qh0 + jmap * 64; const bf16* __restrict__ Kh = Kh0 + jmap * 64;
  int tid_ = wave_s * 64 + lane_id_v(); asm volatile("" : "+v"(tid_));
  const int tid = tid_, wid = wave_s, lane = tid & 63, r32 = lane & 31, hi = lane >> 5;
  char* V_lds = lds; char* K_lds = lds + 2 * SHM_V;
  float* ws = (float*)(lds + 2 * SHM_V + 2 * SHM_K) + wid * 64; float* li_l = ws; float* al_l = ws + 32;
  float m_reg = 0.f, l_reg = 0; bf16x8 qr[4];
  float z_ = 0.f; asm volatile("" : "+v"(z_));
  f32x16 negm, o[4];
#pragma unroll
  for (int r = 0; r < 16; ++r) { negm[r] = z_; o[0][r] = z_; o[1][r] = z_; o[2][r] = z_; o[3][r] = z_; }
  asm volatile("" : "+v"(negm));
  const bf16* Qw = Qh + (long)(qb * 256 + wid * QBLK + r32) * pq + hi * 8;
#pragma unroll
  for (int d0 = 0; d0 < 4; ++d0) qr[d0] = *reinterpret_cast<const bf16x8*>(Qw + d0 * 16);
  const int sr = tid >> 4, sc = (tid & 15) * 8, vst0 = v_st(sr, sc), vst1 = v_st(32 + sr, sc);
  const int kr = tid >> 3, kc = (tid & 7) * 8, kst = KSWZ64(kr, kc * 2);
  const int vb0 = (int)(uintptr_t)V_lds + v_rd_base(lane);
  struct { bf16x8 vs0, vs1, ks0; } sr_[2];
#define SLOAD(i, k0) do { sr_[i].vs0 = *reinterpret_cast<const bf16x8*>(&Vh[(long)((k0) + sr) * pv_ + sc]); sr_[i].vs1 = *reinterpret_cast<const bf16x8*>(&Vh[(long)((k0) + 32 + sr) * pv_ + sc]); \
    sr_[i].ks0 = *reinterpret_cast<const bf16x8*>(&Kh[(long)((k0) + kr) * pk + kc]); } while (0)
#define SWRITE(b, i) do { *(bf16x8*)(V_lds + (b) * SHM_V + vst0) = sr_[i].vs0; *(bf16x8*)(V_lds + (b) * SHM_V + vst1) = sr_[i].vs1; \
    *(bf16x8*)(K_lds + (b) * SHM_K + kst) = sr_[i].ks0; } while (0)
#define SWAIT() asm volatile("s_waitcnt vmcnt(3)" ::: "memory")
#define RESC(a) do { if (__any((a) < 1.f)) { if (hi == 0) al_l[r32] = (a); asm volatile("s_waitcnt lgkmcnt(0)" ::: "memory"); \
    _Pragma("unroll") for (int d = 0; d < 4; ++d) _Pragma("unroll") for (int r = 0; r < 16; ++r) o[d][r] *= al_l[crow(r, hi)]; } } while (0)
  f32x16 pA0, pA1, pB0, pB1; float alA, alB; bf16x8 pa0, pa1, pa2, pa3; constexpr int NT = SEQ / KVBLK;
  constexpr int SE = 0, SO = 1;
  SLOAD(SE, 0); asm volatile("s_waitcnt vmcnt(0)" ::: "memory"); SWRITE(0, SE); WGBAR();
  qkt(pA0, pA1, K_lds, qr, negm, r32, hi); partialSM<true>(pA0, pA1, m_reg, negm, alA);
  SLOAD(SO, KVBLK); SLOAD(SE, 2 * KVBLK);
  SWAIT(); SWRITE(1, SO); WGBAR();
  for (int j = 1; j + 1 < NT; j += 2) {
    SBAR(); qkt(pB0, pB1, K_lds + SHM_K, qr, negm, r32, hi);
    finishSM(pA0, pA1, alA, l_reg, pa0, pa1, pa2, pa3); SBAR();
    SLOAD(SO, (j + 2) * KVBLK); SBAR();
    pv_d0(o, vb0, pa0, pa1, pa2, pa3); partialSM<false>(pB0, pB1, m_reg, negm, alB);
    WGBAR(); SWAIT(); SWRITE(0, SE);
    RESC(alB); WGBAR();
    SBAR(); qkt(pA0, pA1, K_lds, qr, negm, r32, hi);
    finishSM(pB0, pB1, alB, l_reg, pa0, pa1, pa2, pa3); SBAR();
    if (j + 3 < NT) SLOAD(SE, (j + 3) * KVBLK); SBAR();
    pv_d0(o, vb0 + (int)SHM_V, pa0, pa1, pa2, pa3); partialSM_nocheck(pA0, alA);
    WGBAR(); SWAIT(); SWRITE(1, SO);
    RESC(alA); WGBAR();
  }
  SBAR(); qkt(pB0, pB1, K_lds + SHM_K, qr, negm, r32, hi);
  finishSM(pA0, pA1, alA, l_reg, pa0, pa1, pa2, pa3); SBAR();
  pv_d0(o, vb0, pa0, pa1, pa2, pa3); partialSM<false>(pB0, pB1, m_reg, negm, alB);
  WGBAR(); RESC(alB);
  finishSM(pB0, pB1, alB, l_reg, pa0, pa1, pa2, pa3); SBAR();
  pv_d0(o, vb0 + (int)SHM_V, pa0, pa1, pa2, pa3);
  if (hi == 0) li_l[r32] = l_reg; asm volatile("s_waitcnt lgkmcnt(0)" ::: "memory");
  float rli[16];
#pragma unroll
  for (int r = 0; r < 16; ++r) rli[r] = __builtin_amdgcn_rcpf(li_l[crow(r, hi)]);
  unsigned short* stash = (unsigned short*)(lds + SHM_ATTN) + wid * 4096;
  if (jmap == 0) {
#pragma unroll
    for (int r = 0; r < 16; ++r) { const int orow = crow(r, hi);
#pragma unroll
      for (int d0 = 0; d0 < 4; ++d0) { const bf16 v = __float2bfloat16(o[d0][r] * rli[r]); stash[orow * 128 + d0 * 32 + r32] = __builtin_bit_cast(unsigned short, v); } }
  } else {
    float ssq[16];
#pragma unroll
    for (int r = 0; r < 16; ++r) { const int orow = crow(r, hi); float q = 0.f;
#pragma unroll
      for (int d0 = 0; d0 < 4; ++d0) { const float o1 = __uint_as_float((unsigned)stash[orow * 128 + d0 * 32 + r32] << 16); const float v = o1 - lam * (o[d0][r] * rli[r]); o[d0][r] = v; q += v * v; }
      ssq[r] = q; }
#pragma unroll
    for (int msk = 1; msk < 32; msk <<= 1)
#pragma unroll
      for (int r = 0; r < 16; ++r) ssq[r] += shx(ssq[r], lane, msk);
    float gd[4];
#pragma unroll
    for (int d0 = 0; d0 < 4; ++d0) gd[d0] = gdiff[d0 * 32 + r32] * 0.8f;
    bf16* Ow = Oh + (long)(qb * 256 + wid * QBLK) * po;
#pragma unroll
    for (int r = 0; r < 16; ++r) { const int orow = crow(r, hi); const float rs = __builtin_amdgcn_rsqf(ssq[r] * (1.f / 128.f) + 1e-6f);
#pragma unroll
      for (int d0 = 0; d0 < 4; ++d0) Ow[(long)orow * po + d0 * 32 + r32] = __float2bfloat16(o[d0][r] * rs * gd[d0]); }
  }
  WGBAR();
 }
#undef SLOAD
#undef SWRITE
#undef SWAIT
#undef RESC
}
#undef KSWZ64
#undef SBAR
#undef WGBAR
}
#define LAS __attribute__((address_space(3)))
#define XB_TMO      128
#define XB_XCNT(j)  (256  + 64 * (j))
#define XB_XSUB(j)  (1280 + 64 * (j))
#define XB_XGEN(j)  (2304 + 64 * (j))
#define XB_TOP      3328
#define XB_TOPGEN   3392
#define XCD_BAR_WORDS 3456
#define XB_SPIN_CAP (1u << 18)

__device__ __forceinline__ unsigned xb_ld(unsigned* p)              { return __hip_atomic_load(p, __ATOMIC_RELAXED, __HIP_MEMORY_SCOPE_AGENT); }
__device__ __forceinline__ unsigned xb_add(unsigned* p, unsigned v) { return __hip_atomic_fetch_add(p, v, __ATOMIC_RELAXED, __HIP_MEMORY_SCOPE_AGENT); }
__device__ __forceinline__ unsigned xb_xcc_id() { return (unsigned)__builtin_amdgcn_s_getreg((3 << 11) | 20) & 0xFu; }
#define XB_SPIN(cond, bar) do { unsigned _sp = 0; while (cond) { __builtin_amdgcn_s_sleep(1); \
    if ((++_sp & 255u) == 0u) { if (xb_ld(&(bar)[XB_TMO])) break; if (_sp > XB_SPIN_CAP) { atomicAdd(&(bar)[XB_TMO], 1u); break; } } } } while (0)

struct XcdBarrier {
    unsigned* bar; unsigned x;
    volatile LAS unsigned* st; bool leader;
};

__device__ __forceinline__ XcdBarrier xcd_barrier_post(unsigned* bar, volatile LAS unsigned* st, bool leader) {
    XcdBarrier b; b.bar = bar; b.x = xb_xcc_id(); b.st = st; b.leader = leader;
    if (leader) (void)xb_add(&bar[XB_XCNT(b.x)], 1u);
    return b;
}
__device__ __forceinline__ void xcd_barrier_complete(unsigned* bar, unsigned x, unsigned& nloc, unsigned& nx) {
    const unsigned G = gridDim.x * gridDim.y * gridDim.z;
    unsigned sum, cnt, mine, sp = 0u;
    for (;;) {
        sum = 0u; cnt = 0u; mine = 0u;
#pragma unroll
        for (unsigned j = 0; j < 16; ++j) { const unsigned c = xb_ld(&bar[XB_XCNT(j)]); sum += c; cnt += (c > 0u) ? 1u : 0u; mine = (j == x) ? c : mine; }
        if (sum == G) break;
        __builtin_amdgcn_s_sleep(1);
        if ((++sp & 255u) == 0u) { if (xb_ld(&bar[XB_TMO])) break; if (sp > XB_SPIN_CAP) { atomicAdd(&bar[XB_TMO], 1u); break; } }
    }
    nloc = mine > 0u ? mine : 1u; nx = cnt > 0u ? cnt : 1u;
}

__device__ __forceinline__ void xcd_barrier(const XcdBarrier& b) {
    asm volatile("s_waitcnt vmcnt(0)" ::: "memory");
    __syncthreads();
    if (b.leader) {
        unsigned* bar = b.bar;
        __builtin_amdgcn_s_waitcnt(0);
        unsigned nloc = b.st[0], nx = b.st[1];
        if (nloc == 0u) { xcd_barrier_complete(bar, b.x, nloc, nx); b.st[0] = nloc; b.st[1] = nx; }
        const unsigned old = xb_add(&bar[XB_XSUB(b.x)], 1u);
        const unsigned gen = old / nloc;
        if (old + 1u == (gen + 1u) * nloc) {
            __builtin_amdgcn_fence(__ATOMIC_RELEASE, "agent");
            asm volatile("s_waitcnt vmcnt(0)" ::: "memory");
            const unsigned og = xb_add(&bar[XB_TOP], 1u);
            const unsigned tg = og / nx;
            if (og + 1u == (tg + 1u) * nx) xb_add(&bar[XB_TOPGEN], 1u);
            else XB_SPIN(xb_ld(&bar[XB_TOPGEN]) == tg, bar);
            __builtin_amdgcn_fence(__ATOMIC_ACQUIRE, "agent");
            xb_add(&bar[XB_XGEN(b.x)], 1u);
            asm volatile("s_waitcnt vmcnt(0)" ::: "memory");
        } else {
            XB_SPIN(xb_ld(&bar[XB_XGEN(b.x)]) == gen, bar);
            __builtin_amdgcn_fence(__ATOMIC_ACQUIRE, "agent");
            asm volatile("s_waitcnt vmcnt(0)" ::: "memory");
        }
    }
    __syncthreads();
}
#undef LAS
namespace cg = cooperative_groups;
#ifndef PG8_ALIGN1
#define PG8_ALIGN1 PG8_ALIGN
#endif
#ifndef PROBE_REP64
#define PROBE_REP64 1
#endif
#ifndef PROBE_REP128
#define PROBE_REP128 1
#endif
#ifndef NCHUNK_DEF
#define NCHUNK_DEF 3
#endif
constexpr int NWAVES = 8;
constexpr int SEQ = 8192, DM = 1024, MC = 16384  , NCHUNK = NCHUNK_DEF, NPROJ = 6656, DFF = 2816, NUP = 2 * DFF, PLE = 256;
constexpr int C_AQ = 0, C_AK = 1024, C_AV = 2048, C_BQ = 3072, C_BK = 4096, C_BV = 4352, C_GA = 4608, C_GB = 5632;
constexpr float EPS = 1e-6f;
constexpr float QSCALE = 0.125f * 1.4426950408889634f;
constexpr size_t MiB = 1u << 20;
constexpr size_t WS_SS = 420 * MiB;
constexpr size_t WS_TABA = 1 * MiB;
constexpr size_t WS_TABX = 1 * MiB + 512 * 1024;
constexpr size_t WS_WIN = 2 * MiB, WS_WA = 15 * MiB, WS_WB = 17 * MiB, WS_WOUT = 19 * MiB, WS_WUP = 21 * MiB, WS_WDN = 32 * MiB, WS_WPLE = 38 * MiB, WS_WPG = 39 * MiB;
constexpr size_t WS_XN = 42 * MiB;
constexpr size_t WS_PB = 74 * MiB;
constexpr size_t WS_PROJ = 82 * MiB;
constexpr size_t WS_U = WS_PROJ;
constexpr size_t WS_SG = WS_PROJ;
constexpr size_t WS_OA1 = 290 * MiB, WS_OA2 = 322 * MiB, WS_OB = 354 * MiB, WS_MG = WS_OA1  , WS_HS = 386 * MiB  ;
constexpr size_t WS_ACT = WS_OA1;
constexpr size_t WS_E = 424 * MiB;
constexpr size_t WS_XNB = 456 * MiB;
constexpr size_t WS_END = 488 * MiB;
constexpr int LDS_BYTES = 147456, MISC_OFF = 131072 + 320;
constexpr size_t WS_EPS = 1 * MiB + 800 * 1024;
constexpr size_t WS_BAR = 1 * MiB + 768 * 1024;

#define GAS __attribute__((address_space(1)))
#define LAS __attribute__((address_space(3)))
typedef unsigned short bf16_t;
typedef unsigned v4u __attribute__((ext_vector_type(4)));
typedef unsigned v2u __attribute__((ext_vector_type(2)));
typedef float f32x4 __attribute__((ext_vector_type(4)));
#define LDS_WAIT() asm volatile("s_waitcnt lgkmcnt(0)" ::: "memory")
__device__ __forceinline__ unsigned f2bf(float f) { unsigned u = __builtin_bit_cast(unsigned, f); return (u + 0x7fffu + ((u >> 16) & 1u)) >> 16; }
__device__ __forceinline__ unsigned pk2(float lo, float hi) { return f2bf(lo) | (f2bf(hi) << 16); }
__device__ __forceinline__ float wave_sum(float v, int lane) {
#pragma unroll
    for (int o = 1; o < 64; o <<= 1) v += shx(v, lane, o);
    return v;
}
__device__ __forceinline__ void unpack16(const v4u a, const v4u b, float (&x)[16]) {
    x[0] = pg8::bf_lo(a.x); x[1] = pg8::bf_hi(a.x); x[2] = pg8::bf_lo(a.y); x[3] = pg8::bf_hi(a.y); x[4] = pg8::bf_lo(a.z); x[5] = pg8::bf_hi(a.z); x[6] = pg8::bf_lo(a.w); x[7] = pg8::bf_hi(a.w);
    x[8] = pg8::bf_lo(b.x); x[9] = pg8::bf_hi(b.x); x[10] = pg8::bf_lo(b.y); x[11] = pg8::bf_hi(b.y); x[12] = pg8::bf_lo(b.z); x[13] = pg8::bf_hi(b.z); x[14] = pg8::bf_lo(b.w); x[15] = pg8::bf_hi(b.w);
}
__device__ __forceinline__ void pack16(const float (&x)[16], v4u& a, v4u& b) {
    a.x = pk2(x[0], x[1]); a.y = pk2(x[2], x[3]); a.z = pk2(x[4], x[5]); a.w = pk2(x[6], x[7]);
    b.x = pk2(x[8], x[9]); b.y = pk2(x[10], x[11]); b.z = pk2(x[12], x[13]); b.w = pk2(x[14], x[15]);
}

__device__ __forceinline__ void p0_transpose_item(const float* W, int K, int N, bf16_t* WT, LAS float* scr, int item, int lane, const float* kg = nullptr) {
    const int nblk = N / 32, kb = item / nblk, nb = item % nblk, k0 = 64 * kb, n0 = 32 * nb;
#pragma unroll 8
    for (int i = 0; i < 32; ++i) { const int kk = 2 * i + (lane >> 5); scr[kk * 33 + (lane & 31)] = W[(size_t)(k0 + kk) * N + n0 + (lane & 31)] * (kg ? kg[k0 + kk] : 1.0f); }
    LDS_WAIT(); asm volatile("" ::: "memory");
    const int c = lane & 7;
#pragma unroll
    for (int j = 0; j < 4; ++j) { const int n = (lane >> 3) + 8 * j; const LAS float* s = scr + (8 * c) * 33 + n;
        v4u o; o.x = pk2(s[0 * 33], s[1 * 33]); o.y = pk2(s[2 * 33], s[3 * 33]); o.z = pk2(s[4 * 33], s[5 * 33]); o.w = pk2(s[6 * 33], s[7 * 33]);
        *(GAS v4u*)(WT + (size_t)(n0 + n) * K + k0 + 8 * c) = o; }
    LDS_WAIT(); asm volatile("" ::: "memory");
}

struct Ctx {
    int vcu, G, wave_s;
};
__device__ __forceinline__ unsigned long long karg(int i) { const __attribute__((address_space(4))) unsigned long long* ka = (const __attribute__((address_space(4))) unsigned long long*)__builtin_amdgcn_kernarg_segment_ptr(); asm volatile("" : "+s"(ka)); return ka[i]; }
#define KIN(i) ((const float*)karg(i))
#define KOUT() ((float*)karg(25))
#define KWS() ((unsigned char*)karg(26))

__device__ __forceinline__ void phase_prologue(const Ctx& F, LAS unsigned char* lds) {
    int tid_ = F.wave_s * 64 + lane_id_v(); asm volatile("" : "+v"(tid_)); const int tid = tid_, lane = tid & 63, wave = F.wave_s, gw = F.vcu * NWAVES + wave, NGW = F.G * NWAVES; (void)lane; (void)gw; (void)NGW;
    unsigned char* const ws = KWS(); (void)ws;
    const int gt = F.vcu * (NWAVES * 64) + tid, NGT = F.G * NWAVES * 64;
    {
        float* tab = (float*)(ws + WS_TABA);
        for (int i = gt; i < SEQ * 8; i += NGT) { const int pos = i >> 3, k = i & 7;
            const float inv = k == 0 ? 1.0f : k == 1 ? 0.19392274474868576f : k == 2 ? 0.03760603093086393f : k == 3 ? 0.007292664737217109f : k == 4 ? 0.001414213562373095f : k == 5 ? 0.0002742481756762073f : k == 6 ? 5.318295896944988e-05f : 1.031338537721246e-05f;
            const float ang = (float)pos * inv; double rev = (double)ang * 0.15915494309189535; rev -= __builtin_floor(rev); const float r = (float)rev;
            tab[pos * 16 + k] = __builtin_amdgcn_cosf(r); tab[pos * 16 + 8 + k] = __builtin_amdgcn_sinf(r); }
    }
    {
        float* tab = (float*)(ws + WS_TABX);
        for (int i = gt; i < 128 * 16; i += NGT) { const int pos = i >> 4, k = i & 15;
            const float inv = __builtin_amdgcn_exp2f(-(float)k * (13.287712379549449f / 16.0f));
            const float ang = (float)pos * inv; double rev = (double)ang * 0.15915494309189535; rev -= __builtin_floor(rev); const float r = (float)rev;
            tab[pos * 32 + k] = __builtin_amdgcn_cosf(r); tab[pos * 32 + 16 + k] = __builtin_amdgcn_sinf(r); }
    }
    LAS float* scr = (LAS float*)(lds + wave * 16384);
    constexpr int I_IN = (DM / 64) * (NPROJ / 32), I_SQ = (DM / 64) * (DM / 32), I_UP = (DM / 64) * (NUP / 32), I_DN = (DFF / 64) * (DM / 32), I_PLE = (PLE / 64) * (DM / 32);
    constexpr int NITEMS = I_IN + 4 * I_SQ + I_UP + I_DN + I_PLE;
    for (int it = gw; it < NITEMS; it += NGW) {
        int r = it;
        if (r < I_IN) { p0_transpose_item(KIN(5), DM, NPROJ, (bf16_t*)(ws + WS_WIN), scr, r, lane); continue; } r -= I_IN;
        if (r < I_SQ) { p0_transpose_item(KIN(11), DM, DM, (bf16_t*)(ws + WS_WA), scr, r, lane); continue; } r -= I_SQ;
        if (r < I_SQ) { p0_transpose_item(KIN(14), DM, DM, (bf16_t*)(ws + WS_WB), scr, r, lane); continue; } r -= I_SQ;
        if (r < I_SQ) { p0_transpose_item(KIN(15), DM, DM, (bf16_t*)(ws + WS_WOUT), scr, r, lane); continue; } r -= I_SQ;
        if (r < I_SQ) { p0_transpose_item(KIN(23), DM, DM, (bf16_t*)(ws + WS_WPG), scr, r, lane, KIN(22)); continue; } r -= I_SQ;
        if (r < I_UP) { p0_transpose_item(KIN(17), DM, NUP, (bf16_t*)(ws + WS_WUP), scr, r, lane, KIN(16)); continue; } r -= I_UP;
        if (r < I_DN) { p0_transpose_item(KIN(20), DFF, DM, (bf16_t*)(ws + WS_WDN), scr, r, lane); continue; } r -= I_DN;
        p0_transpose_item(KIN(21), PLE, DM, (bf16_t*)(ws + WS_WPLE), scr, r, lane);
    }
}

__device__ __forceinline__ void phase_prep(const Ctx& F, const float* x, const float* p) {
    int tid_ = F.wave_s * 64 + lane_id_v(); asm volatile("" : "+v"(tid_)); const int tid = tid_, lane = tid & 63, wave = F.wave_s, gw = F.vcu * NWAVES + wave, NGW = F.G * NWAVES; (void)lane; (void)gw; (void)NGW;
    unsigned char* const ws = KWS(); (void)ws;
    const float* g = KIN(4);
    bf16_t* XN = (bf16_t*)(ws + WS_XN); bf16_t* PB = (bf16_t*)(ws + WS_PB);
    f32x4 gv[4];
#pragma unroll
    for (int j = 0; j < 4; ++j) gv[j] = ((const f32x4*)g)[lane + 64 * j];
    for (int m0 = gw * 4; m0 < MC; m0 += NGW * 4) {
        f32x4 v[4][4], pv[4];
#pragma unroll
        for (int r = 0; r < 4; ++r) { const f32x4* xr = (const f32x4*)(x + (size_t)(m0 + r) * DM) + lane;
#pragma unroll
            for (int j = 0; j < 4; ++j) v[r][j] = xr[64 * j];
            pv[r] = ((const f32x4*)(p + (size_t)(m0 + r) * PLE))[lane]; }
#pragma unroll
        for (int r = 0; r < 4; ++r) { float s = 0.f;
#pragma unroll
            for (int j = 0; j < 4; ++j) s += (v[r][j].x * v[r][j].x + v[r][j].y * v[r][j].y) + (v[r][j].z * v[r][j].z + v[r][j].w * v[r][j].w);
            const float rstd = __builtin_amdgcn_rsqf(wave_sum(s, lane) * (1.f / DM) + EPS);
            v2u* o8 = (v2u*)(XN + (size_t)(m0 + r) * DM) + lane;
#pragma unroll
            for (int j = 0; j < 4; ++j) { const f32x4 y = v[r][j] * rstd * gv[j]; v2u w; w.x = pk2(y.x, y.y); w.y = pk2(y.z, y.w); o8[64 * j] = w; }
            { v2u w; w.x = pk2(pv[r].x, pv[r].y); w.y = pk2(pv[r].z, pv[r].w); ((v2u*)(PB + (size_t)(m0 + r) * PLE))[lane] = w; } }
    }
}

__device__ __forceinline__ void phase_rope(const Ctx& F) {
    int tid_ = F.wave_s * 64 + lane_id_v(); asm volatile("" : "+v"(tid_)); const int tid = tid_, lane = tid & 63, wave = F.wave_s, gw = F.vcu * NWAVES + wave, NGW = F.G * NWAVES; (void)lane; (void)gw; (void)NGW;
    unsigned char* const ws = KWS(); (void)ws;
    bf16_t* PROJ = (bf16_t*)(ws + WS_PROJ);
    const float* tabA = (const float*)(ws + WS_TABA); const float* tabX = (const float*)(ws + WS_TABX);
    const int q4 = lane & 3;
    float gq[16], gk[16];
#pragma unroll
    for (int k = 0; k < 16; ++k) { gq[k] = KIN(12)[q4 * 16 + k]; gk[k] = KIN(13)[q4 * 16 + k]; }
    const float sgn = (q4 & 1) ? 1.f : -1.f;
    for (int m = gw; m < MC; m += NGW) {
        const int t = m & (SEQ - 1);
        bf16_t* row = PROJ + (size_t)m * NPROJ;
        v4u* paq = (v4u*)(row + C_AQ + (lane & ~3) * 16); v4u* pak = (v4u*)(row + C_AK + (lane & ~3) * 16); v4u* pbq = (v4u*)(row + C_BQ + lane * 16); v4u* pbk = (v4u*)(row + C_BK + (lane & 15) * 16);
        v4u aq0 = paq[0], aq1 = paq[1], ak0 = pak[0], ak1 = pak[1], bq0 = pbq[0], bq1 = pbq[1], bk0 = pbk[0], bk1 = pbk[1];
        float c8[8], s8[8], cx[16], sx[16];
        { const f32x4* tp = (const f32x4*)(tabA + t * 16); const f32x4 a = tp[0], b = tp[1], c = tp[2], d = tp[3];
          c8[0] = a.x; c8[1] = a.y; c8[2] = a.z; c8[3] = a.w; c8[4] = b.x; c8[5] = b.y; c8[6] = b.z; c8[7] = b.w;
          s8[0] = c.x; s8[1] = c.y; s8[2] = c.z; s8[3] = c.w; s8[4] = d.x; s8[5] = d.y; s8[6] = d.z; s8[7] = d.w; }
        { const int pos = (q4 < 2) ? (t >> 6) : (t & 63); const f32x4* tp = (const f32x4*)(tabX + pos * 32);
#pragma unroll
          for (int j = 0; j < 4; ++j) { const f32x4 a = tp[j], b = tp[4 + j]; cx[4 * j] = a.x; cx[4 * j + 1] = a.y; cx[4 * j + 2] = a.z; cx[4 * j + 3] = a.w; sx[4 * j] = b.x; sx[4 * j + 1] = b.y; sx[4 * j + 2] = b.z; sx[4 * j + 3] = b.w; } }
        asm volatile("" ::: "memory");
        if (q4 == 0) {
            float x[16]; unpack16(aq0, aq1, x);
#pragma unroll
            for (int i = 0; i < 8; ++i) { const float x1 = x[i], x2 = x[8 + i]; x[i] = x1 * c8[i] - x2 * s8[i]; x[8 + i] = x2 * c8[i] + x1 * s8[i]; }
            pack16(x, aq0, aq1); paq[0] = aq0; paq[1] = aq1;
        }
        {
            float x[16]; unpack16(ak0, ak1, x);
#pragma unroll
            for (int i = 0; i < 8; ++i) { const float x1 = x[i], x2 = x[8 + i]; x[i] = x1 * c8[i] - x2 * s8[i]; x[8 + i] = x2 * c8[i] + x1 * s8[i]; }
            if (q4 == 0) { pack16(x, ak0, ak1); pak[0] = ak0; pak[1] = ak1; }
        }
        {
            float x[16]; unpack16(bq0, bq1, x);
            float sq = 0.f;
#pragma unroll
            for (int i = 0; i < 16; ++i) sq += x[i] * x[i];
            sq += shx(sq, lane, 1); sq += shx(sq, lane, 2);
            const float r = __builtin_amdgcn_rsqf(sq * (1.f / 64.f) + EPS);
#pragma unroll
            for (int i = 0; i < 16; ++i) x[i] = x[i] * r * gq[i];
#pragma unroll
            for (int i = 0; i < 16; ++i) { const float o = shx(x[i], lane, 1); x[i] = (x[i] * cx[i] + sgn * o * sx[i]) * QSCALE; }
            pack16(x, bq0, bq1); pbq[0] = bq0; pbq[1] = bq1;
        }
        {
            float x[16]; unpack16(bk0, bk1, x);
            float sq = 0.f;
#pragma unroll
            for (int i = 0; i < 16; ++i) sq += x[i] * x[i];
            sq += shx(sq, lane, 1); sq += shx(sq, lane, 2);
            const float r = __builtin_amdgcn_rsqf(sq * (1.f / 64.f) + EPS);
#pragma unroll
            for (int i = 0; i < 16; ++i) x[i] = x[i] * r * gk[i];
#pragma unroll
            for (int i = 0; i < 16; ++i) { const float o = shx(x[i], lane, 1); x[i] = x[i] * cx[i] + sgn * o * sx[i]; }
            if (lane < 16) { pack16(x, bk0, bk1); pbk[0] = bk0; pbk[1] = bk1; }
        }
    }
}

__device__ __forceinline__ void phase_attn(const Ctx& F, char* lds) {
    using abf = attn_body::bf16;
    unsigned char* const ws = KWS();
    abf* PROJ = (abf*)(ws + WS_PROJ); abf* OA1 = (abf*)(ws + WS_OA1); abf* OB = (abf*)(ws + WS_OB);
    float lam;
    { const int lane = lane_id_v(); const float s1 = wave_sum(KIN(6)[lane] * KIN(7)[lane], lane), s2 = wave_sum(KIN(8)[lane] * KIN(9)[lane], lane); lam = __expf(s1) - __expf(s2) + 0.2f; }
    const float* gdiff = KIN(10);
    if (F.wave_s >= 4) __builtin_amdgcn_s_setprio(1);
    for (int i = 0;; ++i) {
        const int L = i * F.G + F.vcu; if (L >= 1536) break;
        if (L < 1024) { for (int rep = 0; rep < PROBE_REP64; ++rep) { const int i4 = (L >> 8) & 3, v = L & 255, g = v >> 3, s = v & 7, qb = i4 * 8 + s;
            const int qd = g >> 2, mem = g & 3, b = qd >> 2, kvh = qd & 3, qh = kvh * 4 + mem; const size_t r0 = (size_t)b * SEQ;
            attn_body::attn_unit<8>(qb, PROJ + r0 * NPROJ + C_BQ + qh * 64, PROJ + r0 * NPROJ + C_BK + kvh * 64, PROJ + r0 * NPROJ + C_BV + kvh * 64, OB + r0 * DM + qh * 64, NPROJ, NPROJ, NPROJ, DM, lds, F.wave_s); }
        } else { for (int rep = 0; rep < PROBE_REP128; ++rep) { const int idx = L - 1024, i4 = idx >> 8, v = idx & 255, g = v >> 3, s = v & 7;
            const int bh = g >> 1, qb = (g & 1) * 16 + i4 * 8 + s, b = bh >> 3, h = bh & 7; const size_t r0 = (size_t)b * SEQ;
            attn128::attn128_unit(qb, PROJ + r0 * NPROJ + C_AQ + h * 128, PROJ + r0 * NPROJ + C_AK + h * 128, PROJ + r0 * NPROJ + C_AV + h * 128, OA1 + r0 * DM + h * 128, NPROJ, NPROJ, NPROJ, DM, lds, F.wave_s, lam, gdiff); } }
    }
    __builtin_amdgcn_s_setprio(0);
}

__device__ __forceinline__ void phase_diffnorm(const Ctx& F) {
    int tid_ = F.wave_s * 64 + lane_id_v(); asm volatile("" : "+v"(tid_)); const int tid = tid_, lane = tid & 63, wave = F.wave_s, gw = F.vcu * NWAVES + wave, NGW = F.G * NWAVES; (void)lane; (void)gw; (void)NGW;
    unsigned char* const ws = KWS(); (void)ws;
    bf16_t* OA1 = (bf16_t*)(ws + WS_OA1); const bf16_t* OA2 = (const bf16_t*)(ws + WS_OA2);
    const float s1 = wave_sum(KIN(6)[lane] * KIN(7)[lane], lane), s2 = wave_sum(KIN(8)[lane] * KIN(9)[lane], lane);
    const float lam = __expf(s1) - __expf(s2) + 0.2f;
    float gd[16];
#pragma unroll
    for (int k = 0; k < 16; ++k) gd[k] = KIN(10)[(lane & 7) * 16 + k] * 0.8f;
    for (int m0 = gw * 4; m0 < MC; m0 += NGW * 4) {
        v4u a[4], b[4], c[4], d[4];
#pragma unroll
        for (int r = 0; r < 4; ++r) { const v4u* pp = (const v4u*)(OA1 + (size_t)(m0 + r) * DM + lane * 16); const v4u* p2 = (const v4u*)(OA2 + (size_t)(m0 + r) * DM + lane * 16); a[r] = pp[0]; b[r] = pp[1]; c[r] = p2[0]; d[r] = p2[1]; }
        asm volatile("" ::: "memory");
#pragma unroll
        for (int r = 0; r < 4; ++r) {
            float x[16], y[16]; unpack16(a[r], b[r], x); unpack16(c[r], d[r], y);
            float s = 0.f;
#pragma unroll
            for (int i = 0; i < 16; ++i) { x[i] = x[i] - lam * y[i]; s += x[i] * x[i]; }
            s += shx(s, lane, 1); s += shx(s, lane, 2); s += shx(s, lane, 4);
            const float rr = __builtin_amdgcn_rsqf(s * (1.f / 128.f) + EPS);
#pragma unroll
            for (int i = 0; i < 16; ++i) x[i] = x[i] * rr * gd[i];
            v4u oa, ob; pack16(x, oa, ob); v4u* pp = (v4u*)(OA1 + (size_t)(m0 + r) * DM + lane * 16); pp[0] = oa; pp[1] = ob;
        }
    }
}

__device__ __forceinline__ float gelu_tanh(float x) { const float u = x + 0.044715f * x * x * x; return x * __builtin_amdgcn_rcpf(1.0f + __builtin_amdgcn_exp2f(-2.302208198f * u)); }
__device__ __forceinline__ void up8(const v4u a, float (&x)[8]) { x[0] = pg8::bf_lo(a.x); x[1] = pg8::bf_hi(a.x); x[2] = pg8::bf_lo(a.y); x[3] = pg8::bf_hi(a.y); x[4] = pg8::bf_lo(a.z); x[5] = pg8::bf_hi(a.z); x[6] = pg8::bf_lo(a.w); x[7] = pg8::bf_hi(a.w); }
__device__ __forceinline__ void phase_conv(const Ctx& F) {
    int tid_ = F.wave_s * 64 + lane_id_v(); asm volatile("" : "+v"(tid_)); const int tid = tid_, lane = tid & 63, wave = F.wave_s, gw = F.vcu * NWAVES + wave, NGW = F.G * NWAVES; (void)lane; (void)gw; (void)NGW;
    unsigned char* const ws = KWS(); (void)ws;
    const bf16_t* U = (const bf16_t*)(ws + WS_U); bf16_t* ACT = (bf16_t*)(ws + WS_ACT);
    const float* cw = KIN(18); const float* cb = KIN(19);
    constexpr int NCG = DFF / 8, RUN = 8, NRUN = MC / RUN;
    if (tid < NCG) {
        const int ch0 = tid * 8;
        float wg[3][8], wv[3][8], bg[8], bv[8];
#pragma unroll
        for (int k = 0; k < 3; ++k) { const f32x4 a = *(const f32x4*)(cw + k * NUP + ch0), b = *(const f32x4*)(cw + k * NUP + ch0 + 4), c = *(const f32x4*)(cw + k * NUP + DFF + ch0), d = *(const f32x4*)(cw + k * NUP + DFF + ch0 + 4);
            wg[k][0] = a.x; wg[k][1] = a.y; wg[k][2] = a.z; wg[k][3] = a.w; wg[k][4] = b.x; wg[k][5] = b.y; wg[k][6] = b.z; wg[k][7] = b.w;
            wv[k][0] = c.x; wv[k][1] = c.y; wv[k][2] = c.z; wv[k][3] = c.w; wv[k][4] = d.x; wv[k][5] = d.y; wv[k][6] = d.z; wv[k][7] = d.w; }
        { const f32x4 a = *(const f32x4*)(cb + ch0), b = *(const f32x4*)(cb + ch0 + 4), c = *(const f32x4*)(cb + DFF + ch0), d = *(const f32x4*)(cb + DFF + ch0 + 4);
          bg[0] = a.x; bg[1] = a.y; bg[2] = a.z; bg[3] = a.w; bg[4] = b.x; bg[5] = b.y; bg[6] = b.z; bg[7] = b.w; bv[0] = c.x; bv[1] = c.y; bv[2] = c.z; bv[3] = c.w; bv[4] = d.x; bv[5] = d.y; bv[6] = d.z; bv[7] = d.w; }
        for (int run = F.vcu; run < NRUN; run += F.G) {
            const int t0 = run * RUN; const bool first = (t0 & (SEQ - 1)) == 0, last = ((t0 + RUN) & (SEQ - 1)) == 0;
            const bf16_t* up = U + (size_t)t0 * NUP + ch0;
            v4u rg[RUN + 2], rv[RUN + 2];
#pragma unroll
            for (int i = 0; i < RUN + 2; ++i) { const bool z = (i == 0 && first) || (i == RUN + 1 && last);
                if (z) { rg[i] = (v4u){0u, 0u, 0u, 0u}; rv[i] = rg[i]; } else { rg[i] = *(const v4u*)(up + (long)(i - 1) * NUP); rv[i] = *(const v4u*)(up + (long)(i - 1) * NUP + DFF); } }
            asm volatile("" ::: "memory");
#pragma unroll
            for (int i = 0; i < RUN; ++i) {
                float pg_[8], cg_[8], ng_[8], pv_[8], cv_[8], nv_[8], o[8];
                up8(rg[i], pg_); up8(rg[i + 1], cg_); up8(rg[i + 2], ng_); up8(rv[i], pv_); up8(rv[i + 1], cv_); up8(rv[i + 2], nv_);
#pragma unroll
                for (int k = 0; k < 8; ++k) { const float ug = pg_[k] * wg[0][k] + cg_[k] * wg[1][k] + ng_[k] * wg[2][k] + bg[k]; const float uv = pv_[k] * wv[0][k] + cv_[k] * wv[1][k] + nv_[k] * wv[2][k] + bv[k]; o[k] = gelu_tanh(ug) * uv; }
                v4u w; w.x = pk2(o[0], o[1]); w.y = pk2(o[2], o[3]); w.z = pk2(o[4], o[5]); w.w = pk2(o[6], o[7]);
                *(v4u*)(ACT + (size_t)(t0 + i) * DFF + ch0) = w;
            }
        }
    }
}

__device__ __forceinline__ void phase_final(const Ctx& F, float* out, const float* ss3, const float oscale) {
    int tid_ = F.wave_s * 64 + lane_id_v(); asm volatile("" : "+v"(tid_)); const int tid = tid_, lane = tid & 63, wave = F.wave_s, gw = F.vcu * NWAVES + wave, NGW = F.G * NWAVES; (void)lane; (void)gw; (void)NGW;
    unsigned char* const ws = KWS(); (void)ws;
    const float* g = KIN(24); const bf16_t* hs = (const bf16_t*)(ws + WS_XNB);
    f32x4 gv[4];
#pragma unroll
    for (int j = 0; j < 4; ++j) gv[j] = ((const f32x4*)g)[lane + 64 * j];
    for (int m0 = gw * 4; m0 < MC; m0 += NGW * 4) {
        v2u v[4][4]; float rs[4];
#pragma unroll
        for (int r = 0; r < 4; ++r) { const v2u* xr = (const v2u*)(hs + (size_t)(m0 + r) * DM) + lane; { const f32x4* sp = (const f32x4*)(ss3 + (size_t)(m0 + r) * 16); const f32x4 sa = (sp[0] + sp[1]) + (sp[2] + sp[3]); rs[r] = (sa[0] + sa[1]) + (sa[2] + sa[3]); }
#pragma unroll
            for (int j = 0; j < 4; ++j) v[r][j] = xr[64 * j]; }
        asm volatile("" ::: "memory");
#pragma unroll
        for (int r = 0; r < 4; ++r) { f32x4* xr = (f32x4*)(out + (size_t)(m0 + r) * DM) + lane; const float rr = __builtin_amdgcn_rsqf(rs[r] * (1.f / DM) + EPS) * oscale;
#pragma unroll
            for (int j = 0; j < 4; ++j) { const f32x4 h = (f32x4){pg8::bf_lo(v[r][j].x), pg8::bf_hi(v[r][j].x), pg8::bf_lo(v[r][j].y), pg8::bf_hi(v[r][j].y)}; xr[64 * j] = h * rr * gv[j]; } }
    }
}

struct Args { const float* in[25]; float* out; unsigned char* ws; };

#ifndef PROBE_GB
#define PROBE_GB 1
#endif
#ifndef PROBE_GF
#define PROBE_GF 1
#endif
#ifndef PROBE_GG
#define PROBE_GG 1
#endif
#ifndef PROBE_GI
#define PROBE_GI 1
#endif
#ifndef PROBE_GL
#define PROBE_GL 1
#endif
#ifndef PROBE_CONV
#define PROBE_CONV 1
#endif
#ifndef PROBE_PRO
#define PROBE_PRO 1
#endif
#ifndef PROBE_PREP
#define PROBE_PREP 1
#endif
#ifndef PROBE_TS
#define PROBE_TS 0
#endif
#ifndef PROBE_TSCALE
#define PROBE_TSCALE 2000
#endif
#if PROBE_TS
#define TS_PTR() ((volatile LAS unsigned long long*)((LAS unsigned char*)lds + MISC_OFF + 64))
#define STAMP(k) do { if (gbar.leader && blockIdx.x == 0) { volatile LAS unsigned long long* T_ = TS_PTR(); const unsigned long long t_ = __builtin_amdgcn_s_memrealtime(); if ((k) >= 0 && ((PROBE_TS >> (k)) & 1)) T_[1] += t_ - T_[0]; T_[0] = t_; } } while (0)
#define TS_PUBLISH() do { if (gbar.leader && blockIdx.x == 0) { const float us_ = (float)TS_PTR()[1] * 0.01f; const float b_ = __builtin_rintf(__builtin_log2f(us_ < 1.f ? 1.f : us_) * 2.6419f); *(volatile float*)(KWS() + WS_EPS) = b_ * (1.0f / 64.0f); } } while (0)
#else
#define STAMP(k) do {} while (0)
#define TS_PUBLISH() do {} while (0)
#endif
#ifndef PROBE_ATTNPH
#define PROBE_ATTNPH 1
#endif
#ifndef PROBE_GK
#define PROBE_GK 1
#endif
#ifndef PROBE_GH
#define PROBE_GH 1
#endif
#ifndef PROBE_BARX
#define PROBE_BARX 1
#endif
#define GBAR() do { for (int rep_ = 0; rep_ < PROBE_BARX; ++rep_) xcd_barrier(gbar); } while (0)
template <int c> __device__ __forceinline__ void run_chunk(const Ctx& F, unsigned char* lds, const XcdBarrier& gbar) {
    LAS unsigned char* L = (LAS unsigned char*)lds;
    const int bid = (int)blockIdx.x;
#define WSP(T, off) ((T*)(ws + (off)))
#define XC() ((c == 0) ? KIN(0) : KIN(1) + (size_t)(c - 1) * MC * DM)
#define OUTC() (KOUT() + (size_t)c * MC * DM)
#define SSP(k) ((float*)(ws + WS_SS) + (size_t)(k) * MC * 16)
#ifndef SKIP_GB
        for (int rep_ = 0; rep_ < PROBE_GB; ++rep_) {
            unsigned char* const ws = KWS(); pg8::Gemm g{WSP(bf16_t, WS_XN), (const bf16_t*)(ws + WS_WIN), MC, NPROJ, DM}; pg8::StaticOrder S; S.init(MC, NPROJ, F.G, bid);
            pg8::EpiProj E{WSP(bf16_t, WS_PROJ), NPROJ, C_GA / 256, C_AK / 256, QSCALE};
            pg8::gemm_phase<pg8::EpiProj, pg8::StaticOrder, PG8_ALIGN, PG8_SP2>(L, g, S, E, F.wave_s);
        }
#endif
        {
            const int extra = ((MC / 256) * (NPROJ / 256)) % F.G, gE = extra ? F.G - extra : F.G, cE = extra ? bid - extra : bid;
            if (cE >= 0) {
            unsigned char* const ws = KWS(); pg8::Gemm g{WSP(bf16_t, WS_PB), (const bf16_t*)(ws + WS_WPLE), MC, DM, PLE}; pg8::StaticOrder S; S.init(MC, DM, gE, cE);
            pg8::EpiProj E{WSP(bf16_t, WS_E), DM, 1 << 20, 0, 1.0f};
            pg8::gemm_phase<pg8::EpiProj, pg8::StaticOrder, PG8_ALIGN, PG8_SP2>(L, g, S, E, F.wave_s);
            }
        }
#ifndef SKIP_EW
        if (c > 0) { unsigned char* const ws = KWS(); phase_final(F, KOUT() + (size_t)(c - 1) * MC * DM, SSP(2), 1.0f); }
#endif
        GBAR(); STAMP(1);
#ifndef SKIP_EW
        phase_rope(F);
        if (c + 1 < NCHUNK) { for (int rep_ = 0; rep_ < PROBE_PREP; ++rep_) phase_prep(F, KIN(1) + (size_t)c * MC * DM, KIN(3) + (size_t)c * MC * PLE); }
#endif
        GBAR(); STAMP(2);
#ifndef SKIP_ATTN
        for (int rep_ = 1; rep_ < PROBE_ATTNPH; ++rep_) { phase_attn(F, (char*)lds); xcd_barrier(gbar); }
        phase_attn(F, (char*)lds);
#endif
        GBAR(); STAMP(3);
#ifndef SKIP_GF
        for (int rep_ = 0; rep_ < PROBE_GF; ++rep_) {
            unsigned char* const ws = KWS(); pg8::Gemm g{WSP(bf16_t, WS_OA1), (const bf16_t*)(ws + WS_WA), MC, DM, DM}; pg8::StaticOrder S; S.init(MC, DM, F.G, bid);
            pg8::EpiT1 E{WSP(bf16_t, WS_PROJ) + C_GA, NPROJ, WSP(bf16_t, WS_OA2), DM};
            pg8::gemm_phase<pg8::EpiT1, pg8::StaticOrder, PG8_ALIGN1, PG8_SP2>(L, g, S, E, F.wave_s);
        }
#endif
        GBAR(); STAMP(5);
#ifndef SKIP_GG
        for (int rep_ = 0; rep_ < PROBE_GG; ++rep_) {
            unsigned char* const ws = KWS(); pg8::Gemm g{WSP(bf16_t, WS_OB), (const bf16_t*)(ws + WS_WB), MC, DM, DM}; pg8::StaticOrder S; S.init(MC, DM, F.G, bid);
            pg8::EpiMerge E{WSP(bf16_t, WS_PROJ) + C_GB, NPROJ, WSP(bf16_t, WS_OA2), DM, WSP(bf16_t, WS_MG), DM};
            pg8::gemm_phase<pg8::EpiMerge, pg8::StaticOrder, PG8_ALIGN1, PG8_SP2>(L, g, S, E, F.wave_s);
        }
#endif
        GBAR(); STAMP(6);
#ifndef SKIP_GH
        for (int rep_ = 0; rep_ < PROBE_GH; ++rep_) {
            unsigned char* const ws = KWS(); pg8::Gemm g{WSP(bf16_t, WS_MG), (const bf16_t*)(ws + WS_WOUT), MC, DM, DM}; pg8::StaticOrder S; S.init(MC, DM, F.G, bid);
            pg8::EpiResidB<false> E{XC(), WSP(bf16_t, WS_HS), SSP(0), DM};
            pg8::gemm_phase<pg8::EpiResidB<false>, pg8::StaticOrder, PG8_ALIGN1, PG8_SP2>(L, g, S, E, F.wave_s);
        }
#endif
        GBAR(); STAMP(7);
#ifndef SKIP_GI
        for (int rep_ = 0; rep_ < PROBE_GI; ++rep_) {
            unsigned char* const ws = KWS(); pg8::Gemm g{WSP(bf16_t, WS_HS), (const bf16_t*)(ws + WS_WUP), MC, NUP, DM}; pg8::StaticOrder S; S.init(MC, NUP, F.G, bid);
            pg8::EpiScale<false> E{SSP(0), 1.f / DM, EPS, WSP(bf16_t, WS_U), nullptr, NUP};
            pg8::gemm_phase<pg8::EpiScale<false>, pg8::StaticOrder, PG8_ALIGN, PG8_SP2>(L, g, S, E, F.wave_s);
        }
#endif
        GBAR(); STAMP(8);
#ifndef SKIP_CONV
        for (int rep_ = 0; rep_ < PROBE_CONV; ++rep_) phase_conv(F);
#endif
        GBAR(); STAMP(9);
#ifndef SKIP_GK
        {
            unsigned char* const ws = KWS(); pg8::Gemm g{WSP(bf16_t, WS_ACT), (const bf16_t*)(ws + WS_WDN), MC, DM, DFF}; pg8::StaticOrder S; S.init(MC, DM, F.G, bid);
            pg8::EpiResidB<true> E{WSP(bf16_t, WS_HS), WSP(bf16_t, WS_HS), SSP(1), DM};
            pg8::gemm_phase<pg8::EpiResidB<true>, pg8::StaticOrder, PG8_ALIGN1, PG8_SP2>(L, g, S, E, F.wave_s);
        }
#endif
        GBAR(); STAMP(10);
#ifndef SKIP_GL
        {
            unsigned char* const ws = KWS(); pg8::Gemm g{WSP(bf16_t, WS_HS), (const bf16_t*)(ws + WS_WPG), MC, DM, DM}; pg8::StaticOrder S; S.init(MC, DM, F.G, bid);
            pg8::EpiPle E{SSP(1), 1.f / DM, EPS, WSP(bf16_t, WS_E), WSP(bf16_t, WS_HS), WSP(bf16_t, WS_XNB), SSP(2), DM};
            pg8::gemm_phase<pg8::EpiPle, pg8::StaticOrder, PG8_ALIGN1, PG8_SP2>(L, g, S, E, F.wave_s);
        }
#endif
        GBAR(); STAMP(11); if (c == NCHUNK - 1) TS_PUBLISH();
#ifndef SKIP_EW
        if (c == NCHUNK - 1) { unsigned char* const ws = KWS(); phase_final(F, OUTC(), SSP(2), (PROBE_TS && c == NCHUNK - 1) ? 1.0f + *(const float*)(ws + WS_EPS) : 1.0f); }
#endif
}

__global__ void __launch_bounds__(NWAVES * 64, 2) mk_fwd(Args args) {
    extern __shared__ __attribute__((aligned(16))) unsigned char lds[];
    cg::grid_group grid = cg::this_grid();
    Ctx F;
    F.wave_s = __builtin_amdgcn_readfirstlane((int)threadIdx.x >> 6);
    if (threadIdx.x < 32) ((volatile LAS unsigned*)((LAS unsigned char*)lds + MISC_OFF))[threadIdx.x] = 0u;
    __syncthreads();
    const XcdBarrier gbar = xcd_barrier_post((unsigned*)(KWS() + WS_BAR), (volatile LAS unsigned*)((LAS unsigned char*)lds + MISC_OFF) + 8, threadIdx.x == 0);
    F.G = gridDim.x; { const int bx = blockIdx.x; F.vcu = (F.G % 8 == 0) ? (bx % 8) * (F.G / 8) + bx / 8 : bx; }
    (void)args;
    LAS unsigned char* L = (LAS unsigned char*)lds;
#ifndef SKIP_EW
    STAMP(-1);
    for (int rep_ = 0; rep_ < PROBE_PRO; ++rep_) phase_prologue(F, L);
    for (int rep_ = 0; rep_ < PROBE_PREP; ++rep_) phase_prep(F, KIN(0), KIN(2));
#endif
    grid.sync(); STAMP(0);
    run_chunk<0>(F, lds, gbar);
#ifndef ONE_CHUNK
    run_chunk<1>(F, lds, gbar);
    run_chunk<2>(F, lds, gbar);
#endif
}

extern "C" void kernel_launch(void* const* d_in, const int* in_sizes, int n_in, void* d_out, int out_size, void* d_ws, size_t ws_size, hipStream_t stream) {
    static int grid = 0;
    if (grid == 0) {
        if (n_in != 25 || ws_size < WS_END) { fprintf(stderr, "kernel_launch: unexpected inputs (n_in %d, ws %zu)\n", n_in, ws_size); grid = -1; return; }
        int dev = 0, cus = 0, per_cu = 0;
        hipGetDevice(&dev); hipDeviceGetAttribute(&cus, hipDeviceAttributeMultiprocessorCount, dev);
        hipFuncSetAttribute((const void*)mk_fwd, hipFuncAttributeMaxDynamicSharedMemorySize, LDS_BYTES);
        hipOccupancyMaxActiveBlocksPerMultiprocessor(&per_cu, (const void*)mk_fwd, NWAVES * 64, LDS_BYTES);
        (void)hipGetLastError();
        if (per_cu < 1) per_cu = 1;
        grid = cus;
    }
    if (grid < 0) return;
    if (hipMemsetAsync((char*)d_ws + WS_BAR, 0, 16384, stream) != hipSuccess) { fprintf(stderr, "kernel_launch: memset failed\n"); return; }
    Args a{};
    for (int i = 0; i < 25; ++i) a.in[i] = (const float*)d_in[i];
    a.out = (float*)d_out; a.ws = (unsigned char*)d_ws;
    void* kargs[] = {&a};
    hipError_t e = hipLaunchCooperativeKernel((const void*)mk_fwd, dim3(grid), dim3(NWAVES * 64), kargs, LDS_BYTES, stream);
    if (e != hipSuccess) fprintf(stderr, "cooperative launch failed: %s (grid %d)\n", hipGetErrorString(e), grid);
}
```

```cpp
#include <hip/hip_runtime.h>
#include <hip/hip_cooperative_groups.h>
#include <cstdio>
#include <cstdint>
__device__ __forceinline__ int lane_id_v() { int l; asm volatile("v_mbcnt_lo_u32_b32 %0, -1, 0\n\tv_mbcnt_hi_u32_b32 %0, -1, %0" : "=v"(l)); return l; }
__device__ __forceinline__ float shx(float v, int lane, int m) { return __int_as_float(__builtin_amdgcn_ds_bpermute((lane ^ m) << 2, __float_as_int(v))); }
namespace pg8 {
#define PG8_LAS __attribute__((address_space(3)))
typedef unsigned short bf16_t;
typedef short bf16x8 __attribute__((ext_vector_type(8)));
typedef float f32x4 __attribute__((ext_vector_type(4)));
typedef unsigned u32x4 __attribute__((ext_vector_type(4)));
constexpr int BM = 256, BK = 64, HALF = 128, HTB = HALF * BK * 2  , STAGE_BYTES = 8 * HTB, NXCD = 8, WGM = 8;

__host__ __device__ __forceinline__ int lds_byte(int r, int c) { const int st = (r >> 4) * 2 + (c >> 5), rr = r & 15, cc = c & 31, ob = rr * 64 + cc * 2; return st * 1024 + (ob ^ (((ob >> 9) & 1) << 5)); }
__host__ __device__ __forceinline__ void stage_rc(int b, int& R, int& C) { const int st = b / 1024, sb = b % 1024, swz = sb ^ (((sb >> 9) & 1) << 5); R = (st >> 1) * 16 + swz / 64; C = (st & 1) * 32 + (swz % 64) / 2; }
__host__ __device__ __forceinline__ int perm32(int rho) { const int n = rho >> 4, i = rho & 15; return 8 * (i >> 2) + 4 * n + (i & 3); }

struct Unit { int pm, pn; };
struct Gemm { const bf16_t* A; const bf16_t* Bt; int M, N, K; };

struct StaticOrder {
    int nM, nN, nwg, G, c;
    __host__ __device__ void init(int M, int N, int G_, int c_) { nM = M / BM; nN = N / BM; nwg = nM * nN; G = G_; c = c_; }
    __host__ __device__ bool next(int i, Unit& u) const {
        const long L = (long)i * G + c; if (L >= nwg) return false;
        int wgid = (int)L; { const int q = nwg / NXCD, r = nwg % NXCD, xcd = wgid % NXCD, off = wgid / NXCD; wgid = (xcd < r ? xcd * (q + 1) : r * (q + 1) + (xcd - r) * q) + off; }
        const int nig = WGM * nN, gid = wgid / nig, fm = gid * WGM, gsz = (nM - fm) < WGM ? (nM - fm) : WGM;
        u.pm = fm + ((wgid % nig) % gsz); u.pn = (wgid % nig) / gsz; return true;
    }
    __device__ __forceinline__ void a_ready(const Unit&) const {}
    __device__ __forceinline__ void done(const Unit&) const {}
};

__device__ __forceinline__ unsigned cvt_pk_bf16(float lo, float hi) { unsigned r; asm volatile("v_cvt_pk_bf16_f32 %0, %1, %2" : "=v"(r) : "v"(lo), "v"(hi)); return r; }
typedef float f32x2 __attribute__((ext_vector_type(2)));
__device__ __forceinline__ f32x2 gelu_pk(f32x2 v) {
    const f32x2 av = __builtin_elementwise_abs(v), d = av * 0.2316418882f + 1.0f;
    f32x2 t; t.x = __builtin_amdgcn_rcpf(d.x); t.y = __builtin_amdgcn_rcpf(d.y);
    f32x2 q = t * 0.5307027145f + (-0.7265760135f); q = q * t + 0.7107068705f; q = q * t + (-0.142248368f); q = q * t + 0.127414796f; q = q * t;
    const f32x2 s = (v * v) * (-0.72134752044f);
    f32x2 e; e.x = __builtin_amdgcn_exp2f(s.x); e.y = __builtin_amdgcn_exp2f(s.y);
    const f32x2 m = v * (q * e), r = v - m;
    f32x2 o; o.x = v.x < 0.f ? m.x : r.x; o.y = v.y < 0.f ? m.y : r.y; return o;
}

template <int ACT  > struct EpiBf16 {
    static constexpr bool PERM = true, AFTER_DRAIN = false; static_assert(ACT == 0 || ACT == 1, "EpiBf16: ACT is 0 (none) or 1 (gelu_pk)");
    bf16_t* O; int ldc; const float* bias; int split_cols; size_t split_stride; float scale0;
    __device__ __forceinline__ void operator()(const f32x4 (&acc)[2][2][4][2], const Unit& u, int wr, int wc, int fr, int fq) const {
        const int row0 = u.pm * BM + wr * 64 + fr; int colt = u.pn * BM; bf16_t* base = O;
        float sc = 1.f; if (split_cols) { const int t = colt / split_cols; base += (size_t)t * split_stride; colt -= t * split_cols; if (t == 0) sc = scale0; }
        const int col0 = colt + wc * 32 + 8 * fq, bcol0 = u.pn * BM + wc * 32 + 8 * fq;
        f32x4 bv[2][2];
#pragma unroll
        for (int bj = 0; bj < 2; ++bj)
#pragma unroll
            for (int n = 0; n < 2; ++n) bv[bj][n] = bias ? *(const f32x4*)(bias + bcol0 + bj * HALF + 4 * n) : (f32x4){0.f, 0.f, 0.f, 0.f};
#pragma unroll
        for (int ai = 0; ai < 2; ++ai)
#pragma unroll
            for (int m = 0; m < 4; ++m) { bf16_t* rowp = base + (size_t)(row0 + ai * HALF + m * 16) * ldc + col0;
#pragma unroll
                for (int bj = 0; bj < 2; ++bj) { f32x4 v0 = acc[ai][bj][m][0] + bv[bj][0], v1 = acc[ai][bj][m][1] + bv[bj][1];
                    if (ACT == 1) { f32x2 a = gelu_pk((f32x2){v0[0], v0[1]}), b = gelu_pk((f32x2){v0[2], v0[3]}), c = gelu_pk((f32x2){v1[0], v1[1]}), d = gelu_pk((f32x2){v1[2], v1[3]});
                        v0 = (f32x4){a.x, a.y, b.x, b.y}; v1 = (f32x4){c.x, c.y, d.x, d.y}; }
                    v0 = v0 * sc; v1 = v1 * sc; u32x4 w; w.x = cvt_pk_bf16(v0[0], v0[1]); w.y = cvt_pk_bf16(v0[2], v0[3]); w.z = cvt_pk_bf16(v1[0], v1[1]); w.w = cvt_pk_bf16(v1[2], v1[3]);
                    *(u32x4*)(rowp + bj * HALF) = w; } }
    }
};

__device__ __forceinline__ float sigm(float x) { return __builtin_amdgcn_rcpf(1.0f + __builtin_amdgcn_exp2f(-1.4426950408889634f * x)); }
__device__ __forceinline__ float bf_lo(unsigned w) { return __uint_as_float(w << 16); }
__device__ __forceinline__ float bf_hi(unsigned w) { return __uint_as_float(w & 0xffff0000u); }
__device__ __forceinline__ u32x4 pack8(const f32x4 v0, const f32x4 v1) { u32x4 w; w.x = cvt_pk_bf16(v0[0], v0[1]); w.y = cvt_pk_bf16(v0[2], v0[3]); w.z = cvt_pk_bf16(v1[0], v1[1]); w.w = cvt_pk_bf16(v1[2], v1[3]); return w; }
__device__ __forceinline__ void unpack8(const u32x4 g, f32x4& a, f32x4& b) { a = (f32x4){bf_lo(g.x), bf_hi(g.x), bf_lo(g.y), bf_hi(g.y)}; b = (f32x4){bf_lo(g.z), bf_hi(g.z), bf_lo(g.w), bf_hi(g.w)}; }

struct EpiProj {
    static constexpr bool PERM = true, AFTER_DRAIN = false;
    bf16_t* O; int ldc; int sig_pn; int scale_pn; float scale;
    __device__ __forceinline__ void operator()(const f32x4 (&acc)[2][2][4][2], const Unit& u, int wr, int wc, int fr, int fq) const {
        const int row0 = u.pm * BM + wr * 64 + fr, col0 = u.pn * BM + wc * 32 + 8 * fq; const bool sg = u.pn >= sig_pn; const float sc = u.pn < scale_pn ? scale : 1.0f;
#pragma unroll
        for (int ai = 0; ai < 2; ++ai)
#pragma unroll
            for (int m = 0; m < 4; ++m) { bf16_t* rowp = O + (size_t)(row0 + ai * HALF + m * 16) * ldc + col0;
#pragma unroll
                for (int bj = 0; bj < 2; ++bj) { f32x4 v0 = acc[ai][bj][m][0] * sc, v1 = acc[ai][bj][m][1] * sc;
                    if (sg) {
#pragma unroll
                        for (int k = 0; k < 4; ++k) { v0[k] = sigm(v0[k]); v1[k] = sigm(v1[k]); } }
                    *(u32x4*)(rowp + bj * HALF) = pack8(v0, v1); } }
    }
};
struct EpiT1 {
    static constexpr bool PERM = true, AFTER_DRAIN = false;
    const bf16_t* G; int ldg; bf16_t* T; int ldt;
    __device__ __forceinline__ void operator()(const f32x4 (&acc)[2][2][4][2], const Unit& u, int wr, int wc, int fr, int fq) const {
        const int row0 = u.pm * BM + wr * 64 + fr, col0 = u.pn * BM + wc * 32 + 8 * fq;
#pragma unroll
        for (int ai = 0; ai < 2; ++ai)
#pragma unroll
            for (int m = 0; m < 4; ++m) { const size_t row = (size_t)(row0 + ai * HALF + m * 16);
#pragma unroll
                for (int bj = 0; bj < 2; ++bj) { const u32x4 g = *(const u32x4*)(G + row * ldg + col0 + bj * HALF); f32x4 g0, g1; unpack8(g, g0, g1);
                    *(u32x4*)(T + row * ldt + col0 + bj * HALF) = pack8(acc[ai][bj][m][0] * g0, acc[ai][bj][m][1] * g1); } }
    }
};
struct EpiMerge {
    static constexpr bool PERM = true, AFTER_DRAIN = false;
    const bf16_t* G; int ldg; const bf16_t* T; int ldt; bf16_t* O; int ldo;
    __device__ __forceinline__ void operator()(const f32x4 (&acc)[2][2][4][2], const Unit& u, int wr, int wc, int fr, int fq) const {
        const int row0 = u.pm * BM + wr * 64 + fr, col0 = u.pn * BM + wc * 32 + 8 * fq;
#pragma unroll
        for (int ai = 0; ai < 2; ++ai)
#pragma unroll
            for (int m = 0; m < 4; ++m) { const size_t row = (size_t)(row0 + ai * HALF + m * 16);
#pragma unroll
                for (int bj = 0; bj < 2; ++bj) { const u32x4 g = *(const u32x4*)(G + row * ldg + col0 + bj * HALF); f32x4 g0, g1; unpack8(g, g0, g1);
                    const u32x4 tv = *(const u32x4*)(T + row * ldt + col0 + bj * HALF); f32x4 t0, t1; unpack8(tv, t0, t1);
                    *(u32x4*)(O + row * ldo + col0 + bj * HALF) = pack8(t0 + acc[ai][bj][m][0] * g0, t1 + acc[ai][bj][m][1] * g1); } }
    }
};
template <bool MUL, bool XN> struct EpiResid {
    static constexpr bool PERM = true, AFTER_DRAIN = false;
    const float* base; float* out; const float* mul; bf16_t* xn; const float* gain; float* ss; int ld;
    __device__ __forceinline__ void operator()(const f32x4 (&acc)[2][2][4][2], const Unit& u, int wr, int wc, int fr, int fq) const {
        const int row0 = u.pm * BM + wr * 64 + fr, col0 = u.pn * BM + wc * 32 + 8 * fq;
        f32x4 gv[2][2];
#pragma unroll
        for (int bj = 0; bj < 2; ++bj) { if (XN) { gv[bj][0] = *(const f32x4*)(gain + col0 + bj * HALF); gv[bj][1] = *(const f32x4*)(gain + col0 + bj * HALF + 4); } else { gv[bj][0] = (f32x4){0.f, 0.f, 0.f, 0.f}; gv[bj][1] = gv[bj][0]; } }
#pragma unroll
        for (int ai = 0; ai < 2; ++ai) {
            f32x4 pre[4][2][2];
#pragma unroll
            for (int m = 0; m < 4; ++m)
#pragma unroll
                for (int bj = 0; bj < 2; ++bj) { const size_t p = (size_t)(row0 + ai * HALF + m * 16) * ld + col0 + bj * HALF; pre[m][bj][0] = *(const f32x4*)(base + p); pre[m][bj][1] = *(const f32x4*)(base + p + 4); }
            asm volatile("" ::: "memory");
#pragma unroll
            for (int m = 0; m < 4; ++m) { const size_t row = (size_t)(row0 + ai * HALF + m * 16); float s = 0.f;
#pragma unroll
                for (int bj = 0; bj < 2; ++bj) { const size_t p = row * ld + col0 + bj * HALF;
                    f32x4 v0 = acc[ai][bj][m][0], v1 = acc[ai][bj][m][1];
                    if (MUL) { v0 = v0 * *(const f32x4*)(mul + p); v1 = v1 * *(const f32x4*)(mul + p + 4); }
                    v0 = v0 + pre[m][bj][0]; v1 = v1 + pre[m][bj][1];
                    *(f32x4*)(out + p) = v0; *(f32x4*)(out + p + 4) = v1;
                    s += (v0[0] * v0[0] + v0[1] * v0[1]) + (v0[2] * v0[2] + v0[3] * v0[3]) + (v1[0] * v1[0] + v1[1] * v1[1]) + (v1[2] * v1[2] + v1[3] * v1[3]);
                    if (XN) *(u32x4*)(xn + p) = pack8(v0 * gv[bj][0], v1 * gv[bj][1]); }
                { const int ln = fr + 16 * fq; s += shx(s, ln, 16); s += shx(s, ln, 32); }
                if (fq == 0) ss[row * 16 + u.pn * 4 + wc] = s; }
            asm volatile("" ::: "memory");
        }
    }
};
template <bool BB> struct EpiResidB {
    static constexpr bool PERM = true, AFTER_DRAIN = false;
    const void* base; bf16_t* hs; float* ss; int ld;
    __device__ __forceinline__ void operator()(const f32x4 (&acc)[2][2][4][2], const Unit& u, int wr, int wc, int fr, int fq) const {
        const int row0 = u.pm * BM + wr * 64 + fr, col0 = u.pn * BM + wc * 32 + 8 * fq;
#pragma unroll
        for (int ai = 0; ai < 2; ++ai) {
            f32x4 pre[4][2][2];
#pragma unroll
            for (int m = 0; m < 4; ++m)
#pragma unroll
                for (int bj = 0; bj < 2; ++bj) { const size_t p = (size_t)(row0 + ai * HALF + m * 16) * ld + col0 + bj * HALF;
                    if (BB) { const u32x4 b = *(const u32x4*)((const bf16_t*)base + p); unpack8(b, pre[m][bj][0], pre[m][bj][1]); }
                    else { pre[m][bj][0] = *(const f32x4*)((const float*)base + p); pre[m][bj][1] = *(const f32x4*)((const float*)base + p + 4); } }
            asm volatile("" ::: "memory");
#pragma unroll
            for (int m = 0; m < 4; ++m) { const size_t row = (size_t)(row0 + ai * HALF + m * 16); float s = 0.f;
#pragma unroll
                for (int bj = 0; bj < 2; ++bj) { const size_t p = row * ld + col0 + bj * HALF;
                    const f32x4 v0 = acc[ai][bj][m][0] + pre[m][bj][0], v1 = acc[ai][bj][m][1] + pre[m][bj][1];
                    *(u32x4*)(hs + p) = pack8(v0, v1);
                    s += (v0[0] * v0[0] + v0[1] * v0[1]) + (v0[2] * v0[2] + v0[3] * v0[3]) + (v1[0] * v1[0] + v1[1] * v1[1]) + (v1[2] * v1[2] + v1[3] * v1[3]);
}
                { const int ln = fr + 16 * fq; s += shx(s, ln, 16); s += shx(s, ln, 32); }
                if (fq == 0) ss[row * 16 + u.pn * 4 + wc] = s; }
            asm volatile("" ::: "memory");
        }
    }
};
template <bool SIG> struct EpiScale {
    static constexpr bool PERM = true, AFTER_DRAIN = false;
    const float* ss; float inv_n, eps; bf16_t* O; float* F; int ldc;
    __device__ __forceinline__ void operator()(const f32x4 (&acc)[2][2][4][2], const Unit& u, int wr, int wc, int fr, int fq) const {
        const int row0 = u.pm * BM + wr * 64 + fr, col0 = u.pn * BM + wc * 32 + 8 * fq;
#pragma unroll
        for (int ai = 0; ai < 2; ++ai)
#pragma unroll
            for (int m = 0; m < 4; ++m) { const size_t row = (size_t)(row0 + ai * HALF + m * 16); const f32x4* sp = (const f32x4*)(ss + row * 16); const f32x4 sa = (sp[0] + sp[1]) + (sp[2] + sp[3]); const float r = __builtin_amdgcn_rsqf(((sa[0] + sa[1]) + (sa[2] + sa[3])) * inv_n + eps);
#pragma unroll
                for (int bj = 0; bj < 2; ++bj) { f32x4 v0 = acc[ai][bj][m][0] * r, v1 = acc[ai][bj][m][1] * r; const size_t p = row * ldc + col0 + bj * HALF;
                    if (SIG) {
#pragma unroll
                        for (int k = 0; k < 4; ++k) { v0[k] = sigm(v0[k]); v1[k] = sigm(v1[k]); }
                        *(f32x4*)(F + p) = v0; *(f32x4*)(F + p + 4) = v1;
                    } else *(u32x4*)(O + p) = pack8(v0, v1); } }
    }
};

struct EpiPle {
    static constexpr bool PERM = true, AFTER_DRAIN = false;
    const float* ss2; float inv_n, eps; const bf16_t* E; const bf16_t* hs; bf16_t* ho; float* ss3; int ld;
    __device__ __forceinline__ void operator()(const f32x4 (&acc)[2][2][4][2], const Unit& u, int wr, int wc, int fr, int fq) const {
        const int row0 = u.pm * BM + wr * 64 + fr, col0 = u.pn * BM + wc * 32 + 8 * fq;
#pragma unroll
        for (int ai = 0; ai < 2; ++ai)
#pragma unroll
          for (int mp = 0; mp < 2; ++mp) {
            f32x4 pre[2][2][2]; u32x4 ev[2][2]; f32x4 sv[2][4];
#pragma unroll
            for (int mm = 0; mm < 2; ++mm) { const size_t row = (size_t)(row0 + ai * HALF + (2 * mp + mm) * 16); const f32x4* sp = (const f32x4*)(ss2 + row * 16); sv[mm][0] = sp[0]; sv[mm][1] = sp[1]; sv[mm][2] = sp[2]; sv[mm][3] = sp[3];
#pragma unroll
                for (int bj = 0; bj < 2; ++bj) { const size_t p = row * ld + col0 + bj * HALF; { const u32x4 hb = *(const u32x4*)(hs + p); unpack8(hb, pre[mm][bj][0], pre[mm][bj][1]); } ev[mm][bj] = *(const u32x4*)(E + p); } }
            asm volatile("" ::: "memory");
#pragma unroll
            for (int mm = 0; mm < 2; ++mm) { const int m = 2 * mp + mm; const size_t row = (size_t)(row0 + ai * HALF + m * 16); float s = 0.f;
                const f32x4 sa = (sv[mm][0] + sv[mm][1]) + (sv[mm][2] + sv[mm][3]); const float r = __builtin_amdgcn_rsqf(((sa[0] + sa[1]) + (sa[2] + sa[3])) * inv_n + eps);
#pragma unroll
                for (int bj = 0; bj < 2; ++bj) { const size_t p = row * ld + col0 + bj * HALF;
                    f32x4 e0, e1; unpack8(ev[mm][bj], e0, e1);
                    f32x4 v0 = acc[ai][bj][m][0] * r, v1 = acc[ai][bj][m][1] * r;
#pragma unroll
                    for (int k = 0; k < 4; ++k) { v0[k] = sigm(v0[k]); v1[k] = sigm(v1[k]); }
                    v0 = v0 * e0 + pre[mm][bj][0]; v1 = v1 * e1 + pre[mm][bj][1];
                    *(u32x4*)(ho + p) = pack8(v0, v1);
                    s += (v0[0] * v0[0] + v0[1] * v0[1]) + (v0[2] * v0[2] + v0[3] * v0[3]) + (v1[0] * v1[0] + v1[1] * v1[1]) + (v1[2] * v1[2] + v1[3] * v1[3]); }
                { const int ln = fr + 16 * fq; s += shx(s, ln, 16); s += shx(s, ln, 32); }
                if (fq == 0) ss3[row * 16 + u.pn * 4 + wc] = s; }
            asm volatile("" ::: "memory");
          }
    }
};

template <class Epi, class Sched, bool ALIGN_EPI = false, bool SP2 = false>
__device__ __forceinline__ void gemm_phase(PG8_LAS unsigned char* lds, const Gemm g, const Sched& S, const Epi& E, int wave_s) {
    int tid_ = wave_s * 64 + lane_id_v(); asm volatile("" : "+v"(tid_));
    const int tid = tid_, wid = __builtin_amdgcn_readfirstlane(tid >> 6), lane = tid & 63, wr = wid >> 2, wc = wid & 3, fr = lane & 15, fq = lane >> 4;
    const int K = g.K, nt = K / BK;
    unsigned voffA[2], voffB[2];
#pragma unroll
    for (int i = 0; i < 2; ++i) { int R, C; stage_rc(tid * 16 + i * 8192, R, C); const int Rb = Epi::PERM ? ((R & ~31) + perm32(R & 31)) : R;
        voffA[i] = (unsigned)(R * K + C) * 2u; voffB[i] = (unsigned)(Rb * K + C) * 2u; }
    const size_t kstep = (size_t)(BK * 2);
    const size_t hstep = (size_t)HALF * K * 2;
    const size_t tstep = 2 * hstep;
    const unsigned ldsw = (unsigned)wid * 1024u;
    const int aoff = lds_byte(wr * 64 + fr, fq * 8), boff = lds_byte(wc * 32 + fr, fq * 8);
#define PG8_SA(b, h) (((b) * 2 + (h)) * HTB)
#define PG8_SB(b, h) ((4 + (b) * 2 + (h)) * HTB)
#define PG8_STAGE(bufoff, gbase, voff) do { _Pragma("unroll") for (int _i = 0; _i < 2; ++_i) \
        __builtin_amdgcn_global_load_lds((const unsigned*)((const char*)(gbase) + (voff)[_i]), (PG8_LAS unsigned*)(lds + (bufoff) + ldsw + _i * 8192), 16, 0, 0); } while (0)
#define PG8_LDA(dst, b, h) do { _Pragma("unroll") for (int m = 0; m < 4; ++m) _Pragma("unroll") for (int k = 0; k < 2; ++k) dst[m][k] = *(const PG8_LAS bf16x8*)(lds + PG8_SA(b, h) + aoff + m * 2048 + k * 1024); } while (0)
#define PG8_LDB(dst, b, h) do { _Pragma("unroll") for (int n = 0; n < 2; ++n) _Pragma("unroll") for (int k = 0; k < 2; ++k) dst[n][k] = *(const PG8_LAS bf16x8*)(lds + PG8_SB(b, h) + boff + n * 2048 + k * 1024); } while (0)
#define PG8_MMA(ai, bj, At, Bt) do { __builtin_amdgcn_s_setprio(1); _Pragma("unroll") for (int m = 0; m < 4; ++m) _Pragma("unroll") for (int n = 0; n < 2; ++n) _Pragma("unroll") for (int k = 0; k < 2; ++k) \
        acc[ai][bj][m][n] = __builtin_amdgcn_mfma_f32_16x16x32_bf16(Bt[n][k], At[m][k], acc[ai][bj][m][n], 0, 0, 0); __builtin_amdgcn_s_setprio(0); } while (0)
#define PG8_WAIT_V(n) asm volatile("s_waitcnt vmcnt(" #n ")" ::: "memory")
#define PG8_WAIT_L(n) asm volatile("s_waitcnt lgkmcnt(" #n ")" ::: "memory")
#define PG8_BAR __builtin_amdgcn_s_barrier()
#define PG8_SCHED __builtin_amdgcn_sched_barrier(0)
    Unit cur, nxt; int ui = 0;
    if (!S.next(0, cur)) return;
    f32x4 acc[2][2][4][2];
#pragma unroll
    for (int a = 0; a < 2; ++a)
#pragma unroll
        for (int b = 0; b < 2; ++b)
#pragma unroll
            for (int m = 0; m < 4; ++m)
#pragma unroll
                for (int n = 0; n < 2; ++n) acc[a][b][m][n] = (f32x4){0.f, 0.f, 0.f, 0.f};
    bf16x8 At[4][2], B0[2][2], B1[2][2];
    const char* cA = (const char*)g.A + (size_t)cur.pm * tstep; const char* cB = (const char*)g.Bt + (size_t)cur.pn * tstep;
    S.a_ready(cur);
    if constexpr (SP2) {
        PG8_STAGE(PG8_SB(0, 0), cB, voffB); PG8_STAGE(PG8_SB(0, 1), cB + hstep, voffB); PG8_STAGE(PG8_SA(0, 0), cA, voffA); PG8_STAGE(PG8_SA(0, 1), cA + hstep, voffA);
        if (wr == 1) PG8_BAR;
        PG8_WAIT_V(2); PG8_BAR;
        PG8_STAGE(PG8_SB(1, 0), cB + kstep, voffB); PG8_STAGE(PG8_SA(1, 0), cA + kstep, voffA); PG8_STAGE(PG8_SB(1, 1), cB + hstep + kstep, voffB);
        PG8_WAIT_V(6); PG8_BAR;
    } else {
        PG8_STAGE(PG8_SB(0, 0), cB, voffB); PG8_STAGE(PG8_SA(0, 0), cA, voffA); PG8_STAGE(PG8_SB(0, 1), cB + hstep, voffB); PG8_STAGE(PG8_SA(0, 1), cA + hstep, voffA);
        if (wr == 1) PG8_BAR;
        PG8_WAIT_V(4); PG8_BAR;
        PG8_STAGE(PG8_SB(1, 0), cB + kstep, voffB); PG8_STAGE(PG8_SA(1, 0), cA + kstep, voffA); PG8_STAGE(PG8_SB(1, 1), cB + hstep + kstep, voffB);
        PG8_WAIT_V(6); PG8_BAR;
    }
    for (;;) {
        const bool has_next = S.next(ui + 1, nxt);
        const char* nA = has_next ? (const char*)g.A + (size_t)nxt.pm * tstep : cA; const char* nB = has_next ? (const char*)g.Bt + (size_t)nxt.pn * tstep : cB;
        for (int t = 0; t < nt; t += 2) {
            const bool last = (t == nt - 2);
            const char* a1 = cA + (size_t)(t + 1) * kstep;
            const char* a2 = last ? nA : cA + (size_t)(t + 2) * kstep; const char* b2 = last ? nB : cB + (size_t)(t + 2) * kstep;
            const char* a3 = a2 + kstep; const char* b3 = b2 + kstep;
            if (last && has_next) S.a_ready(nxt);
            if constexpr (SP2) {
            PG8_LDB(B0, 0, 0); PG8_LDB(B1, 0, 1); PG8_SCHED; PG8_LDA(At, 0, 0); PG8_STAGE(PG8_SA(1, 1), a1 + hstep, voffA);
            PG8_WAIT_V(8); PG8_WAIT_L(0); PG8_BAR; PG8_MMA(0, 0, At, B0); PG8_MMA(0, 1, At, B1); PG8_BAR; PG8_SCHED;
            PG8_LDA(At, 0, 1); PG8_STAGE(PG8_SB(0, 0), b2, voffB); PG8_STAGE(PG8_SB(0, 1), b2 + hstep, voffB); PG8_STAGE(PG8_SA(0, 0), a2, voffA);
            PG8_WAIT_V(8); PG8_WAIT_L(0); PG8_BAR; PG8_MMA(1, 0, At, B0); PG8_MMA(1, 1, At, B1); PG8_BAR; PG8_SCHED;
            PG8_LDB(B0, 1, 0); PG8_LDB(B1, 1, 1); PG8_SCHED; PG8_LDA(At, 1, 0); PG8_STAGE(PG8_SA(0, 1), a2 + hstep, voffA);
            PG8_WAIT_V(8); PG8_WAIT_L(0); PG8_BAR; PG8_MMA(0, 0, At, B0); PG8_MMA(0, 1, At, B1); PG8_BAR; PG8_SCHED;
            PG8_LDA(At, 1, 1); PG8_STAGE(PG8_SB(1, 0), b3, voffB); PG8_STAGE(PG8_SB(1, 1), b3 + hstep, voffB); PG8_STAGE(PG8_SA(1, 0), a3, voffA);
            PG8_WAIT_V(8); PG8_WAIT_L(0); PG8_BAR; PG8_MMA(1, 0, At, B0); PG8_MMA(1, 1, At, B1); PG8_BAR; PG8_SCHED;
            } else {
            PG8_LDB(B0, 0, 0); PG8_SCHED; PG8_LDA(At, 0, 0); PG8_STAGE(PG8_SA(1, 1), a1 + hstep, voffA);
            PG8_WAIT_L(8); PG8_BAR; PG8_WAIT_L(0); PG8_MMA(0, 0, At, B0); PG8_BAR; PG8_SCHED;
            PG8_LDB(B1, 0, 1); PG8_STAGE(PG8_SB(0, 0), b2, voffB);
            PG8_BAR; PG8_WAIT_L(0); PG8_MMA(0, 1, At, B1); PG8_BAR;
            PG8_LDA(At, 0, 1); PG8_STAGE(PG8_SA(0, 0), a2, voffA);
            PG8_BAR; PG8_WAIT_L(0); PG8_MMA(1, 0, At, B0); PG8_BAR; PG8_SCHED;
            PG8_STAGE(PG8_SB(0, 1), b2 + hstep, voffB);
            PG8_WAIT_V(6); PG8_BAR; PG8_MMA(1, 1, At, B1); PG8_BAR;
            PG8_LDB(B0, 1, 0); PG8_SCHED; PG8_LDA(At, 1, 0); PG8_STAGE(PG8_SA(0, 1), a2 + hstep, voffA);
            PG8_WAIT_L(8); PG8_BAR; PG8_WAIT_L(0); PG8_MMA(0, 0, At, B0); PG8_BAR; PG8_SCHED;
            PG8_LDB(B1, 1, 1); PG8_STAGE(PG8_SB(1, 0), b3, voffB);
            PG8_BAR; PG8_WAIT_L(0); PG8_MMA(0, 1, At, B1); PG8_BAR;
            PG8_LDA(At, 1, 1); PG8_STAGE(PG8_SA(1, 0), a3, voffA);
            PG8_BAR; PG8_WAIT_L(0); PG8_MMA(1, 0, At, B0); PG8_BAR; PG8_SCHED;
            PG8_STAGE(PG8_SB(1, 1), b3 + hstep, voffB);
            PG8_WAIT_V(6); PG8_BAR; PG8_MMA(1, 1, At, B1); PG8_BAR;
            }
        }
        if constexpr (ALIGN_EPI) { if (wr == 0) PG8_BAR; }
        if constexpr (!Epi::AFTER_DRAIN) { E(acc, cur, wr, wc, fr, fq); S.done(cur); }
        if (!has_next) break;
#pragma unroll
        for (int a = 0; a < 2; ++a)
#pragma unroll
            for (int b = 0; b < 2; ++b)
#pragma unroll
                for (int m = 0; m < 4; ++m)
#pragma unroll
                    for (int n = 0; n < 2; ++n) acc[a][b][m][n] = (f32x4){0.f, 0.f, 0.f, 0.f};
        cur = nxt; cA = nA; cB = nB; ++ui;
        if constexpr (ALIGN_EPI) { if (wr == 1) PG8_BAR; }
    }
    PG8_WAIT_V(0);
    if constexpr (!ALIGN_EPI) { if (wr == 0) PG8_BAR; }
    PG8_BAR;
    if constexpr (Epi::AFTER_DRAIN) { E.fused(acc, cur, wr, wc, fr, fq, lds, wid, lane); S.done(cur); }
#undef PG8_SA
#undef PG8_SB
#undef PG8_STAGE
#undef PG8_LDA
#undef PG8_LDB
#undef PG8_MMA
#undef PG8_WAIT_V
#undef PG8_WAIT_L
#undef PG8_BAR
#undef PG8_SCHED
}
}

#ifndef PG8_SP2
#define PG8_SP2 true
#endif
#ifndef PG8_ALIGN
#define PG8_ALIGN true
#endif
#include <hip/hip_bf16.h>
#include <cmath>
#include <hip/hip_bf16.h>
#include <cmath>
namespace attn_body {
using bf16=__hip_bfloat16;
using bf16x8=__attribute__((ext_vector_type(8)))short;
using s16x4=__attribute__((ext_vector_type(4)))short;
using f32x16=__attribute__((ext_vector_type(16)))float;
using u32x4=__attribute__((ext_vector_type(4)))unsigned;
constexpr int BATCH=2,NHEAD=16,SEQ=8192,D=64,DM=NHEAD*D;
constexpr int NW=8,QBLK=32,QB=QBLK*NW,KVBLK=64,NQB=SEQ/QB;
constexpr int ATTN_PITCH=DM, ATTN_UNIT_ROWS=QB;
__device__ __forceinline__ int crow(int r,int hi){return (r&3)+8*(r>>2)+4*hi;}
#define SBAR() __builtin_amdgcn_sched_barrier(0)
__device__ __forceinline__ void cmask(f32x16&p0,f32x16&p1,int jb,int qrel,int hi){
  const float NEG=-INFINITY; int kb=64*jb+4*hi;
  #pragma unroll
  for(int r=0;r<16;++r){int kv=kb+(r&3)+8*(r>>2); if(kv>qrel)p0[r]=NEG; if(kv+32>qrel)p1[r]=NEG;}
}

constexpr int NSLOT=3, SLOTB=8192;
constexpr int LDS_K=0, LDS_V=NSLOT*SLOTB, LDS_WS=2*NSLOT*SLOTB, LDS_OST=LDS_WS+NW*64*4, LDS_BYTES=LDS_OST+NW*4096;
constexpr float C2=0.125f*1.4426950408889634f;
__device__ __forceinline__ void glds16(const void*gsrc,unsigned lds_dst){unsigned keep;
  asm volatile("s_mov_b32 %0, m0\n\ts_mov_b32 m0, %2\n\ts_nop 0\n\tglobal_load_lds_dwordx4 %1, off\n\ts_mov_b32 m0, %0":"=&s"(keep):"v"(gsrc),"s"(lds_dst):"memory");}
__device__ __forceinline__ float max3f(float a,float b,float c){float r;asm("v_max3_f32 %0, %1, %2, %3":"=v"(r):"v"(a),"v"(b),"v"(c));return r;}
__device__ __forceinline__ float max2f(float a,float b){float r;asm("v_max_f32_e32 %0, %1, %2":"=v"(r):"v"(a),"v"(b));return r;}
__device__ __forceinline__ float fadd_s(float a,float b){float r;asm("v_add_f32_e32 %0, %1, %2":"=v"(r):"v"(a),"v"(b));return r;}
__device__ __forceinline__ float fsub_s(float a,float b){float r;asm("v_sub_f32_e32 %0, %1, %2":"=v"(r):"v"(a),"v"(b));return r;}
typedef float f32x2_t __attribute__((ext_vector_type(2))); typedef __bf16 bf16x2_t __attribute__((ext_vector_type(2)));
__device__ __forceinline__ unsigned cvtpk_s(float lo,float hi){f32x2_t v={lo,hi};bf16x2_t b=__builtin_convertvector(v,bf16x2_t);return __builtin_bit_cast(unsigned,b);}
#define WAIT_BAR(N) asm volatile("s_waitcnt vmcnt(" #N ") lgkmcnt(0)\n\ts_barrier":::"memory")

__device__ __forceinline__ void qkt(f32x16&p0,f32x16&p1,const char*Kslot,const bf16x8*qr,const f32x16&negm,int r32,int hi){
  const char*kb=Kslot+hi*1024+r32*16;
  #pragma unroll
  for(int d0=0;d0<4;++d0){
    const bf16x8 b0=*reinterpret_cast<const bf16x8*>(kb+d0*2048);
    const bf16x8 b1=*reinterpret_cast<const bf16x8*>(kb+d0*2048+512);
    if(d0==0){p0=__builtin_amdgcn_mfma_f32_32x32x16_bf16(b0,qr[0],negm,0,0,0);p1=__builtin_amdgcn_mfma_f32_32x32x16_bf16(b1,qr[0],negm,0,0,0);}
    else{p0=__builtin_amdgcn_mfma_f32_32x32x16_bf16(b0,qr[d0],p0,0,0,0);p1=__builtin_amdgcn_mfma_f32_32x32x16_bf16(b1,qr[d0],p1,0,0,0);}}
}
typedef __attribute__((address_space(3))) const char* lds_cptr;
typedef short v4i16_t __attribute__((ext_vector_type(4)));
__device__ __forceinline__ void kload8(bf16x8*kf,lds_cptr kp){
  kf[0]=*(const __attribute__((address_space(3))) bf16x8*)(kp);      kf[1]=*(const __attribute__((address_space(3))) bf16x8*)(kp+512);
  kf[2]=*(const __attribute__((address_space(3))) bf16x8*)(kp+2048); kf[3]=*(const __attribute__((address_space(3))) bf16x8*)(kp+2560);
  kf[4]=*(const __attribute__((address_space(3))) bf16x8*)(kp+4096); kf[5]=*(const __attribute__((address_space(3))) bf16x8*)(kp+4608);
  kf[6]=*(const __attribute__((address_space(3))) bf16x8*)(kp+6144); kf[7]=*(const __attribute__((address_space(3))) bf16x8*)(kp+6656);
}
__device__ __forceinline__ void kload2(bf16x8*kf,lds_cptr kp,int j){ kf[2*j]=*(const __attribute__((address_space(3))) bf16x8*)(kp+j*2048); kf[2*j+1]=*(const __attribute__((address_space(3))) bf16x8*)(kp+j*2048+512); }
__device__ __forceinline__ s16x4 vtr(lds_cptr p){ return __builtin_bit_cast(s16x4,__builtin_amdgcn_ds_read_tr16_b64_v4i16((__attribute__((address_space(3))) v4i16_t*)p)); }
__device__ __forceinline__ float rowmax(const f32x16&p0,const f32x16&p1){
  float a=max3f(p0[0],p0[1],p1[0]),b=max3f(p0[2],p0[3],p1[1]);a=max3f(a,p1[2],p1[3]);
  #pragma unroll
  for(int r=4;r<16;r+=4){a=max3f(a,p0[r],p0[r+1]);b=max3f(b,p0[r+2],p0[r+3]);a=max3f(a,p1[r],p1[r+1]);b=max3f(b,p1[r+2],p1[r+3]);}
  const float m=max2f(a,b);
  auto rr=__builtin_amdgcn_permlane32_swap(__float_as_uint(m),__float_as_uint(m),false,false);
  return max2f(__uint_as_float(rr[0]),__uint_as_float(rr[1]));
}
__device__ __forceinline__ void pv(f32x16*o,int vb,bf16x8 pa0,bf16x8 pa1,bf16x8 pa2,bf16x8 pa3){
  #pragma unroll
  for(int d0=0;d0<2;++d0){s16x4 lo[4],hi[4];
    #pragma unroll
    for(int ks=0;ks<4;++ks){
      asm volatile("ds_read_b64_tr_b16 %0,%1 offset:%c2":"=&v"(lo[ks]):"v"(vb),"i"(d0*4096+ks*1024):"memory");
      asm volatile("ds_read_b64_tr_b16 %0,%1 offset:%c2":"=&v"(hi[ks]):"v"(vb),"i"(d0*4096+ks*1024+512):"memory");}
    asm volatile("s_waitcnt lgkmcnt(0)":::"memory");SBAR();
    #define PK(k) (bf16x8){lo[k][0],lo[k][1],lo[k][2],lo[k][3],hi[k][0],hi[k][1],hi[k][2],hi[k][3]}
    o[d0]=__builtin_amdgcn_mfma_f32_32x32x16_bf16(pa0,PK(0),o[d0],0,0,0);
    o[d0]=__builtin_amdgcn_mfma_f32_32x32x16_bf16(pa1,PK(1),o[d0],0,0,0);
    o[d0]=__builtin_amdgcn_mfma_f32_32x32x16_bf16(pa2,PK(2),o[d0],0,0,0);
    o[d0]=__builtin_amdgcn_mfma_f32_32x32x16_bf16(pa3,PK(3),o[d0],0,0,0);
    #undef PK
  }
}

#ifndef ATTN_STORE16
#define ATTN_STORE16(p,v) (*(u32x4*)(p)=(v))
#endif
template<int THRL> __device__ __forceinline__ void attn_unit(int qb,const bf16*Qh,const bf16*Kh,const bf16*Vh,bf16*Oh,int pq,int pk,int pv_,int po,char*shm,int wave_s){
  int tid_=wave_s*64+lane_id_v(); asm volatile("":"+v"(tid_)); const int tid=tid_,lane=tid&63,r32=lane&31,hi=lane>>5; const int wid=__builtin_amdgcn_readfirstlane(tid>>6);
  const int q0=qb*QB;
  const bf16*Qw=Qh+(long)(q0+wid*QBLK)*pq;
  const unsigned lds0=(unsigned)(uintptr_t)shm;
  float*wsf=(float*)(shm+LDS_WS)+wid*64;
  const bf16*ksrc=Kh+(long)lane*pk+wid*8;
  const bf16*vsrc=Vh+(long)(16*(wid&3)+(lane>>2))*pv_+(wid>>2)*32+(lane&3)*8;
  const unsigned kdst=lds0+LDS_K+wid*1024, vdst=lds0+LDS_V+wid*1024;
  #define DMA_K(t,slot) glds16(ksrc+(long)(t)*KVBLK*pk,(unsigned)__builtin_amdgcn_readfirstlane(kdst+(slot)))
  #define DMA_V(t,slot) glds16(vsrc+(long)(t)*KVBLK*pv_,(unsigned)__builtin_amdgcn_readfirstlane(vdst+(slot)))
  const int vb0=(int)(lds0+LDS_V)+((lane>>4)&1)*32+(lane&3)*8+(4*hi+((lane&15)>>2))*64;
  const char*Kbase=shm+LDS_K; bf16x8 kf[8];
  const lds_cptr shm3=(lds_cptr)shm; const lds_cptr kp0=shm3+LDS_K+hi*1024+r32*16; const lds_cptr vp0=shm3+LDS_V+((lane>>4)&1)*32+(lane&3)*8+(4*hi+((lane&15)>>2))*64;
  constexpr int NT=SEQ/KVBLK;
  DMA_K(0,0);DMA_V(0,0);DMA_K(1,SLOTB);
  bf16x8 qr[4];
  #pragma unroll
  for(int d0=0;d0<4;++d0)qr[d0]=*reinterpret_cast<const bf16x8*>(&Qw[(long)r32*pq+d0*16+hi*8]);
  float mhat=0.f,l_reg=0.f;f32x16 o[2];o[0]=f32x16{};o[1]=f32x16{};f32x16 negm=f32x16{};asm volatile("":"+v"(negm));

  #define CMASK(P0,P1,t) do{}while(0)
  bool resc=false;
  #define START(P0,P1) do{ const float rm=rowmax(P0,P1); resc=false; \
    { const float dl=rm; mhat=fadd_s(mhat,dl); \
      _Pragma("unroll") for(int r=0;r<16;++r){P0[r]=fsub_s(P0[r],dl);P1[r]=fsub_s(P1[r],dl);} \
      _Pragma("unroll") for(int r=0;r<16;++r)negm[r]=-mhat; asm volatile("":"+v"(negm)); } \
    _Pragma("unroll") for(int r=0;r<16;++r)P0[r]=__builtin_amdgcn_exp2f(P0[r]); }while(0)
  #define RESC() do{ if(resc){ asm volatile("s_waitcnt lgkmcnt(0)":::"memory"); \
      _Pragma("unroll") for(int d_=0;d_<2;++d_) _Pragma("unroll") for(int r=0;r<16;++r)o[d_][r]*=wsf[crow(r,hi)]; } }while(0)
  f32x16 pA0,pA1,pB0,pB1;
  int sl_prev=0,sl_cur=0,sl_next=SLOTB;
  #define ROT() do{sl_prev=sl_cur;sl_cur=sl_next;sl_next=(sl_next==(NSLOT-1)*SLOTB)?0:sl_next+SLOTB;}while(0)
  DMA_K(2,2*SLOTB);
  WAIT_BAR(3);
  qkt(pA0,pA1,Kbase,qr,negm,r32,hi);asm volatile("s_nop 15\n\ts_nop 7":"+v"(pA0),"+v"(pA1));CMASK(pA0,pA1,0);
  START(pA0,pA1);
  _Pragma("unroll") for(int r=0;r<16;++r)pA1[r]=__builtin_amdgcn_exp2f(pA1[r]);
  WAIT_BAR(0);
  DMA_K(3,0);DMA_V(1,SLOTB);
  ROT();
  kload8(kf,kp0+sl_cur);
  WAIT_BAR(2);
  s16x4 vlo[8],vhi[8]; u32x4 pw0,pw1,pw2,pw3;
  #define PKW(P,B) cvtpk_s(P[B],P[B+1])
  #define PAF(k) __builtin_bit_cast(bf16x8,pw##k)
  #define VFR(i) (bf16x8){vlo[i][0],vlo[i][1],vlo[i][2],vlo[i][3],vhi[i][0],vhi[i][1],vhi[i][2],vhi[i][3]}
  #define PIN(x) asm volatile("":"+v"(x))
  #define MX3(a,b,c) __builtin_fmaxf(__builtin_fmaxf((a),(b)),(c))
  #define GAPA(MF,A0,A1,A2,A3,W0,W1,PW) do{ MF; sacc+=A0; sacc+=A1; sacc+=A2; sacc+=A3; PIN(sacc); W0; W1; PIN(PW); SBAR(); }while(0)
  #define EX(v) __builtin_amdgcn_exp2f(v)
  #define GAPB(MF,X,B) do{ MF; X[B]=EX(X[B]); X[B+1]=EX(X[B+1]); X[B+2]=EX(X[B+2]); X[B+3]=EX(X[B+3]); PIN(X); SBAR(); }while(0)
  #define VRD(i) do{ vlo[i]=vtr(vp_+(((i)>>2)*4096+((i)&3)*1024)); vhi[i]=vtr(vp_+(((i)>>2)*4096+((i)&3)*1024+512)); }while(0)
  #define KRD(G,j) do{ if(G){ kload2(kf,kp0+sl_next,j); SBAR(); } }while(0)
  #define STEP(C0,C1,P0,P1,t,GK,GV,GL,GM) do{ SBAR(); \
    const lds_cptr vp_=vp0+sl_prev; \
    VRD(0); SBAR(); float sacc=(P0[0]+P0[1]); \
    GAPA(C0=__builtin_amdgcn_mfma_f32_32x32x16_bf16(kf[0],qr[0],negm,0,0,0), P0[2],P0[3],P0[4],P0[5],     pw0[0]=PKW(P0,0), pw0[1]=PKW(P0,2), pw0); \
    VRD(4); SBAR(); GAPA(C1=__builtin_amdgcn_mfma_f32_32x32x16_bf16(kf[1],qr[0],negm,0,0,0), P0[6],P0[7],P0[8],P0[9],     pw0[2]=PKW(P0,4), pw0[3]=PKW(P0,6), pw0); \
    VRD(1); SBAR(); GAPA(C0=__builtin_amdgcn_mfma_f32_32x32x16_bf16(kf[2],qr[1],C0,0,0,0),   P0[10],P0[11],P0[12],P0[13], pw1[0]=PKW(P0,8), pw1[1]=PKW(P0,10), pw1); \
    VRD(5); SBAR(); GAPA(C1=__builtin_amdgcn_mfma_f32_32x32x16_bf16(kf[3],qr[1],C1,0,0,0),   P0[14],P0[15],P1[0],P1[1],   pw1[2]=PKW(P0,12),pw1[3]=PKW(P0,14), pw1); \
    VRD(2); SBAR(); GAPA(C0=__builtin_amdgcn_mfma_f32_32x32x16_bf16(kf[4],qr[2],C0,0,0,0),   P1[2],P1[3],P1[4],P1[5],     pw2[0]=PKW(P1,0), pw2[1]=PKW(P1,2), pw2); \
    VRD(6); SBAR(); GAPA(C1=__builtin_amdgcn_mfma_f32_32x32x16_bf16(kf[5],qr[2],C1,0,0,0),   P1[6],P1[7],P1[8],P1[9],     pw2[2]=PKW(P1,4), pw2[3]=PKW(P1,6), pw2); \
    VRD(3); SBAR(); GAPA(C0=__builtin_amdgcn_mfma_f32_32x32x16_bf16(kf[6],qr[3],C0,0,0,0),   P1[10],P1[11],P1[12],P1[13], pw3[0]=PKW(P1,8), pw3[1]=PKW(P1,10), pw3); \
    VRD(7); SBAR(); GAPA(C1=__builtin_amdgcn_mfma_f32_32x32x16_bf16(kf[7],qr[3],C1,0,0,0),   P1[14],P1[15],0.f,0.f,       pw3[2]=PKW(P1,12),pw3[3]=PKW(P1,14), pw3); \
    l_reg+=sacc; \
    if(GK){DMA_K((t)+3,sl_cur);} if(GV){DMA_V((t)+1,sl_next);} \
    CMASK(C0,C1,t); \
    if(GM){ float a=MX3(C0[0],C0[1],C1[0]),b=MX3(C0[2],C0[3],C1[1]); a=MX3(a,C1[2],C1[3]); \
      _Pragma("unroll") for(int r=4;r<16;r+=4){a=MX3(a,C0[r],C0[r+1]);b=MX3(b,C0[r+2],C0[r+3]);a=MX3(a,C1[r],C1[r+1]);b=MX3(b,C1[r+2],C1[r+3]);} \
      float rm=__builtin_fmaxf(a,b); { auto rr=__builtin_amdgcn_permlane32_swap(__float_as_uint(rm),__float_as_uint(rm),false,false); rm=__builtin_fmaxf(__uint_as_float(rr[0]),__uint_as_float(rr[1])); } \
      resc=false; \
      if(__builtin_expect(__any(rm>(float)THRL),0)){ const float dl=__builtin_fmaxf(rm,0.f); mhat+=dl; \
        _Pragma("unroll") for(int r=0;r<16;++r){C0[r]-=dl;C1[r]-=dl;} \
        _Pragma("unroll") for(int r=0;r<16;++r)negm[r]=-mhat; asm volatile("":"+v"(negm)); \
        const float f=__builtin_amdgcn_exp2f(-dl); l_reg*=f; if(hi==0)wsf[r32]=f; resc=true; } } else { resc=false; } \
    SBAR(); \
    GAPB(o[0]=__builtin_amdgcn_mfma_f32_32x32x16_bf16(PAF(0),VFR(0),o[0],0,0,0), C0,0); \
    GAPB(o[1]=__builtin_amdgcn_mfma_f32_32x32x16_bf16(PAF(0),VFR(4),o[1],0,0,0), C0,4); \
    KRD(GL,0); GAPB(o[0]=__builtin_amdgcn_mfma_f32_32x32x16_bf16(PAF(1),VFR(1),o[0],0,0,0), C0,8); \
    KRD(GL,1); GAPB(o[1]=__builtin_amdgcn_mfma_f32_32x32x16_bf16(PAF(1),VFR(5),o[1],0,0,0), C0,12); \
    KRD(GL,2); GAPB(o[0]=__builtin_amdgcn_mfma_f32_32x32x16_bf16(PAF(2),VFR(2),o[0],0,0,0), C1,0); \
    KRD(GL,3); GAPB(o[1]=__builtin_amdgcn_mfma_f32_32x32x16_bf16(PAF(2),VFR(6),o[1],0,0,0), C1,4); \
    GAPB(o[0]=__builtin_amdgcn_mfma_f32_32x32x16_bf16(PAF(3),VFR(3),o[0],0,0,0), C1,8); \
    GAPB(o[1]=__builtin_amdgcn_mfma_f32_32x32x16_bf16(PAF(3),VFR(7),o[1],0,0,0), C1,12); \
    }while(0)
  int t=1;
  #undef CMASK
  #define CMASK(P0,P1,t) do{}while(0)
  for(;t+5<NT;t+=2){
    STEP(pB0,pB1,pA0,pA1,t,true,true,true,((t&2)==0));     WAIT_BAR(2); RESC(); ROT();
    STEP(pA0,pA1,pB0,pB1,t+1,true,true,true,false);   WAIT_BAR(2); ROT();
  }
  #undef CMASK
  #define CMASK(P0,P1,t) do{}while(0)
  #define ENDW(tt) do{ if((tt)+3<NT){WAIT_BAR(2);} else if((tt)+2<NT){WAIT_BAR(1);} else {WAIT_BAR(0);} }while(0)
  for(;t+1<NT;t+=2){
    STEP(pB0,pB1,pA0,pA1,t,(t+3<NT),(t+1<NT),(t+1<NT),true);       ENDW(t);   RESC(); ROT();
    STEP(pA0,pA1,pB0,pB1,t+1,(t+4<NT),(t+2<NT),(t+2<NT),true);     ENDW(t+1); RESC(); ROT();
  }
  STEP(pB0,pB1,pA0,pA1,NT-1,false,false,false,true); RESC();
  { float sacc=pB0[0]+pB0[1]; _Pragma("unroll") for(int r=2;r<16;++r)sacc+=pB0[r]; _Pragma("unroll") for(int r=0;r<16;++r)sacc+=pB1[r]; l_reg+=sacc;
    pw0=(u32x4){PKW(pB0,0),PKW(pB0,2),PKW(pB0,4),PKW(pB0,6)};pw1=(u32x4){PKW(pB0,8),PKW(pB0,10),PKW(pB0,12),PKW(pB0,14)};pw2=(u32x4){PKW(pB1,0),PKW(pB1,2),PKW(pB1,4),PKW(pB1,6)};pw3=(u32x4){PKW(pB1,8),PKW(pB1,10),PKW(pB1,12),PKW(pB1,14)};
    SBAR(); pv(o,vb0+sl_cur,PAF(0),PAF(1),PAF(2),PAF(3)); }
  #undef PKW
  #undef PAF
  #undef VFR
  #undef PIN
  #undef MX3
  #undef GAPA
  #undef GAPB
  #undef EX
  #undef VRD
  #undef KRD
  #undef STEP
  #undef ENDW
  {auto rr=__builtin_amdgcn_permlane32_swap(__float_as_uint(l_reg),__float_as_uint(l_reg),false,false);l_reg=__uint_as_float(rr[0])+__uint_as_float(rr[1]);}
  if(hi==0)wsf[32+r32]=l_reg;asm volatile("s_waitcnt lgkmcnt(0)":::"memory");
  float rli[16];
  #pragma unroll
  for(int r=0;r<16;++r)rli[r]=__builtin_amdgcn_rcpf(wsf[32+crow(r,hi)]);
  bf16*Ow=Oh+(long)(q0+wid*QBLK)*po;
  { bf16*stg=(bf16*)(shm+LDS_OST)+wid*2048;
    #pragma unroll
    for(int r=0;r<16;++r){const int orow=crow(r,hi);
      #pragma unroll
      for(int d0=0;d0<2;++d0)stg[orow*64+d0*32+r32]=__float2bfloat16(o[d0][r]*rli[r]);}
    asm volatile("s_waitcnt lgkmcnt(0)":::"memory");
    #pragma unroll
    for(int i=0;i<4;++i){const int row=i*8+(lane>>3),ch=lane&7; const u32x4 v=*(const u32x4*)(stg+row*64+ch*8); ATTN_STORE16(Ow+(long)row*po+ch*8,v);} }
  asm volatile("s_waitcnt lgkmcnt(0)\n\ts_barrier":::"memory");
  #undef DMA_K
  #undef DMA_V
  #undef CMASK
  #undef START
  #undef RESC
  #undef ROT
}
#undef SBAR
#undef WAIT_BAR
}
namespace attn128 {
using bf16 = __hip_bfloat16;
using bf16x8 = __attribute__((ext_vector_type(8))) short;
using s16x4  = __attribute__((ext_vector_type(4))) short;
using f32x16 = __attribute__((ext_vector_type(16))) float;
using u32x4  = __attribute__((ext_vector_type(4))) unsigned;
constexpr int NW = 8, QBLK = 32, KVBLK = 64, SEQ = 8192;
constexpr float THR = 8.f;
constexpr size_t SHM_V = KVBLK * 128 * 2, SHM_K = KVBLK * 64 * 2, SHM_ATTN = 2 * SHM_V + 2 * SHM_K + NW * 64 * 4;
#define KSWZ64(row, colB) ((row) * 128 + ((colB) ^ ((((row) >> 1) & 7) << 4)))
#define SBAR() __builtin_amdgcn_sched_barrier(0)
#define WGBAR() asm volatile("s_waitcnt lgkmcnt(0)\n\ts_barrier" ::: "memory")
__device__ __forceinline__ int crow(int r, int hi) { return (r & 3) + 8 * (r >> 2) + 4 * hi; }
__device__ __forceinline__ unsigned cvtpk(float lo, float hi) { unsigned r; asm volatile("v_cvt_pk_bf16_f32 %0, %1, %2" : "=v"(r) : "v"(lo), "v"(hi)); return r; }
__device__ __forceinline__ void partialSM_nocheck(f32x16& p0, float& alpha) {
  alpha = 1.f;
#pragma unroll
  for (int r = 0; r < 16; ++r) p0[r] = __builtin_amdgcn_exp2f(p0[r]);
}
template <bool FIRST> __device__ __forceinline__ void partialSM(f32x16& p0, f32x16& p1, float& m_reg, f32x16& negm, float& alpha, const bool chk = true) {
  alpha = 1.f;
  if (chk) {
  float pmax = p0[0];
#pragma unroll
  for (int r = 1; r < 16; ++r) pmax = fmaxf(pmax, p0[r]);
#pragma unroll
  for (int r = 0; r < 16; ++r) pmax = fmaxf(pmax, p1[r]);
  { auto rr = __builtin_amdgcn_permlane32_swap(__float_as_uint(pmax), __float_as_uint(pmax), false, false);
    pmax = fmaxf(__uint_as_float(rr[0]), __uint_as_float(rr[1])); }
  if (FIRST || !__builtin_expect(__all(pmax <= THR), 1)) { const float d = FIRST ? pmax : fmaxf(pmax, 0.f); alpha = FIRST ? 1.f : __builtin_amdgcn_exp2f(-d); m_reg += d;
#pragma unroll
    for (int r = 0; r < 16; ++r) { p0[r] -= d; p1[r] -= d; }
#pragma unroll
    for (int r = 0; r < 16; ++r) negm[r] = -m_reg;
    asm volatile("" : "+v"(negm)); }
  }
#pragma unroll
  for (int r = 0; r < 16; ++r) p0[r] = __builtin_amdgcn_exp2f(p0[r]);
}
__device__ __forceinline__ void finishSM(f32x16& p0, f32x16& p1, float alpha, float& l_reg, bf16x8& pa0, bf16x8& pa1, bf16x8& pa2, bf16x8& pa3) {
#pragma unroll
  for (int r = 0; r < 16; ++r) p1[r] = __builtin_amdgcn_exp2f(p1[r]);
  float ps = 0;
#pragma unroll
  for (int r = 0; r < 16; ++r) ps += p0[r];
#pragma unroll
  for (int r = 0; r < 16; ++r) ps += p1[r];
  { auto rr = __builtin_amdgcn_permlane32_swap(__float_as_uint(ps), __float_as_uint(ps), false, false);
    ps = __uint_as_float(rr[0]) + __uint_as_float(rr[1]); }
  l_reg = l_reg * alpha + ps;
#define PK4(P, BASE, OUT) do { unsigned a0 = cvtpk(P[BASE + 0], P[BASE + 1]), a1 = cvtpk(P[BASE + 2], P[BASE + 3]);   \
    unsigned b0 = cvtpk(P[BASE + 4], P[BASE + 5]), b1 = cvtpk(P[BASE + 6], P[BASE + 7]);                              \
    auto r0 = __builtin_amdgcn_permlane32_swap(a0, b0, false, false); auto r1 = __builtin_amdgcn_permlane32_swap(a1, b1, false, false); \
    u32x4 w = {r0[0], r1[0], r0[1], r1[1]}; OUT = *reinterpret_cast<bf16x8*>(&w); } while (0)
  PK4(p0, 0, pa0); PK4(p0, 8, pa1); PK4(p1, 0, pa2); PK4(p1, 8, pa3);
#undef PK4
}
__device__ __forceinline__ void qkt(f32x16& p0, f32x16& p1, const char* Ks, const bf16x8* qr, const f32x16& negm, int r32, int hi) {
  p0 = negm; p1 = negm;
#pragma unroll
  for (int d0 = 0; d0 < 4; ++d0) { const int cb = (d0 * 16 + hi * 8) * 2;
    bf16x8 b0 = *reinterpret_cast<const bf16x8*>(Ks + KSWZ64(r32, cb));
    bf16x8 b1 = *reinterpret_cast<const bf16x8*>(Ks + KSWZ64(32 + r32, cb));
    p0 = __builtin_amdgcn_mfma_f32_32x32x16_bf16(b0, qr[d0], p0, 0, 0, 0);
    p1 = __builtin_amdgcn_mfma_f32_32x32x16_bf16(b1, qr[d0], p1, 0, 0, 0); }
}
__device__ __forceinline__ int v_st(int k, int c) { const int kk = (k & ~0xC) | ((k & 4) << 1) | ((k & 8) >> 1); return ((kk >> 3) * 4 + (c >> 5)) * 512 + ((kk & 7) * 32 + (c & 31)) * 2; }
__device__ __forceinline__ int v_rd_base(int lane) { return ((lane & 3) << 3) | (((lane >> 2) & 3) << 6) | (((lane >> 4) & 1) << 5) | (((lane >> 5) & 1) << 8); }
constexpr int v_rd_off(int d0, int ks, int half) { return d0 * 512 + ks * 4096 + half * 2048; }
template <int OFF> __device__ __forceinline__ s16x4 tr_read(int vb) { s16x4 r; asm volatile("ds_read_b64_tr_b16 %0, %1 offset:%2" : "=&v"(r) : "v"(vb), "i"(OFF) : "memory"); return r; }
template <int D0> __device__ __forceinline__ void pv_one(f32x16& od, int vb, bf16x8 pa0, bf16x8 pa1, bf16x8 pa2, bf16x8 pa3) {
  const s16x4 l0 = tr_read<v_rd_off(D0, 0, 0)>(vb), h0 = tr_read<v_rd_off(D0, 0, 1)>(vb), l1 = tr_read<v_rd_off(D0, 1, 0)>(vb), h1 = tr_read<v_rd_off(D0, 1, 1)>(vb);
  const s16x4 l2 = tr_read<v_rd_off(D0, 2, 0)>(vb), h2 = tr_read<v_rd_off(D0, 2, 1)>(vb), l3 = tr_read<v_rd_off(D0, 3, 0)>(vb), h3 = tr_read<v_rd_off(D0, 3, 1)>(vb);
  asm volatile("s_waitcnt lgkmcnt(0)" ::: "memory"); SBAR();
#define PK(L, H) (bf16x8){L[0], L[1], L[2], L[3], H[0], H[1], H[2], H[3]}
  od = __builtin_amdgcn_mfma_f32_32x32x16_bf16(pa0, PK(l0, h0), od, 0, 0, 0);
  od = __builtin_amdgcn_mfma_f32_32x32x16_bf16(pa1, PK(l1, h1), od, 0, 0, 0);
  od = __builtin_amdgcn_mfma_f32_32x32x16_bf16(pa2, PK(l2, h2), od, 0, 0, 0);
  od = __builtin_amdgcn_mfma_f32_32x32x16_bf16(pa3, PK(l3, h3), od, 0, 0, 0);
#undef PK
}
#define PV_RD(F, D0) do { F[0] = tr_read<v_rd_off(D0, 0, 0)>(vb); F[1] = tr_read<v_rd_off(D0, 0, 1)>(vb); F[2] = tr_read<v_rd_off(D0, 1, 0)>(vb); F[3] = tr_read<v_rd_off(D0, 1, 1)>(vb); \
    F[4] = tr_read<v_rd_off(D0, 2, 0)>(vb); F[5] = tr_read<v_rd_off(D0, 2, 1)>(vb); F[6] = tr_read<v_rd_off(D0, 3, 0)>(vb); F[7] = tr_read<v_rd_off(D0, 3, 1)>(vb); } while (0)
#define PV_PK(L, H) (bf16x8){L[0], L[1], L[2], L[3], H[0], H[1], H[2], H[3]}
#define PV_MF(OD, F) do { OD = __builtin_amdgcn_mfma_f32_32x32x16_bf16(pa0, PV_PK(F[0], F[1]), OD, 0, 0, 0); OD = __builtin_amdgcn_mfma_f32_32x32x16_bf16(pa1, PV_PK(F[2], F[3]), OD, 0, 0, 0); \
    OD = __builtin_amdgcn_mfma_f32_32x32x16_bf16(pa2, PV_PK(F[4], F[5]), OD, 0, 0, 0); OD = __builtin_amdgcn_mfma_f32_32x32x16_bf16(pa3, PV_PK(F[6], F[7]), OD, 0, 0, 0); } while (0)
__device__ __forceinline__ void pv_d0(f32x16* o, int vb, bf16x8 pa0, bf16x8 pa1, bf16x8 pa2, bf16x8 pa3) {
  s16x4 fa[8], fb[8];
  PV_RD(fa, 0); PV_RD(fb, 1);
  asm volatile("s_waitcnt lgkmcnt(8)" ::: "memory"); SBAR();
  PV_MF(o[0], fa); SBAR();
  PV_RD(fa, 2);
  asm volatile("s_waitcnt lgkmcnt(8)" ::: "memory"); SBAR();
  PV_MF(o[1], fb); SBAR();
  PV_RD(fb, 3);
  asm volatile("s_waitcnt lgkmcnt(8)" ::: "memory"); SBAR();
  PV_MF(o[2], fa); SBAR();
  asm volatile("s_waitcnt lgkmcnt(0)" ::: "memory"); SBAR();
  PV_MF(o[3], fb);
}
#undef PV_RD
#undef PV_PK
#undef PV_MF
__device__ __forceinline__ void attn128_unit(int qb, const bf16* __restrict__ Qh0, const bf16* __restrict__ Kh0, const bf16* __restrict__ Vh, bf16* __restrict__ Oh,
                                             int pq, int pk, int pv_, int po, char* lds, int wave_s, float lam, const float* __restrict__ gdiff) {
#pragma nounroll
 for (int jmap = 0; jmap < 2; ++jmap) {
  const bf16* __restrict__ Qh = Qh0 + jmap * 64; const bf16* __restrict__ Kh = Kh0 + jmap * 64;
  int tid_ = wave_s * 64 + lane_id_v(); asm volatile("" : "+v"(tid_));
  const int tid = tid_, wid = wave_s, lane = tid & 63, r32 = lane & 31, hi = lane >> 5;
  char* V_lds = lds; char* K_lds = lds + 2 * SHM_V;
  float* ws = (float*)(lds + 2 * SHM_V + 2 * SHM_K) + wid * 64; float* li_l = ws; float* al_l = ws + 32;
  float m_reg = 0.f, l_reg = 0; bf16x8 qr[4];
  float z_ = 0.f; asm volatile("" : "+v"(z_));
  f32x16 negm, o[4];
#pragma unroll
  for (int r = 0; r < 16; ++r) { negm[r] = z_; o[0][r] = z_; o[1][r] = z_; o[2][r] = z_; o[3][r] = z_; }
  asm volatile("" : "+v"(negm));
  const bf16* Qw = Qh + (long)(qb * 256 + wid * QBLK + r32) * pq + hi * 8;
#pragma unroll
  for (int d0 = 0; d0 < 4; ++d0) qr[d0] = *reinterpret_cast<const bf16x8*>(Qw + d0 * 16);
  const int sr = tid >> 4, sc = (tid & 15) * 8, vst0 = v_st(sr, sc), vst1 = v_st(32 + sr, sc);
  const int kr = tid >> 3, kc = (tid & 7) * 8, kst = KSWZ64(kr, kc * 2);
  const int vb0 = (int)(uintptr_t)V_lds + v_rd_base(lane);
  struct { bf16x8 vs0, vs1, ks0; } sr_[2];
#define SLOAD(i, k0) do { sr_[i].vs0 = *reinterpret_cast<const bf16x8*>(&Vh[(long)((k0) + sr) * pv_ + sc]); sr_[i].vs1 = *reinterpret_cast<const bf16x8*>(&Vh[(long)((k0) + 32 + sr) * pv_ + sc]); \
    sr_[i].ks0 = *reinterpret_cast<const bf16x8*>(&Kh[(long)((k0) + kr) * pk + kc]); } while (0)
#define SWRITE(b, i) do { *(bf16x8*)(V_lds + (b) * SHM_V + vst0) = sr_[i].vs0; *(bf16x8*)(V_lds + (b) * SHM_V + vst1) = sr_[i].vs1; \
    *(bf16x8*)(K_lds + (b) * SHM_K + kst) = sr_[i].ks0; } while (0)
#define SWAIT() asm volatile("s_waitcnt vmcnt(3)" ::: "memory")
#define RESC(a) do { if (__any((a) < 1.f)) { if (hi == 0) al_l[r32] = (a); asm volatile("s_waitcnt lgkmcnt(0)" ::: "memory"); \
    _Pragma("unroll") for (int d = 0; d < 4; ++d) _Pragma("unroll") for (int r = 0; r < 16; ++r) o[d][r] *= al_l[crow(r, hi)]; } } while (0)
  f32x16 pA0, pA1, pB0, pB1; float alA, alB; bf16x8 pa0, pa1, pa2, pa3; constexpr int NT = SEQ / KVBLK;
  constexpr int SE = 0, SO = 1;
  SLOAD(SE, 0); asm volatile("s_waitcnt vmcnt(0)" ::: "memory"); SWRITE(0, SE); WGBAR();
  qkt(pA0, pA1, K_lds, qr, negm, r32, hi); partialSM<true>(pA0, pA1, m_reg, negm, alA);
  SLOAD(SO, KVBLK); SLOAD(SE, 2 * KVBLK);
  SWAIT(); SWRITE(1, SO); WGBAR();
  for (int j = 1; j + 1 < NT; j += 2) {
    SBAR(); qkt(pB0, pB1, K_lds + SHM_K, qr, negm, r32, hi);
    finishSM(pA0, pA1, alA, l_reg, pa0, pa1, pa2, pa3); SBAR();
    SLOAD(SO, (j + 2) * KVBLK); SBAR();
    pv_d0(o, vb0, pa0, pa1, pa2, pa3); partialSM<false>(pB0, pB1, m_reg, negm, alB, (j & 2) == 0);
    WGBAR(); SWAIT(); SWRITE(0, SE);
    RESC(alB); WGBAR();
    SBAR(); qkt(pA0, pA1, K_lds, qr, negm, r32, hi);
    finishSM(pB0, pB1, alB, l_reg, pa0, pa1, pa2, pa3); SBAR();
    if (j + 3 < NT) SLOAD(SE, (j + 3) * KVBLK); SBAR();
    pv_d0(o, vb0 + (int)SHM_V, pa0, pa1, pa2, pa3); partialSM_nocheck(pA0, alA);
    WGBAR(); SWAIT(); SWRITE(1, SO);
    RESC(alA); WGBAR();
  }
  SBAR(); qkt(pB0, pB1, K_lds + SHM_K, qr, negm, r32, hi);
  finishSM(pA0, pA1, alA, l_reg, pa0, pa1, pa2, pa3); SBAR();
  pv_d0(o, vb0, pa0, pa1, pa2, pa3); partialSM<false>(pB0, pB1, m_reg, negm, alB);
  WGBAR(); RESC(alB);
  finishSM(pB0, pB1, alB, l_reg, pa0, pa1, pa2, pa3); SBAR();
  pv_d0(o, vb0 + (int)SHM_V, pa0, pa1, pa2, pa3);
  if (hi == 0) li_l[r32] = l_reg; asm volatile("s_waitcnt lgkmcnt(0)" ::: "memory");
  float rli[16];
#pragma unroll
  for (int r = 0; r < 16; ++r) rli[r] = __builtin_amdgcn_rcpf(li_l[crow(r, hi)]);
  unsigned short* stash = (unsigned short*)(lds + SHM_ATTN) + wid * 4096;
  if (jmap == 0) {
#pragma unroll
    for (int r = 0; r < 16; ++r) { const int orow = crow(r, hi);
#pragma unroll
      for (int d0 = 0; d0 < 4; ++d0) { const bf16 v = __float2bfloat16(o[d0][r] * rli[r]); stash[orow * 128 + d0 * 32 + r32] = __builtin_bit_cast(unsigned short, v); } }
  } else {
    float ssq[16];
#pragma unroll
    for (int r = 0; r < 16; ++r) { const int orow = crow(r, hi); float q = 0.f;
#pragma unroll
      for (int d0 = 0; d0 < 4; ++d0) { const float o1 = __uint_as_float((unsigned)stash[orow * 128 + d0 * 32 + r32] << 16); const float v = o1 - lam * (o[d0][r] * rli[r]); o[d0][r] = v; q += v * v; }
      ssq[r] = q; }
#pragma unroll
    for (int msk = 1; msk < 32; msk <<= 1)
#pragma unroll
      for (int r = 0; r < 16; ++r) ssq[r] += shx(ssq[r], lane, msk);
    float gd[4];
#pragma unroll
    for (int d0 = 0; d0 < 4; ++d0) gd[d0] = gdiff[d0 * 32 + r32] * 0.8f;
    bf16* Ow = Oh + (long)(qb * 256 + wid * QBLK) * po;
#pragma unroll
    for (int r = 0; r < 16; ++r) { const int orow = crow(r, hi); const float rs = __builtin_amdgcn_rsqf(ssq[r] * (1.f / 128.f) + 1e-6f);
#pragma unroll
      for (int d0 = 0; d0 < 4; ++d0) Ow[(long)orow * po + d0 * 32 + r32] = __float2bfloat16(o[d0][r] * rs * gd[d0]); }
  }
  WGBAR();
 }
#undef SLOAD
#undef SWRITE
#undef SWAIT
#undef RESC
}
#undef KSWZ64
#undef SBAR
#undef WGBAR
}
#define LAS __attribute__((address_space(3)))
#define XB_TMO      128
#define XB_XCNT(j)  (256  + 64 * (j))
#define XB_XSUB(j)  (1280 + 64 * (j))
#define XB_XGEN(j)  (2304 + 64 * (j))
#define XB_TOP      3328
#define XB_TOPGEN   3392
#define XCD_BAR_WORDS 3456
#define XB_SPIN_CAP (1u << 18)

__device__ __forceinline__ unsigned xb_ld(unsigned* p)              { return __hip_atomic_load(p, __ATOMIC_RELAXED, __HIP_MEMORY_SCOPE_AGENT); }
__device__ __forceinline__ unsigned xb_add(unsigned* p, unsigned v) { return __hip_atomic_fetch_add(p, v, __ATOMIC_RELAXED, __HIP_MEMORY_SCOPE_AGENT); }
__device__ __forceinline__ unsigned xb_xcc_id() { return (unsigned)__builtin_amdgcn_s_getreg((3 << 11) | 20) & 0xFu; }
#define XB_SPIN(cond, bar) do { unsigned _sp = 0; while (cond) { __builtin_amdgcn_s_sleep(1); \
    if ((++_sp & 255u) == 0u) { if (xb_ld(&(bar)[XB_TMO])) break; if (_sp > XB_SPIN_CAP) { atomicAdd(&(bar)[XB_TMO], 1u); break; } } } } while (0)

struct XcdBarrier {
    unsigned* bar; unsigned x;
    volatile LAS unsigned* st; bool leader;
};

__device__ __forceinline__ XcdBarrier xcd_barrier_post(unsigned* bar, volatile LAS unsigned* st, bool leader) {
    XcdBarrier b; b.bar = bar; b.x = xb_xcc_id(); b.st = st; b.leader = leader;
    if (leader) (void)xb_add(&bar[XB_XCNT(b.x)], 1u);
    return b;
}
__device__ __forceinline__ void xcd_barrier_complete(unsigned* bar, unsigned x, unsigned& nloc, unsigned& nx) {
    const unsigned G = gridDim.x * gridDim.y * gridDim.z;
    unsigned sum, cnt, mine, sp = 0u;
    for (;;) {
        sum = 0u; cnt = 0u; mine = 0u;
#pragma unroll
        for (unsigned j = 0; j < 16; ++j) { const unsigned c = xb_ld(&bar[XB_XCNT(j)]); sum += c; cnt += (c > 0u) ? 1u : 0u; mine = (j == x) ? c : mine; }
        if (sum == G) break;
        __builtin_amdgcn_s_sleep(1);
        if ((++sp & 255u) == 0u) { if (xb_ld(&bar[XB_TMO])) break; if (sp > XB_SPIN_CAP) { atomicAdd(&bar[XB_TMO], 1u); break; } }
    }
    nloc = mine > 0u ? mine : 1u; nx = cnt > 0u ? cnt : 1u;
}

__device__ __forceinline__ void xcd_barrier(const XcdBarrier& b) {
    asm volatile("s_waitcnt vmcnt(0)" ::: "memory");
    __syncthreads();
    if (b.leader) {
        unsigned* bar = b.bar;
        __builtin_amdgcn_s_waitcnt(0);
        unsigned nloc = b.st[0], nx = b.st[1];
        if (nloc == 0u) { xcd_barrier_complete(bar, b.x, nloc, nx); b.st[0] = nloc; b.st[1] = nx; }
        const unsigned old = xb_add(&bar[XB_XSUB(b.x)], 1u);
        const unsigned gen = old / nloc;
        if (old + 1u == (gen + 1u) * nloc) {
            __builtin_amdgcn_fence(__ATOMIC_RELEASE, "agent");
            asm volatile("s_waitcnt vmcnt(0)" ::: "memory");
            const unsigned og = xb_add(&bar[XB_TOP], 1u);
            const unsigned tg = og / nx;
            if (og + 1u == (tg + 1u) * nx) xb_add(&bar[XB_TOPGEN], 1u);
            else XB_SPIN(xb_ld(&bar[XB_TOPGEN]) == tg, bar);
            __builtin_amdgcn_fence(__ATOMIC_ACQUIRE, "agent");
            xb_add(&bar[XB_XGEN(b.x)], 1u);
            asm volatile("s_waitcnt vmcnt(0)" ::: "memory");
        } else {
            XB_SPIN(xb_ld(&bar[XB_XGEN(b.x)]) == gen, bar);
            __builtin_amdgcn_fence(__ATOMIC_ACQUIRE, "agent");
            asm volatile("s_waitcnt vmcnt(0)" ::: "memory");
        }
    }
    __syncthreads();
}
#undef LAS
namespace cg = cooperative_groups;
#ifndef PG8_ALIGN1
#define PG8_ALIGN1 PG8_ALIGN
#endif
#ifndef PROBE_REP64
#define PROBE_REP64 1
#endif
#ifndef PROBE_REP128
#define PROBE_REP128 1
#endif
#ifndef NCHUNK_DEF
#define NCHUNK_DEF 3
#endif
constexpr int NWAVES = 8;
constexpr int SEQ = 8192, DM = 1024, MC = 16384  , NCHUNK = NCHUNK_DEF, NPROJ = 6656, DFF = 2816, NUP = 2 * DFF, PLE = 256;
constexpr int C_AQ = 0, C_AK = 1024, C_AV = 2048, C_BQ = 3072, C_BK = 4096, C_BV = 4352, C_GA = 4608, C_GB = 5632;
constexpr float EPS = 1e-6f;
constexpr float QSCALE = 0.125f * 1.4426950408889634f;
constexpr size_t MiB = 1u << 20;
constexpr size_t WS_SS = 420 * MiB;
constexpr size_t WS_TABA = 1 * MiB;
constexpr size_t WS_TABX = 1 * MiB + 512 * 1024;
constexpr size_t WS_WIN = 2 * MiB, WS_WA = 15 * MiB, WS_WB = 17 * MiB, WS_WOUT = 19 * MiB, WS_WUP = 21 * MiB, WS_WDN = 32 * MiB, WS_WPLE = 38 * MiB, WS_WPG = 39 * MiB;
constexpr size_t WS_XN = 42 * MiB;
constexpr size_t WS_PB = 74 * MiB;
constexpr size_t WS_PROJ = 82 * MiB;
constexpr size_t WS_U = WS_PROJ;
constexpr size_t WS_SG = WS_PROJ;
constexpr size_t WS_OA1 = 290 * MiB, WS_OA2 = 322 * MiB, WS_OB = 354 * MiB, WS_MG = WS_OA1  , WS_HS = 386 * MiB  ;
constexpr size_t WS_ACT = WS_OA1;
constexpr size_t WS_E = 424 * MiB;
constexpr size_t WS_XNB = 456 * MiB;
constexpr size_t WS_END = 488 * MiB;
constexpr int LDS_BYTES = 147456, MISC_OFF = 131072 + 320;
constexpr size_t WS_EPS = 1 * MiB + 800 * 1024;
constexpr size_t WS_BAR = 1 * MiB + 768 * 1024;

#define GAS __attribute__((address_space(1)))
#define LAS __attribute__((address_space(3)))
typedef unsigned short bf16_t;
typedef unsigned v4u __attribute__((ext_vector_type(4)));
typedef unsigned v2u __attribute__((ext_vector_type(2)));
typedef float f32x4 __attribute__((ext_vector_type(4)));
#define LDS_WAIT() asm volatile("s_waitcnt lgkmcnt(0)" ::: "memory")
__device__ __forceinline__ unsigned f2bf(float f) { unsigned u = __builtin_bit_cast(unsigned, f); return (u + 0x7fffu + ((u >> 16) & 1u)) >> 16; }
__device__ __forceinline__ unsigned pk2(float lo, float hi) { return f2bf(lo) | (f2bf(hi) << 16); }
__device__ __forceinline__ float wave_sum(float v, int lane) {
#pragma unroll
    for (int o = 1; o < 64; o <<= 1) v += shx(v, lane, o);
    return v;
}
__device__ __forceinline__ void unpack16(const v4u a, const v4u b, float (&x)[16]) {
    x[0] = pg8::bf_lo(a.x); x[1] = pg8::bf_hi(a.x); x[2] = pg8::bf_lo(a.y); x[3] = pg8::bf_hi(a.y); x[4] = pg8::bf_lo(a.z); x[5] = pg8::bf_hi(a.z); x[6] = pg8::bf_lo(a.w); x[7] = pg8::bf_hi(a.w);
    x[8] = pg8::bf_lo(b.x); x[9] = pg8::bf_hi(b.x); x[10] = pg8::bf_lo(b.y); x[11] = pg8::bf_hi(b.y); x[12] = pg8::bf_lo(b.z); x[13] = pg8::bf_hi(b.z); x[14] = pg8::bf_lo(b.w); x[15] = pg8::bf_hi(b.w);
}
__device__ __forceinline__ void pack16(const float (&x)[16], v4u& a, v4u& b) {
    a.x = pk2(x[0], x[1]); a.y = pk2(x[2], x[3]); a.z = pk2(x[4], x[5]); a.w = pk2(x[6], x[7]);
    b.x = pk2(x[8], x[9]); b.y = pk2(x[10], x[11]); b.z = pk2(x[12], x[13]); b.w = pk2(x[14], x[15]);
}

__device__ __forceinline__ void p0_transpose_item(const float* W, int K, int N, bf16_t* WT, LAS float* scr, int item, int lane, const float* kg = nullptr) {
    const int nblk = N / 32, kb = item / nblk, nb = item % nblk, k0 = 64 * kb, n0 = 32 * nb;
#pragma unroll 8
    for (int i = 0; i < 32; ++i) { const int kk = 2 * i + (lane >> 5); scr[kk * 33 + (lane & 31)] = W[(size_t)(k0 + kk) * N + n0 + (lane & 31)] * (kg ? kg[k0 + kk] : 1.0f); }
    LDS_WAIT(); asm volatile("" ::: "memory");
    const int c = lane & 7;
#pragma unroll
    for (int j = 0; j < 4; ++j) { const int n = (lane >> 3) + 8 * j; const LAS float* s = scr + (8 * c) * 33 + n;
        v4u o; o.x = pk2(s[0 * 33], s[1 * 33]); o.y = pk2(s[2 * 33], s[3 * 33]); o.z = pk2(s[4 * 33], s[5 * 33]); o.w = pk2(s[6 * 33], s[7 * 33]);
        *(GAS v4u*)(WT + (size_t)(n0 + n) * K + k0 + 8 * c) = o; }
    LDS_WAIT(); asm volatile("" ::: "memory");
}

struct Ctx {
    int vcu, G, wave_s;
};
__device__ __forceinline__ unsigned long long karg(int i) { const __attribute__((address_space(4))) unsigned long long* ka = (const __attribute__((address_space(4))) unsigned long long*)__builtin_amdgcn_kernarg_segment_ptr(); asm volatile("" : "+s"(ka)); return ka[i]; }
#define KIN(i) ((const float*)karg(i))
#define KOUT() ((float*)karg(25))
#define KWS() ((unsigned char*)karg(26))

__device__ __forceinline__ void phase_prologue(const Ctx& F, LAS unsigned char* lds) {
    int tid_ = F.wave_s * 64 + lane_id_v(); asm volatile("" : "+v"(tid_)); const int tid = tid_, lane = tid & 63, wave = F.wave_s, gw = F.vcu * NWAVES + wave, NGW = F.G * NWAVES; (void)lane; (void)gw; (void)NGW;
    unsigned char* const ws = KWS(); (void)ws;
    const int gt = F.vcu * (NWAVES * 64) + tid, NGT = F.G * NWAVES * 64;
    {
        float* tab = (float*)(ws + WS_TABA);
        for (int i = gt; i < SEQ * 8; i += NGT) { const int pos = i >> 3, k = i & 7;
            const float inv = k == 0 ? 1.0f : k == 1 ? 0.19392274474868576f : k == 2 ? 0.03760603093086393f : k == 3 ? 0.007292664737217109f : k == 4 ? 0.001414213562373095f : k == 5 ? 0.0002742481756762073f : k == 6 ? 5.318295896944988e-05f : 1.031338537721246e-05f;
            const float ang = (float)pos * inv; double rev = (double)ang * 0.15915494309189535; rev -= __builtin_floor(rev); const float r = (float)rev;
            tab[pos * 16 + k] = __builtin_amdgcn_cosf(r); tab[pos * 16 + 8 + k] = __builtin_amdgcn_sinf(r); }
    }
    {
        float* tab = (float*)(ws + WS_TABX);
        for (int i = gt; i < 128 * 16; i += NGT) { const int pos = i >> 4, k = i & 15;
            const float inv = __builtin_amdgcn_exp2f(-(float)k * (13.287712379549449f / 16.0f));
            const float ang = (float)pos * inv; double rev = (double)ang * 0.15915494309189535; rev -= __builtin_floor(rev); const float r = (float)rev;
            tab[pos * 32 + k] = __builtin_amdgcn_cosf(r); tab[pos * 32 + 16 + k] = __builtin_amdgcn_sinf(r); }
    }
    LAS float* scr = (LAS float*)(lds + wave * 16384);
    constexpr int I_IN = (DM / 64) * (NPROJ / 32), I_SQ = (DM / 64) * (DM / 32), I_UP = (DM / 64) * (NUP / 32), I_DN = (DFF / 64) * (DM / 32), I_PLE = (PLE / 64) * (DM / 32);
    constexpr int NITEMS = I_IN + 4 * I_SQ + I_UP + I_DN + I_PLE;
    for (int it = gw; it < NITEMS; it += NGW) {
        int r = it;
        if (r < I_IN) { p0_transpose_item(KIN(5), DM, NPROJ, (bf16_t*)(ws + WS_WIN), scr, r, lane); continue; } r -= I_IN;
        if (r < I_SQ) { p0_transpose_item(KIN(11), DM, DM, (bf16_t*)(ws + WS_WA), scr, r, lane); continue; } r -= I_SQ;
        if (r < I_SQ) { p0_transpose_item(KIN(14), DM, DM, (bf16_t*)(ws + WS_WB), scr, r, lane); continue; } r -= I_SQ;
        if (r < I_SQ) { p0_transpose_item(KIN(15), DM, DM, (bf16_t*)(ws + WS_WOUT), scr, r, lane); continue; } r -= I_SQ;
        if (r < I_SQ) { p0_transpose_item(KIN(23), DM, DM, (bf16_t*)(ws + WS_WPG), scr, r, lane, KIN(22)); continue; } r -= I_SQ;
        if (r < I_UP) { p0_transpose_item(KIN(17), DM, NUP, (bf16_t*)(ws + WS_WUP), scr, r, lane, KIN(16)); continue; } r -= I_UP;
        if (r < I_DN) { p0_transpose_item(KIN(20), DFF, DM, (bf16_t*)(ws + WS_WDN), scr, r, lane); continue; } r -= I_DN;
        p0_transpose_item(KIN(21), PLE, DM, (bf16_t*)(ws + WS_WPLE), scr, r, lane);
    }
}

__device__ __forceinline__ void phase_prep(const Ctx& F, const float* x, const float* p) {
    int tid_ = F.wave_s * 64 + lane_id_v(); asm volatile("" : "+v"(tid_)); const int tid = tid_, lane = tid & 63, wave = F.wave_s, gw = F.vcu * NWAVES + wave, NGW = F.G * NWAVES; (void)lane; (void)gw; (void)NGW;
    unsigned char* const ws = KWS(); (void)ws;
    const float* g = KIN(4);
    bf16_t* XN = (bf16_t*)(ws + WS_XN); bf16_t* PB = (bf16_t*)(ws + WS_PB);
    f32x4 gv[4];
#pragma unroll
    for (int j = 0; j < 4; ++j) gv[j] = ((const f32x4*)g)[lane + 64 * j];
    for (int m0 = gw * 4; m0 < MC; m0 += NGW * 4) {
        f32x4 v[4][4], pv[4];
#pragma unroll
        for (int r = 0; r < 4; ++r) { const f32x4* xr = (const f32x4*)(x + (size_t)(m0 + r) * DM) + lane;
#pragma unroll
            for (int j = 0; j < 4; ++j) v[r][j] = xr[64 * j];
            pv[r] = ((const f32x4*)(p + (size_t)(m0 + r) * PLE))[lane]; }
#pragma unroll
        for (int r = 0; r < 4; ++r) { float s = 0.f;
#pragma unroll
            for (int j = 0; j < 4; ++j) s += (v[r][j].x * v[r][j].x + v[r][j].y * v[r][j].y) + (v[r][j].z * v[r][j].z + v[r][j].w * v[r][j].w);
            const float rstd = __builtin_amdgcn_rsqf(wave_sum(s, lane) * (1.f / DM) + EPS);
            v2u* o8 = (v2u*)(XN + (size_t)(m0 + r) * DM) + lane;
#pragma unroll
            for (int j = 0; j < 4; ++j) { const f32x4 y = v[r][j] * rstd * gv[j]; v2u w; w.x = pk2(y.x, y.y); w.y = pk2(y.z, y.w); o8[64 * j] = w; }
            { v2u w; w.x = pk2(pv[r].x, pv[r].y); w.y = pk2(pv[r].z, pv[r].w); ((v2u*)(PB + (size_t)(m0 + r) * PLE))[lane] = w; } }
    }
}

__device__ __forceinline__ void phase_rope(const Ctx& F) {
    int tid_ = F.wave_s * 64 + lane_id_v(); asm volatile("" : "+v"(tid_)); const int tid = tid_, lane = tid & 63, wave = F.wave_s, gw = F.vcu * NWAVES + wave, NGW = F.G * NWAVES; (void)lane; (void)gw; (void)NGW;
    unsigned char* const ws = KWS(); (void)ws;
    bf16_t* PROJ = (bf16_t*)(ws + WS_PROJ);
    const float* tabA = (const float*)(ws + WS_TABA); const float* tabX = (const float*)(ws + WS_TABX);
    const int q4 = lane & 3;
    float gq[16], gk[16];
#pragma unroll
    for (int k = 0; k < 16; ++k) { gq[k] = KIN(12)[q4 * 16 + k]; gk[k] = KIN(13)[q4 * 16 + k]; }
    const float sgn = (q4 & 1) ? 1.f : -1.f;
    for (int m = gw; m < MC; m += NGW) {
        const int t = m & (SEQ - 1);
        bf16_t* row = PROJ + (size_t)m * NPROJ;
        v4u* paq = (v4u*)(row + C_AQ + (lane & ~3) * 16); v4u* pak = (v4u*)(row + C_AK + (lane & ~3) * 16); v4u* pbq = (v4u*)(row + C_BQ + lane * 16); v4u* pbk = (v4u*)(row + C_BK + (lane & 15) * 16);
        v4u aq0 = paq[0], aq1 = paq[1], ak0 = pak[0], ak1 = pak[1], bq0 = pbq[0], bq1 = pbq[1], bk0 = pbk[0], bk1 = pbk[1];
        float c8[8], s8[8], cx[16], sx[16];
        { const f32x4* tp = (const f32x4*)(tabA + t * 16); const f32x4 a = tp[0], b = tp[1], c = tp[2], d = tp[3];
          c8[0] = a.x; c8[1] = a.y; c8[2] = a.z; c8[3] = a.w; c8[4] = b.x; c8[5] = b.y; c8[6] = b.z; c8[7] = b.w;
          s8[0] = c.x; s8[1] = c.y; s8[2] = c.z; s8[3] = c.w; s8[4] = d.x; s8[5] = d.y; s8[6] = d.z; s8[7] = d.w; }
        { const int pos = (q4 < 2) ? (t >> 6) : (t & 63); const f32x4* tp = (const f32x4*)(tabX + pos * 32);
#pragma unroll
          for (int j = 0; j < 4; ++j) { const f32x4 a = tp[j], b = tp[4 + j]; cx[4 * j] = a.x; cx[4 * j + 1] = a.y; cx[4 * j + 2] = a.z; cx[4 * j + 3] = a.w; sx[4 * j] = b.x; sx[4 * j + 1] = b.y; sx[4 * j + 2] = b.z; sx[4 * j + 3] = b.w; } }
        asm volatile("" ::: "memory");
        if (q4 == 0) {
            float x[16]; unpack16(aq0, aq1, x);
#pragma unroll
            for (int i = 0; i < 8; ++i) { const float x1 = x[i], x2 = x[8 + i]; x[i] = x1 * c8[i] - x2 * s8[i]; x[8 + i] = x2 * c8[i] + x1 * s8[i]; }
            pack16(x, aq0, aq1); paq[0] = aq0; paq[1] = aq1;
        }
        {
            float x[16]; unpack16(ak0, ak1, x);
#pragma unroll
            for (int i = 0; i < 8; ++i) { const float x1 = x[i], x2 = x[8 + i]; x[i] = x1 * c8[i] - x2 * s8[i]; x[8 + i] = x2 * c8[i] + x1 * s8[i]; }
            if (q4 == 0) { pack16(x, ak0, ak1); pak[0] = ak0; pak[1] = ak1; }
        }
        {
            float x[16]; unpack16(bq0, bq1, x);
            float sq = 0.f;
#pragma unroll
            for (int i = 0; i < 16; ++i) sq += x[i] * x[i];
            sq += shx(sq, lane, 1); sq += shx(sq, lane, 2);
            const float r = __builtin_amdgcn_rsqf(sq * (1.f / 64.f) + EPS);
#pragma unroll
            for (int i = 0; i < 16; ++i) x[i] = x[i] * r * gq[i];
#pragma unroll
            for (int i = 0; i < 16; ++i) { const float o = shx(x[i], lane, 1); x[i] = (x[i] * cx[i] + sgn * o * sx[i]) * QSCALE; }
            pack16(x, bq0, bq1); pbq[0] = bq0; pbq[1] = bq1;
        }
        {
            float x[16]; unpack16(bk0, bk1, x);
            float sq = 0.f;
#pragma unroll
            for (int i = 0; i < 16; ++i) sq += x[i] * x[i];
            sq += shx(sq, lane, 1); sq += shx(sq, lane, 2);
            const float r = __builtin_amdgcn_rsqf(sq * (1.f / 64.f) + EPS);
#pragma unroll
            for (int i = 0; i < 16; ++i) x[i] = x[i] * r * gk[i];
#pragma unroll
            for (int i = 0; i < 16; ++i) { const float o = shx(x[i], lane, 1); x[i] = x[i] * cx[i] + sgn * o * sx[i]; }
            if (lane < 16) { pack16(x, bk0, bk1); pbk[0] = bk0; pbk[1] = bk1; }
        }
    }
}

__device__ __forceinline__ void phase_attn(const Ctx& F, char* lds) {
    using abf = attn_body::bf16;
    unsigned char* const ws = KWS();
    abf* PROJ = (abf*)(ws + WS_PROJ); abf* OA1 = (abf*)(ws + WS_OA1); abf* OB = (abf*)(ws + WS_OB);
    float lam;
    { const int lane = lane_id_v(); const float s1 = wave_sum(KIN(6)[lane] * KIN(7)[lane], lane), s2 = wave_sum(KIN(8)[lane] * KIN(9)[lane], lane); lam = __expf(s1) - __expf(s2) + 0.2f; }
    const float* gdiff = KIN(10);
    if (F.wave_s >= 4) __builtin_amdgcn_s_setprio(1);
    for (int i = 0;; ++i) {
        const int L = i * F.G + F.vcu; if (L >= 1536) break;
        if (L < 1024) { for (int rep = 0; rep < PROBE_REP64; ++rep) { const int i4 = (L >> 8) & 3, v = L & 255, g = v >> 3, s = v & 7, qb = i4 * 8 + s;
            const int qd = g >> 2, mem = g & 3, b = qd >> 2, kvh = qd & 3, qh = kvh * 4 + mem; const size_t r0 = (size_t)b * SEQ;
            attn_body::attn_unit<8>(qb, PROJ + r0 * NPROJ + C_BQ + qh * 64, PROJ + r0 * NPROJ + C_BK + kvh * 64, PROJ + r0 * NPROJ + C_BV + kvh * 64, OB + r0 * DM + qh * 64, NPROJ, NPROJ, NPROJ, DM, lds, F.wave_s); }
        } else { for (int rep = 0; rep < PROBE_REP128; ++rep) { const int idx = L - 1024, i4 = idx >> 8, v = idx & 255, g = v >> 3, s = v & 7;
            const int bh = g >> 1, qb = (g & 1) * 16 + i4 * 8 + s, b = bh >> 3, h = bh & 7; const size_t r0 = (size_t)b * SEQ;
            attn128::attn128_unit(qb, PROJ + r0 * NPROJ + C_AQ + h * 128, PROJ + r0 * NPROJ + C_AK + h * 128, PROJ + r0 * NPROJ + C_AV + h * 128, OA1 + r0 * DM + h * 128, NPROJ, NPROJ, NPROJ, DM, lds, F.wave_s, lam, gdiff); } }
    }
    __builtin_amdgcn_s_setprio(0);
}

__device__ __forceinline__ void phase_diffnorm(const Ctx& F) {
    int tid_ = F.wave_s * 64 + lane_id_v(); asm volatile("" : "+v"(tid_)); const int tid = tid_, lane = tid & 63, wave = F.wave_s, gw = F.vcu * NWAVES + wave, NGW = F.G * NWAVES; (void)lane; (void)gw; (void)NGW;
    unsigned char* const ws = KWS(); (void)ws;
    bf16_t* OA1 = (bf16_t*)(ws + WS_OA1); const bf16_t* OA2 = (const bf16_t*)(ws + WS_OA2);
    const float s1 = wave_sum(KIN(6)[lane] * KIN(7)[lane], lane), s2 = wave_sum(KIN(8)[lane] * KIN(9)[lane], lane);
    const float lam = __expf(s1) - __expf(s2) + 0.2f;
    float gd[16];
#pragma unroll
    for (int k = 0; k < 16; ++k) gd[k] = KIN(10)[(lane & 7) * 16 + k] * 0.8f;
    for (int m0 = gw * 4; m0 < MC; m0 += NGW * 4) {
        v4u a[4], b[4], c[4], d[4];
#pragma unroll
        for (int r = 0; r < 4; ++r) { const v4u* pp = (const v4u*)(OA1 + (size_t)(m0 + r) * DM + lane * 16); const v4u* p2 = (const v4u*)(OA2 + (size_t)(m0 + r) * DM + lane * 16); a[r] = pp[0]; b[r] = pp[1]; c[r] = p2[0]; d[r] = p2[1]; }
        asm volatile("" ::: "memory");
#pragma unroll
        for (int r = 0; r < 4; ++r) {
            float x[16], y[16]; unpack16(a[r], b[r], x); unpack16(c[r], d[r], y);
            float s = 0.f;
#pragma unroll
            for (int i = 0; i < 16; ++i) { x[i] = x[i] - lam * y[i]; s += x[i] * x[i]; }
            s += shx(s, lane, 1); s += shx(s, lane, 2); s += shx(s, lane, 4);
            const float rr = __builtin_amdgcn_rsqf(s * (1.f / 128.f) + EPS);
#pragma unroll
            for (int i = 0; i < 16; ++i) x[i] = x[i] * rr * gd[i];
            v4u oa, ob; pack16(x, oa, ob); v4u* pp = (v4u*)(OA1 + (size_t)(m0 + r) * DM + lane * 16); pp[0] = oa; pp[1] = ob;
        }
    }
}

__device__ __forceinline__ float gelu_tanh(float x) { const float u = x + 0.044715f * x * x * x; return x * __builtin_amdgcn_rcpf(1.0f + __builtin_amdgcn_exp2f(-2.302208198f * u)); }
__device__ __forceinline__ void up8(const v4u a, float (&x)[8]) { x[0] = pg8::bf_lo(a.x); x[1] = pg8::bf_hi(a.x); x[2] = pg8::bf_lo(a.y); x[3] = pg8::bf_hi(a.y); x[4] = pg8::bf_lo(a.z); x[5] = pg8::bf_hi(a.z); x[6] = pg8::bf_lo(a.w); x[7] = pg8::bf_hi(a.w); }
__device__ __forceinline__ void phase_conv(const Ctx& F) {
    int tid_ = F.wave_s * 64 + lane_id_v(); asm volatile("" : "+v"(tid_)); const int tid = tid_, lane = tid & 63, wave = F.wave_s, gw = F.vcu * NWAVES + wave, NGW = F.G * NWAVES; (void)lane; (void)gw; (void)NGW;
    unsigned char* const ws = KWS(); (void)ws;
    const bf16_t* U = (const bf16_t*)(ws + WS_U); bf16_t* ACT = (bf16_t*)(ws + WS_ACT);
    const float* cw = KIN(18); const float* cb = KIN(19);
    constexpr int NCG = DFF / 8, RUN = 8, NRUN = MC / RUN;
    if (tid < NCG) {
        const int ch0 = tid * 8;
        float wg[3][8], wv[3][8], bg[8], bv[8];
#pragma unroll
        for (int k = 0; k < 3; ++k) { const f32x4 a = *(const f32x4*)(cw + k * NUP + ch0), b = *(const f32x4*)(cw + k * NUP + ch0 + 4), c = *(const f32x4*)(cw + k * NUP + DFF + ch0), d = *(const f32x4*)(cw + k * NUP + DFF + ch0 + 4);
            wg[k][0] = a.x; wg[k][1] = a.y; wg[k][2] = a.z; wg[k][3] = a.w; wg[k][4] = b.x; wg[k][5] = b.y; wg[k][6] = b.z; wg[k][7] = b.w;
            wv[k][0] = c.x; wv[k][1] = c.y; wv[k][2] = c.z; wv[k][3] = c.w; wv[k][4] = d.x; wv[k][5] = d.y; wv[k][6] = d.z; wv[k][7] = d.w; }
        { const f32x4 a = *(const f32x4*)(cb + ch0), b = *(const f32x4*)(cb + ch0 + 4), c = *(const f32x4*)(cb + DFF + ch0), d = *(const f32x4*)(cb + DFF + ch0 + 4);
          bg[0] = a.x; bg[1] = a.y; bg[2] = a.z; bg[3] = a.w; bg[4] = b.x; bg[5] = b.y; bg[6] = b.z; bg[7] = b.w; bv[0] = c.x; bv[1] = c.y; bv[2] = c.z; bv[3] = c.w; bv[4] = d.x; bv[5] = d.y; bv[6] = d.z; bv[7] = d.w; }
        for (int run = F.vcu; run < NRUN; run += F.G) {
            const int t0 = run * RUN; const bool first = (t0 & (SEQ - 1)) == 0, last = ((t0 + RUN) & (SEQ - 1)) == 0;
            const bf16_t* up = U + (size_t)t0 * NUP + ch0;
            v4u rg[RUN + 2], rv[RUN + 2];
#pragma unroll
            for (int i = 0; i < RUN + 2; ++i) { const bool z = (i == 0 && first) || (i == RUN + 1 && last);
                if (z) { rg[i] = (v4u){0u, 0u, 0u, 0u}; rv[i] = rg[i]; } else { rg[i] = *(const v4u*)(up + (long)(i - 1) * NUP); rv[i] = *(const v4u*)(up + (long)(i - 1) * NUP + DFF); } }
            asm volatile("" ::: "memory");
#pragma unroll
            for (int i = 0; i < RUN; ++i) {
                float pg_[8], cg_[8], ng_[8], pv_[8], cv_[8], nv_[8], o[8];
                up8(rg[i], pg_); up8(rg[i + 1], cg_); up8(rg[i + 2], ng_); up8(rv[i], pv_); up8(rv[i + 1], cv_); up8(rv[i + 2], nv_);
#pragma unroll
                for (int k = 0; k < 8; ++k) { const float ug = pg_[k] * wg[0][k] + cg_[k] * wg[1][k] + ng_[k] * wg[2][k] + bg[k]; const float uv = pv_[k] * wv[0][k] + cv_[k] * wv[1][k] + nv_[k] * wv[2][k] + bv[k]; o[k] = gelu_tanh(ug) * uv; }
                v4u w; w.x = pk2(o[0], o[1]); w.y = pk2(o[2], o[3]); w.z = pk2(o[4], o[5]); w.w = pk2(o[6], o[7]);
                *(v4u*)(ACT + (size_t)(t0 + i) * DFF + ch0) = w;
            }
        }
    }
}

__device__ __forceinline__ void phase_final(const Ctx& F, float* out, const float* ss3, const float oscale) {
    int tid_ = F.wave_s * 64 + lane_id_v(); asm volatile("" : "+v"(tid_)); const int tid = tid_, lane = tid & 63, wave = F.wave_s, gw = F.vcu * NWAVES + wave, NGW = F.G * NWAVES; (void)lane; (void)gw; (void)NGW;
    unsigned char* const ws = KWS(); (void)ws;
    const float* g = KIN(24); const bf16_t* hs = (const bf16_t*)(ws + WS_XNB);
    f32x4 gv[4];
#pragma unroll
    for (int j = 0; j < 4; ++j) gv[j] = ((const f32x4*)g)[lane + 64 * j];
    for (int m0 = gw * 4; m0 < MC; m0 += NGW * 4) {
        v2u v[4][4]; float rs[4];
#pragma unroll
        for (int r = 0; r < 4; ++r) { const v2u* xr = (const v2u*)(hs + (size_t)(m0 + r) * DM) + lane; { const f32x4* sp = (const f32x4*)(ss3 + (size_t)(m0 + r) * 16); const f32x4 sa = (sp[0] + sp[1]) + (sp[2] + sp[3]); rs[r] = (sa[0] + sa[1]) + (sa[2] + sa[3]); }
#pragma unroll
            for (int j = 0; j < 4; ++j) v[r][j] = xr[64 * j]; }
        asm volatile("" ::: "memory");
#pragma unroll
        for (int r = 0; r < 4; ++r) { f32x4* xr = (f32x4*)(out + (size_t)(m0 + r) * DM) + lane; const float rr = __builtin_amdgcn_rsqf(rs[r] * (1.f / DM) + EPS) * oscale;
#pragma unroll
            for (int j = 0; j < 4; ++j) { const f32x4 h = (f32x4){pg8::bf_lo(v[r][j].x), pg8::bf_hi(v[r][j].x), pg8::bf_lo(v[r][j].y), pg8::bf_hi(v[r][j].y)}; xr[64 * j] = h * rr * gv[j]; } }
    }
}

struct Args { const float* in[25]; float* out; unsigned char* ws; };

#ifndef PROBE_GB
#define PROBE_GB 1
#endif
#ifndef PROBE_GF
#define PROBE_GF 1
#endif
#ifndef PROBE_GG
#define PROBE_GG 1
#endif
#ifndef PROBE_GI
#define PROBE_GI 1
#endif
#ifndef PROBE_GL
#define PROBE_GL 1
#endif
#ifndef PROBE_CONV
#define PROBE_CONV 1
#endif
#ifndef PROBE_PRO
#define PROBE_PRO 1
#endif
#ifndef PROBE_PREP
#define PROBE_PREP 1
#endif
#ifndef PROBE_TS
#define PROBE_TS 0
#endif
#ifndef PROBE_TSCALE
#define PROBE_TSCALE 2000
#endif
#if PROBE_TS
#define TS_PTR() ((volatile LAS unsigned long long*)((LAS unsigned char*)lds + MISC_OFF + 64))
#define STAMP(k) do { if (gbar.leader && blockIdx.x == 0) { volatile LAS unsigned long long* T_ = TS_PTR(); const unsigned long long t_ = __builtin_amdgcn_s_memrealtime(); if ((k) >= 0 && ((PROBE_TS >> (k)) & 1)) T_[1] += t_ - T_[0]; T_[0] = t_; } } while (0)
#define TS_PUBLISH() do { if (gbar.leader && blockIdx.x == 0) { const float us_ = (float)TS_PTR()[1] * 0.01f; const float b_ = __builtin_rintf(__builtin_log2f(us_ < 1.f ? 1.f : us_) * 2.6419f); *(volatile float*)(KWS() + WS_EPS) = b_ * (1.0f / 64.0f); } } while (0)
#else
#define STAMP(k) do {} while (0)
#define TS_PUBLISH() do {} while (0)
#endif
#ifndef PROBE_ATTNPH
#define PROBE_ATTNPH 1
#endif
#ifndef PROBE_GK
#define PROBE_GK 1
#endif
#ifndef PROBE_GH
#define PROBE_GH 1
#endif
#ifndef PROBE_BARX
#define PROBE_BARX 1
#endif
#define GBAR() do { for (int rep_ = 0; rep_ < PROBE_BARX; ++rep_) xcd_barrier(gbar); } while (0)
template <int c> __device__ __forceinline__ void run_chunk(const Ctx& F, unsigned char* lds, const XcdBarrier& gbar) {
    LAS unsigned char* L = (LAS unsigned char*)lds;
    const int bid = (int)blockIdx.x;
#define WSP(T, off) ((T*)(ws + (off)))
#define XC() ((c == 0) ? KIN(0) : KIN(1) + (size_t)(c - 1) * MC * DM)
#define OUTC() (KOUT() + (size_t)c * MC * DM)
#define SSP(k) ((float*)(ws + WS_SS) + (size_t)(k) * MC * 16)
#ifndef SKIP_GB
        for (int rep_ = 0; rep_ < PROBE_GB; ++rep_) {
            unsigned char* const ws = KWS(); pg8::Gemm g{WSP(bf16_t, WS_XN), (const bf16_t*)(ws + WS_WIN), MC, NPROJ, DM}; pg8::StaticOrder S; S.init(MC, NPROJ, F.G, bid);
            pg8::EpiProj E{WSP(bf16_t, WS_PROJ), NPROJ, C_GA / 256, C_AK / 256, QSCALE};
            pg8::gemm_phase<pg8::EpiProj, pg8::StaticOrder, PG8_ALIGN, PG8_SP2>(L, g, S, E, F.wave_s);
        }
#endif
        {
            const int extra = ((MC / 256) * (NPROJ / 256)) % F.G, gE = extra ? F.G - extra : F.G, cE = extra ? bid - extra : bid;
            if (cE >= 0) {
            unsigned char* const ws = KWS(); pg8::Gemm g{WSP(bf16_t, WS_PB), (const bf16_t*)(ws + WS_WPLE), MC, DM, PLE}; pg8::StaticOrder S; S.init(MC, DM, gE, cE);
            pg8::EpiProj E{WSP(bf16_t, WS_E), DM, 1 << 20, 0, 1.0f};
            pg8::gemm_phase<pg8::EpiProj, pg8::StaticOrder, PG8_ALIGN, PG8_SP2>(L, g, S, E, F.wave_s);
            }
        }
#ifndef SKIP_EW
        if (c > 0) { unsigned char* const ws = KWS(); phase_final(F, KOUT() + (size_t)(c - 1) * MC * DM, SSP(2), 1.0f); }
#endif
        GBAR(); STAMP(1);
#ifndef SKIP_EW
        phase_rope(F);
        if (c + 1 < NCHUNK) { for (int rep_ = 0; rep_ < PROBE_PREP; ++rep_) phase_prep(F, KIN(1) + (size_t)c * MC * DM, KIN(3) + (size_t)c * MC * PLE); }
#endif
        GBAR(); STAMP(2);
#ifndef SKIP_ATTN
        for (int rep_ = 1; rep_ < PROBE_ATTNPH; ++rep_) { phase_attn(F, (char*)lds); xcd_barrier(gbar); }
        phase_attn(F, (char*)lds);
#endif
        GBAR(); STAMP(3);
#ifndef SKIP_GF
        for (int rep_ = 0; rep_ < PROBE_GF; ++rep_) {
            unsigned char* const ws = KWS(); pg8::Gemm g{WSP(bf16_t, WS_OA1), (const bf16_t*)(ws + WS_WA), MC, DM, DM}; pg8::StaticOrder S; S.init(MC, DM, F.G, bid);
            pg8::EpiT1 E{WSP(bf16_t, WS_PROJ) + C_GA, NPROJ, WSP(bf16_t, WS_OA2), DM};
            pg8::gemm_phase<pg8::EpiT1, pg8::StaticOrder, PG8_ALIGN1, PG8_SP2>(L, g, S, E, F.wave_s);
        }
#endif
        GBAR(); STAMP(5);
#ifndef SKIP_GG
        for (int rep_ = 0; rep_ < PROBE_GG; ++rep_) {
            unsigned char* const ws = KWS(); pg8::Gemm g{WSP(bf16_t, WS_OB), (const bf16_t*)(ws + WS_WB), MC, DM, DM}; pg8::StaticOrder S; S.init(MC, DM, F.G, bid);
            pg8::EpiMerge E{WSP(bf16_t, WS_PROJ) + C_GB, NPROJ, WSP(bf16_t, WS_OA2), DM, WSP(bf16_t, WS_MG), DM};
            pg8::gemm_phase<pg8::EpiMerge, pg8::StaticOrder, PG8_ALIGN1, PG8_SP2>(L, g, S, E, F.wave_s);
        }
#endif
        GBAR(); STAMP(6);
#ifndef SKIP_GH
        for (int rep_ = 0; rep_ < PROBE_GH; ++rep_) {
            unsigned char* const ws = KWS(); pg8::Gemm g{WSP(bf16_t, WS_MG), (const bf16_t*)(ws + WS_WOUT), MC, DM, DM}; pg8::StaticOrder S; S.init(MC, DM, F.G, bid);
            pg8::EpiResidB<false> E{XC(), WSP(bf16_t, WS_HS), SSP(0), DM};
            pg8::gemm_phase<pg8::EpiResidB<false>, pg8::StaticOrder, PG8_ALIGN1, PG8_SP2>(L, g, S, E, F.wave_s);
        }
#endif
        GBAR(); STAMP(7);
#ifndef SKIP_GI
        for (int rep_ = 0; rep_ < PROBE_GI; ++rep_) {
            unsigned char* const ws = KWS(); pg8::Gemm g{WSP(bf16_t, WS_HS), (const bf16_t*)(ws + WS_WUP), MC, NUP, DM}; pg8::StaticOrder S; S.init(MC, NUP, F.G, bid);
            pg8::EpiScale<false> E{SSP(0), 1.f / DM, EPS, WSP(bf16_t, WS_U), nullptr, NUP};
            pg8::gemm_phase<pg8::EpiScale<false>, pg8::StaticOrder, PG8_ALIGN, PG8_SP2>(L, g, S, E, F.wave_s);
        }
#endif
        GBAR(); STAMP(8);
#ifndef SKIP_CONV
        for (int rep_ = 0; rep_ < PROBE_CONV; ++rep_) phase_conv(F);
#endif
        GBAR(); STAMP(9);
#ifndef SKIP_GK
        {
            unsigned char* const ws = KWS(); pg8::Gemm g{WSP(bf16_t, WS_ACT), (const bf16_t*)(ws + WS_WDN), MC, DM, DFF}; pg8::StaticOrder S; S.init(MC, DM, F.G, bid);
            pg8::EpiResidB<true> E{WSP(bf16_t, WS_HS), WSP(bf16_t, WS_HS), SSP(1), DM};
            pg8::gemm_phase<pg8::EpiResidB<true>, pg8::StaticOrder, PG8_ALIGN1, PG8_SP2>(L, g, S, E, F.wave_s);
        }
#endif
        GBAR(); STAMP(10);
#ifndef SKIP_GL
        {
            unsigned char* const ws = KWS(); pg8::Gemm g{WSP(bf16_t, WS_HS), (const bf16_t*)(ws + WS_WPG), MC, DM, DM}; pg8::StaticOrder S; S.init(MC, DM, F.G, bid);
            pg8::EpiPle E{SSP(1), 1.f / DM, EPS, WSP(bf16_t, WS_E), WSP(bf16_t, WS_HS), WSP(bf16_t, WS_XNB), SSP(2), DM};
            pg8::gemm_phase<pg8::EpiPle, pg8::StaticOrder, PG8_ALIGN1, PG8_SP2>(L, g, S, E, F.wave_s);
        }
#endif
        GBAR(); STAMP(11); if (c == NCHUNK - 1) TS_PUBLISH();
#ifndef SKIP_EW
        if (c == NCHUNK - 1) { unsigned char* const ws = KWS(); phase_final(F, OUTC(), SSP(2), (PROBE_TS && c == NCHUNK - 1) ? 1.0f + *(const float*)(ws + WS_EPS) : 1.0f); }
#endif
}

__global__ void __launch_bounds__(NWAVES * 64, 2) mk_fwd(Args args) {
    extern __shared__ __attribute__((aligned(16))) unsigned char lds[];
    cg::grid_group grid = cg::this_grid();
    Ctx F;
    F.wave_s = __builtin_amdgcn_readfirstlane((int)threadIdx.x >> 6);
    if (threadIdx.x < 32) ((volatile LAS unsigned*)((LAS unsigned char*)lds + MISC_OFF))[threadIdx.x] = 0u;
    __syncthreads();
    const XcdBarrier gbar = xcd_barrier_post((unsigned*)(KWS() + WS_BAR), (volatile LAS unsigned*)((LAS unsigned char*)lds + MISC_OFF) + 8, threadIdx.x == 0);
    F.G = gridDim.x; { const int bx = blockIdx.x; F.vcu = (F.G % 8 == 0) ? (bx % 8) * (F.G / 8) + bx / 8 : bx; }
    (void)args;
    LAS unsigned char* L = (LAS unsigned char*)lds;
#ifndef SKIP_EW
    STAMP(-1);
    for (int rep_ = 0; rep_ < PROBE_PRO; ++rep_) phase_prologue(F, L);
    for (int rep_ = 0; rep_ < PROBE_PREP; ++rep_) phase_prep(F, KIN(0), KIN(2));
#endif
    grid.sync(); STAMP(0);
    run_chunk<0>(F, lds, gbar);
#ifndef ONE_CHUNK
    run_chunk<1>(F, lds, gbar);
    run_chunk<2>(F, lds, gbar);
#endif
}

extern "C" void kernel_launch(void* const* d_in, const int* in_sizes, int n_in, void* d_out, int out_size, void* d_ws, size_t ws_size, hipStream_t stream) {
    static int grid = 0;
    if (grid == 0) {
        if (n_in != 25 || ws_size < WS_END) { fprintf(stderr, "kernel_launch: unexpected inputs (n_in %d, ws %zu)\n", n_in, ws_size); grid = -1; return; }
        int dev = 0, cus = 0, per_cu = 0;
        hipGetDevice(&dev); hipDeviceGetAttribute(&cus, hipDeviceAttributeMultiprocessorCount, dev);
        hipFuncSetAttribute((const void*)mk_fwd, hipFuncAttributeMaxDynamicSharedMemorySize, LDS_BYTES);
        hipOccupancyMaxActiveBlocksPerMultiprocessor(&per_cu, (const void*)mk_fwd, NWAVES * 64, LDS_BYTES);
        (void)hipGetLastError();
        if (per_cu < 1) per_cu = 1;
        grid = cus;
    }
    if (grid < 0) return;
    if (hipMemsetAsync((char*)d_ws + WS_BAR, 0, 16384, stream) != hipSuccess) { fprintf(stderr, "kernel_launch: memset failed\n"); return; }
    Args a{};
    for (int i = 0; i < 25; ++i) a.in[i] = (const float*)d_in[i];
    a.out = (float*)d_out; a.ws = (unsigned char*)d_ws;
    void* kargs[] = {&a};
    hipError_t e = hipLaunchCooperativeKernel((const void*)mk_fwd, dim3(grid), dim3(NWAVES * 64), kargs, LDS_BYTES, stream);
    if (e != hipSuccess) fprintf(stderr, "cooperative launch failed: %s (grid %d)\n", hipGetErrorString(e), grid);
}
```
